# Optimizing an MI355X kernel written in HIP

```python
import math
import jax
import jax.numpy as jnp
from jax import lax
import numpy as np

D_MODEL = 1024
BATCH = 8
SEQ = 4096
DEPTH = 4

GRID_W = 64
CTX_LEN = 256
N_MIXERS = 3
MIX_POOL = 0
MIX_SSM = 1
MIX_ATTN = 2
NORM_EPS = 1e-6
N_MOD = 6

POOL_WINDOWS = (2, 4, 8, 16)
POOL_GROUPS = len(POOL_WINDOWS)
POOL_GC = D_MODEL // POOL_GROUPS

SSM_H = 16
SSM_G = D_MODEL // SSM_H
SSM_P = 64
SSM_CHUNK = 128
SSM_DT_MIN = 0.001
SSM_DT_MAX = 0.1

HEAD_DIM = 128
N_HEADS = D_MODEL // HEAD_DIM
N_KV_HEADS = 2
KV_REP = N_HEADS // N_KV_HEADS
QKV_DIM = D_MODEL + 2 * N_KV_HEADS * HEAD_DIM
Q_BLOCK = 128
ROPE_F = HEAD_DIM // 4
ROPE_THETA = 10000.0

N_EXPERTS = 32
TOP_K = 4
D_FF = D_MODEL
SWIGLU_ALPHA = 1.702
SWIGLU_LIMIT = 7.0
MOE_BLOCK = 256

kernel_name = 'hybrid_pool_s5_gqa_moe_prefix_dit'


def _layers_of(kind):
    return len(range(kind, DEPTH, N_MIXERS))


def _rms(x, g):
    x32 = x.astype(jnp.float32)
    y = x32 * lax.rsqrt(jnp.mean(x32 * x32, axis=-1, keepdims=True) + NORM_EPS)
    return (y * g.astype(jnp.float32)).astype(x.dtype)


def _modulate(h, shift, scale):
    return h * (1 + scale) + shift


def _pool_mixer(h, w, scale):
    b, n, d = h.shape
    h32 = h.astype(jnp.float32)
    csum = jnp.concatenate([jnp.zeros((b, 1, d), jnp.float32), jnp.cumsum(h32, axis=1)], axis=1)
    t = jnp.arange(n)
    diffs = []
    for g, win in enumerate(POOL_WINDOWS):
        lo = jnp.clip(t - win // 2, 0, n)
        hi = jnp.clip(t + win // 2, 0, n)
        sl = slice(g * POOL_GC, (g + 1) * POOL_GC)
        total = csum[:, hi, sl] - csum[:, lo, sl]
        cnt = (hi - lo).astype(jnp.float32)[None, :, None]
        diffs.append(total / cnt - h32[:, :, sl])
    diff = jnp.stack(diffs, axis=2).astype(h.dtype)
    y = jnp.einsum('bngc,gce->bnge', diff, w).reshape(b, n, d)
    return y * scale


def _s5_discretise(lam_re, lam_im, log_dt, b_re, b_im):
    f32 = jnp.float32
    lam_re, lam_im = lam_re.astype(f32), lam_im.astype(f32)
    b_re, b_im = b_re.astype(f32), b_im.astype(f32)
    dt = jnp.exp(log_dt.astype(f32))[:, None]
    zr, zi = lam_re * dt, lam_im * dt
    mag = jnp.exp(zr)
    ar, ai = mag * jnp.cos(zi), mag * jnp.sin(zi)
    den = lam_re * lam_re + lam_im * lam_im
    cr = ((ar - 1.0) * lam_re + ai * lam_im) / den
    ci = (ai * lam_re - (ar - 1.0) * lam_im) / den
    bbr = cr[..., None] * b_re - ci[..., None] * b_im
    bbi = cr[..., None] * b_im + ci[..., None] * b_re
    return zr, zi, bbr, bbi


def _ssm_combine(e1, e2):
    a1r, a1i, b1r, b1i = e1
    a2r, a2i, b2r, b2i = e2
    return (a1r * a2r - a1i * a2i,
            a1r * a2i + a1i * a2r,
            a2r * b1r - a2i * b1i + b2r,
            a2r * b1i + a2i * b1r + b2i)


def _s5_scan(u, zr, zi, bbr, bbi, c_re, c_im, h0r, h0i, readout):
    n, b = u.shape[0], u.shape[1]
    tau = jnp.arange(1, SSM_CHUNK + 1, dtype=jnp.float32)[:, None, None]
    pmag = jnp.exp(tau * zr)
    pr = (pmag * jnp.cos(tau * zi))[:, None]
    pi_ = (pmag * jnp.sin(tau * zi))[:, None]
    full = (SSM_CHUNK, b, SSM_G, SSM_P)
    a_r = jnp.broadcast_to(pr[:1], full)
    a_i = jnp.broadcast_to(pi_[:1], full)

    def step(carry, u_blk):
        hr0, hi0 = carry
        bur = jnp.einsum('tbgh,gph->tbgp', u_blk, bbr)
        bui = jnp.einsum('tbgh,gph->tbgp', u_blk, bbi)
        _, _, hr, hi = lax.associative_scan(_ssm_combine, (a_r, a_i, bur, bui), axis=0)
        hr, hi = hr + pr * hr0 - pi_ * hi0, hi + pr * hi0 + pi_ * hr0
        y = None
        if readout:
            y = jnp.einsum('tbgp,ghp->tbgh', hr, c_re) - jnp.einsum('tbgp,ghp->tbgh', hi, c_im)
        return (hr[-1], hi[-1]), y

    u_chunks = u.reshape((n // SSM_CHUNK, SSM_CHUNK) + u.shape[1:])
    h_last, ys = lax.scan(step, (h0r, h0i), u_chunks)
    if readout:
        ys = ys.reshape(u.shape)
    return ys, h_last


def _s5_mixer(h, hc, lam_re, lam_im, log_dt, b_re, b_im, c_re, c_im, d_skip, glu_w, glu_b, need_ctx_out):
    f32 = jnp.float32
    b = h.shape[0]

    def to_seq(t):
        return jnp.transpose(t.astype(f32).reshape(t.shape[0], t.shape[1], SSM_G, SSM_H), (1, 0, 2, 3))

    u, uc = to_seq(h), to_seq(hc)
    zeros = jnp.zeros((b, SSM_G, SSM_P), f32)
    y_lat, y_ctx = [], []
    for direction in range(2):
        zr, zi, bbr, bbi = _s5_discretise(lam_re[direction], lam_im[direction], log_dt[direction],
                                          b_re[direction], b_im[direction])
        cr, ci = c_re[direction].astype(f32), c_im[direction].astype(f32)
        rev = direction == 1
        uc_d = uc[::-1] if rev else uc
        u_d = u[::-1] if rev else u
        yc_d, (hr, hi) = _s5_scan(uc_d, zr, zi, bbr, bbi, cr, ci, zeros, zeros, need_ctx_out)
        yl_d, _ = _s5_scan(u_d, zr, zi, bbr, bbi, cr, ci, hr, hi, True)
        y_lat.append(yl_d[::-1] if rev else yl_d)
        if need_ctx_out:
            y_ctx.append(yc_d[::-1] if rev else yc_d)

    def readout(ys, t):
        ysum = ys[0] + ys[1]
        y = jnp.transpose(ysum, (1, 0, 2, 3)).reshape(t.shape) + d_skip.astype(f32) * t.astype(f32)
        g = jax.nn.gelu(y).astype(t.dtype)
        z = g @ glu_w + glu_b
        val, gate = jnp.split(z, 2, axis=-1)
        return val * jax.nn.sigmoid(gate)

    y = readout(y_lat, h)
    yc = readout(y_ctx, hc) if need_ctx_out else None
    return y, yc


def _grid_angles(n):
    rows = n // GRID_W
    row = jnp.repeat(jnp.arange(rows), GRID_W)
    col = jnp.tile(jnp.arange(GRID_W), rows)
    pos = jnp.stack([row, col], axis=-1).astype(jnp.float32)
    inv_freq = ROPE_THETA ** (-jnp.arange(ROPE_F, dtype=jnp.float32) / ROPE_F)
    ang = pos[:, :, None] * inv_freq
    return jnp.cos(ang), jnp.sin(ang)


def _rope2d(x, cos, sin):
    xr = x.reshape(x.shape[:-1] + (2, 2, ROPE_F))
    x1, x2 = xr[..., 0, :], xr[..., 1, :]
    shape = (1, cos.shape[0]) + (1,) * (x1.ndim - 4) + (2, ROPE_F)
    cs = cos.reshape(shape).astype(x.dtype)
    sn = sin.reshape(shape).astype(x.dtype)
    out = jnp.stack([x1 * cs - x2 * sn, x2 * cs + x1 * sn], axis=-2)
    return out.reshape(x.shape)


def _attend(q, k, v):
    s = jnp.einsum('bqgrd,bkgd->bgrqk', q, k).astype(jnp.float32) * (HEAD_DIM ** -0.5)
    p = jax.nn.softmax(s, axis=-1).astype(v.dtype)
    return jnp.einsum('bgrqk,bkgd->bqgrd', p, v)


def _attn_mixer(h, hc, wqkv, q_g, k_g, wo, need_ctx_out):
    b, n, _ = h.shape
    l = hc.shape[1]

    def project(t, with_q):
        m = t.shape[1]
        kv_w = N_KV_HEADS * HEAD_DIM
        z = t @ (wqkv if with_q else wqkv[:, D_MODEL:])
        q = None
        if with_q:
            q, z = z[..., :D_MODEL], z[..., D_MODEL:]
            q = _rms(q.reshape(b, m, N_KV_HEADS, KV_REP, HEAD_DIM), q_g)
        k = _rms(z[..., :kv_w].reshape(b, m, N_KV_HEADS, HEAD_DIM), k_g)
        v = z[..., kv_w:].reshape(b, m, N_KV_HEADS, HEAD_DIM)
        return q, k, v

    q, k, v = project(h, True)
    cos, sin = _grid_angles(n)
    q, k = _rope2d(q, cos, sin), _rope2d(k, cos, sin)
    qc, kc, vc = project(hc, need_ctx_out)
    keys = jnp.concatenate([kc, k], axis=1)
    vals = jnp.concatenate([vc, v], axis=1)
    nb = n // Q_BLOCK
    q_blocks = jnp.moveaxis(q.reshape(b, nb, Q_BLOCK, N_KV_HEADS, KV_REP, HEAD_DIM), 1, 0)
    o = lax.map(lambda qb: _attend(qb, keys, vals), q_blocks)
    o = jnp.moveaxis(o, 0, 1).reshape(b, n, D_MODEL)
    y = o @ wo
    yc = _attend(qc, kc, vc).reshape(b, l, D_MODEL) @ wo if need_ctx_out else None
    return y, yc


def _moe(h, router_w, router_b, w1, b1, w2, b2):
    t, d = h.shape
    logits = (h @ router_w + router_b).astype(jnp.float32)
    vals, idx = lax.top_k(logits, TOP_K)
    gates = jax.nn.softmax(vals, axis=-1)
    flat_e = idx.reshape(-1)
    flat_tok = jnp.repeat(jnp.arange(t, dtype=jnp.int32), TOP_K)
    flat_g = gates.reshape(-1)
    order = jnp.argsort(flat_e)
    sorted_e = flat_e[order]
    counts = jnp.bincount(flat_e, length=N_EXPERTS)
    padded = (counts + MOE_BLOCK - 1) // MOE_BLOCK * MOE_BLOCK
    ends = jnp.cumsum(padded)
    pad_start = ends - padded
    grp_start = jnp.cumsum(counts) - counts
    rank = jnp.arange(t * TOP_K) - grp_start[sorted_e]
    dest = pad_start[sorted_e] + rank
    n_blocks = -(-(t * TOP_K) // MOE_BLOCK) + N_EXPERTS
    cap = n_blocks * MOE_BLOCK
    tok_buf = jnp.full((cap,), t, jnp.int32).at[dest].set(flat_tok[order])
    gate_buf = jnp.zeros((cap,), jnp.float32).at[dest].set(flat_g[order])
    h_pad = jnp.concatenate([h, jnp.zeros((1, d), h.dtype)], axis=0)
    x_blocks = h_pad[tok_buf].reshape(n_blocks, MOE_BLOCK, d)
    block_e = jnp.minimum(jnp.searchsorted(ends, jnp.arange(n_blocks) * MOE_BLOCK, side='right'), N_EXPERTS - 1)

    def expert(args):
        xb, e = args
        z = xb @ w1[e] + b1[e]
        glu, lin = z[:, :D_FF], z[:, D_FF:]
        glu = jnp.minimum(glu, SWIGLU_LIMIT)
        lin = jnp.clip(lin, -SWIGLU_LIMIT, SWIGLU_LIMIT)
        act = glu * jax.nn.sigmoid(SWIGLU_ALPHA * glu) * (lin + 1)
        return act @ w2[e] + b2[e]

    y = lax.map(expert, (x_blocks, block_e)).reshape(cap, d)
    out = jax.ops.segment_sum(y * gate_buf[:, None].astype(y.dtype), tok_buf, num_segments=t + 1)
    return out[:t]


def setup_inputs(seed: int = 0) -> dict:
    key = jax.random.key(seed)
    keys = iter(jax.random.split(key, 32))
    f32 = jnp.float32

    def nrm(shape, s=1.0):
        return jax.random.normal(next(keys), shape, f32) * s

    n_pool, n_ssm, n_attn = _layers_of(MIX_POOL), _layers_of(MIX_SSM), _layers_of(MIX_ATTN)
    d = D_MODEL
    return {
        'x': nrm((BATCH, SEQ, d)),
        'c': nrm((BATCH, d)),
        'ctx': nrm((BATCH, CTX_LEN, d)),
        'c_ctx': nrm((d,)),
        'ada_w': nrm((DEPTH, d, N_MOD * d), 0.5 * d ** -0.5),
        'ada_b': nrm((DEPTH, N_MOD * d), 0.01),
        'norm1_g': 1.0 + nrm((DEPTH, d), 0.01),
        'norm2_g': 1.0 + nrm((DEPTH, d), 0.01),
        'pool_w': nrm((n_pool, POOL_GROUPS, POOL_GC, POOL_GC), POOL_GC ** -0.5),
        'pool_scale': 1.0 + nrm((n_pool, d), 0.02),
        'ssm_lam_re': -0.5 + nrm((n_ssm, 2, SSM_G, SSM_P), 0.01),
        'ssm_lam_im': jnp.pi * jnp.arange(SSM_P, dtype=f32) + nrm((n_ssm, 2, SSM_G, SSM_P), 0.01),
        'ssm_log_dt': jax.random.uniform(next(keys), (n_ssm, 2, SSM_G), f32,
                                         math.log(SSM_DT_MIN), math.log(SSM_DT_MAX)),
        'ssm_b_re': nrm((n_ssm, 2, SSM_G, SSM_P, SSM_H), (2 * SSM_H) ** -0.5),
        'ssm_b_im': nrm((n_ssm, 2, SSM_G, SSM_P, SSM_H), (2 * SSM_H) ** -0.5),
        'ssm_c_re': nrm((n_ssm, 2, SSM_G, SSM_H, SSM_P), SSM_P ** -0.5),
        'ssm_c_im': nrm((n_ssm, 2, SSM_G, SSM_H, SSM_P), SSM_P ** -0.5),
        'ssm_d': nrm((n_ssm, d)),
        'ssm_glu_w': nrm((n_ssm, d, 2 * d), d ** -0.5),
        'ssm_glu_b': nrm((n_ssm, 2 * d), 0.01),
        'attn_wqkv': nrm((n_attn, d, QKV_DIM), d ** -0.5),
        'attn_q_g': 1.0 + nrm((n_attn, HEAD_DIM), 0.01),
        'attn_k_g': 1.0 + nrm((n_attn, HEAD_DIM), 0.01),
        'attn_wo': nrm((n_attn, d, d), d ** -0.5),
        'router_w': nrm((DEPTH, d, N_EXPERTS), d ** -0.5),
        'router_b': nrm((DEPTH, N_EXPERTS), 0.01),
        'moe_w1': nrm((DEPTH, N_EXPERTS, d, 2 * D_FF), d ** -0.5),
        'moe_b1': nrm((DEPTH, N_EXPERTS, 2 * D_FF), 0.01),
        'moe_w2': nrm((DEPTH, N_EXPERTS, D_FF, d), D_FF ** -0.5),
        'moe_b2': nrm((DEPTH, N_EXPERTS, d), 0.01),
    }


def reference(x, c, ctx, c_ctx, ada_w, ada_b, norm1_g, norm2_g, pool_w, pool_scale,
              ssm_lam_re, ssm_lam_im, ssm_log_dt, ssm_b_re, ssm_b_im, ssm_c_re, ssm_c_im,
              ssm_d, ssm_glu_w, ssm_glu_b, attn_wqkv, attn_q_g, attn_k_g, attn_wo,
              router_w, router_b, moe_w1, moe_b1, moe_w2, moe_b2):
    b, n, d = x.shape
    xc = ctx
    s_lat = jax.nn.silu(c)
    s_ctx = jax.nn.silu(c_ctx)
    for i in range(DEPTH):
        kind, j = i % N_MIXERS, i // N_MIXERS
        last = i == DEPTH - 1
        ctx_in = (not last) or kind != MIX_POOL
        mod = [m[:, None, :] for m in jnp.split(s_lat @ ada_w[i] + ada_b[i], N_MOD, axis=-1)]
        h = _modulate(_rms(x, norm1_g[i]), mod[0], mod[1])
        hc, mod_c = None, None
        if ctx_in:
            n_c = 2 if last else N_MOD
            width = n_c * D_MODEL
            mod_c = jnp.split(s_ctx @ ada_w[i][:, :width] + ada_b[i][:width], n_c, axis=-1)
            hc = _modulate(_rms(xc, norm1_g[i]), mod_c[0], mod_c[1])
        if kind == MIX_POOL:
            y = _pool_mixer(h, pool_w[j], pool_scale[j])
            yc = None if last else _pool_mixer(hc, pool_w[j], pool_scale[j])
        elif kind == MIX_SSM:
            y, yc = _s5_mixer(h, hc, ssm_lam_re[j], ssm_lam_im[j], ssm_log_dt[j], ssm_b_re[j], ssm_b_im[j],
                              ssm_c_re[j], ssm_c_im[j], ssm_d[j], ssm_glu_w[j], ssm_glu_b[j], not last)
        else:
            y, yc = _attn_mixer(h, hc, attn_wqkv[j], attn_q_g[j], attn_k_g[j], attn_wo[j], not last)
        x = x + mod[2] * y
        h2 = _modulate(_rms(x, norm2_g[i]), mod[3], mod[4]).reshape(b * n, d)
        if last:
            f = _moe(h2, router_w[i], router_b[i], moe_w1[i], moe_b1[i], moe_w2[i], moe_b2[i])
            x = x + mod[5] * f.reshape(b, n, d)
        else:
            xc = xc + mod_c[2] * yc
            hc2 = _modulate(_rms(xc, norm2_g[i]), mod_c[3], mod_c[4]).reshape(-1, d)
            f = _moe(jnp.concatenate([h2, hc2], axis=0),
                     router_w[i], router_b[i], moe_w1[i], moe_b1[i], moe_w2[i], moe_b2[i])
            x = x + mod[5] * f[:b * n].reshape(b, n, d)
            xc = xc + mod_c[5] * f[b * n:].reshape(xc.shape)
    return x
```

```cpp
#include <hip/hip_runtime.h>
#include <cstdio>
#include <cstdint>

#ifndef MK_SPLIT
#define MK_SPLIT 0
#endif
#ifndef MK_LAYERS
#define MK_LAYERS 4
#endif
#ifndef MK_EN
#define MK_EN 0xFFFFF
#endif
#define EN(n) ((MK_EN >> (n)) & 1)
#ifndef MK_REP
#define MK_REP 0
#endif
#ifndef MK_PROBE_NULL
#define MK_PROBE_NULL 0
#endif
#define NREP(n) (1 + ((MK_REP >> (n)) & 1))

#define GAS __attribute__((address_space(1)))
#define LAS __attribute__((address_space(3)))
typedef unsigned short bf16;
typedef float f32x4 __attribute__((ext_vector_type(4)));
typedef float f32x2 __attribute__((ext_vector_type(2)));
typedef float f32x16 __attribute__((ext_vector_type(16)));
typedef float f32x8 __attribute__((ext_vector_type(8)));
typedef short bf16x8 __attribute__((ext_vector_type(8)));
typedef short s16x4 __attribute__((ext_vector_type(4)));
typedef unsigned u32x4 __attribute__((ext_vector_type(4)));
typedef unsigned u32x2 __attribute__((ext_vector_type(2)));
typedef int v8i __attribute__((ext_vector_type(8)));
typedef int v4i __attribute__((ext_vector_type(4)));
constexpr float W8_SCALE = 32.0f;
constexpr float Y8_SCALE = 8.0f;

constexpr int DM = 1024, NB = 8, SEQ = 4096, CTXL = 256, SEG = SEQ + CTXL  , NR = NB * SEG  , NTILE = NR / 256  ;
constexpr int NE = 32, TOPK = 4, DFF = 1024, NMOD = 6 * DM;
constexpr int CAPROWS = NR * TOPK + NE * 256;
constexpr float NORM_EPS = 1e-6f;
constexpr int NWAVES = 8, NTHR = 512;

enum { I_X = 0, I_C, I_CTX, I_CCTX, I_ADAW, I_ADAB, I_N1G, I_N2G, I_POOLW, I_POOLS, I_LAMRE, I_LAMIM, I_LOGDT, I_BRE, I_BIM, I_CRE, I_CIM, I_SSMD, I_GLUW, I_GLUB,
       I_WQKV, I_QG, I_KG, I_WO, I_RW, I_RB, I_W1, I_B1, I_W2, I_B2, N_IN };

constexpr size_t al256(size_t x) { return (x + 255) & ~(size_t)255; }
constexpr size_t WS_CTL = 0, CTL_BYTES = 1u << 20;
constexpr size_t WS_MODS = WS_CTL + CTL_BYTES;
constexpr size_t WS_ROPE = al256(WS_MODS + (size_t)4 * 9 * NMOD * 4);
constexpr size_t WS_S5LAM = al256(WS_ROPE + 64 * 32 * 8);
constexpr size_t WS_S5BF = al256(WS_S5LAM + 2 * 64 * 64 * 8);
constexpr size_t WS_S5CF = al256(WS_S5BF + (size_t)2 * 64 * 4 * 64 * 16);
constexpr size_t WS_RT = al256(WS_S5CF + (size_t)2 * 64 * 4 * 64 * 16);
constexpr size_t WS_POOLW = al256(WS_RT + (size_t)4 * 32 * 1024 * 4);
constexpr size_t WS_GLUW = al256(WS_POOLW + (size_t)2 * 4 * 256 * 256 * 2);
constexpr size_t WS_WQKV = al256(WS_GLUW + (size_t)2048 * 1024 * 2);
constexpr size_t WS_WO = al256(WS_WQKV + (size_t)1536 * 1024 * 2);
constexpr size_t WS_GATE = al256(WS_WO + (size_t)1024 * 1024 * 2);
constexpr size_t WS_LIST = al256(WS_GATE + (size_t)32 * NR * 4);
constexpr size_t WS_XS = al256(WS_LIST + (size_t)32 * NR * 4);
constexpr size_t WS_B1 = al256(WS_XS + (size_t)NR * DM * 4);
constexpr size_t WS_B2 = al256(WS_B1 + (size_t)NR * DM * 2);
constexpr size_t WS_B3 = al256(WS_B2 + (size_t)NR * DM * 2);
constexpr size_t WS_KB = al256(WS_B3 + (size_t)NR * DM * 2);
constexpr size_t WS_VB = al256(WS_KB + (size_t)NR * 256 * 2);
constexpr size_t WS_YG = al256(WS_VB + (size_t)NR * 256 * 2);
constexpr size_t WS_ACT = al256(WS_YG + (size_t)2 * NR * DM * 4);
constexpr size_t WS_YB = al256(WS_ACT + (size_t)CAPROWS * DFF * 2);
constexpr size_t WS_B3F = al256(WS_YB + (size_t)(NR * 4 + 1) * DM * 2);
constexpr size_t WS_W1T = al256(WS_B3F + (size_t)NR * DM);
constexpr size_t WS_W2T = al256(WS_W1T + (size_t)4 * 32 * 2048 * 1024);
constexpr size_t WS_END = al256(WS_W2T + (size_t)4 * 32 * 1024 * 1024);

constexpr int CW_CNT = 64;
constexpr int CW_BAR = 4096;

constexpr int RING_BYTES = 131072;
constexpr int ROWTAB_OFF = RING_BYTES;
constexpr int RSCR_OFF = 132096;
constexpr int LDS_BYTES = 147456;
constexpr int MISC_OFF = LDS_BYTES - 64;
constexpr int RPB_MAX = 280;
static_assert(RSCR_OFF + RPB_MAX * 4 * 8 + 3 * 32 * 4 + 64 <= MISC_OFF, "LDS map");

__device__ __forceinline__ unsigned cvt_pk_bf16(float lo, float hi) { unsigned r; asm volatile("v_cvt_pk_bf16_f32 %0, %1, %2" : "=v"(r) : "v"(lo), "v"(hi)); return r; }
__device__ __forceinline__ unsigned cvt_pk4_fp8(float a, float b, float c, float d) { unsigned w = 0; w = __builtin_amdgcn_cvt_pk_fp8_f32(a, b, w, false); w = __builtin_amdgcn_cvt_pk_fp8_f32(c, d, w, true); return w; }
__device__ __forceinline__ float bf_lo(unsigned w) { return __uint_as_float(w << 16); }
__device__ __forceinline__ float bf_hi(unsigned w) { return __uint_as_float(w & 0xffff0000u); }
__device__ __forceinline__ float wave_sum(float v) {
#pragma unroll
    for (int o = 1; o < 64; o <<= 1) v += __shfl_xor(v, o);
    return v;
}
__device__ __forceinline__ float sigmoidf_(float x) { return 1.0f / (1.0f + __expf(-x)); }
#define LDS_WAIT() asm volatile("s_waitcnt lgkmcnt(0)" ::: "memory")
#define VM_WAIT() asm volatile("s_waitcnt vmcnt(0)" ::: "memory")

#define XB_TMO      128
#define XB_XCNT(j)  (256  + 64 * (j))
#define XB_XSUB(j)  (1280 + 64 * (j))
#define XB_XGEN(j)  (2304 + 64 * (j))
#define XB_TOP      3328
#define XB_TOPGEN   3392
#define XCD_BAR_WORDS 3456
#define XB_SPIN_CAP (1u << 18)
__device__ __forceinline__ unsigned xb_ld(unsigned* p)              { return __hip_atomic_load(p, __ATOMIC_RELAXED, __HIP_MEMORY_SCOPE_AGENT); }
__device__ __forceinline__ unsigned xb_add(unsigned* p, unsigned v) { return __hip_atomic_fetch_add(p, v, __ATOMIC_RELAXED, __HIP_MEMORY_SCOPE_AGENT); }
__device__ __forceinline__ unsigned xb_xcc_id() { return (unsigned)__builtin_amdgcn_s_getreg((3 << 11) | 20) & 0xFu; }
#define XB_SPIN(cond, bar) do { unsigned _sp = 0; while (cond) { __builtin_amdgcn_s_sleep(1); \
    if ((++_sp & 255u) == 0u) { if (xb_ld(&(bar)[XB_TMO])) break; if (_sp > XB_SPIN_CAP) { atomicAdd(&(bar)[XB_TMO], 1u); break; } } } } while (0)
struct XcdBarrier { unsigned* bar; unsigned x; volatile LAS unsigned* st; };
__device__ __forceinline__ XcdBarrier xcd_barrier_post(unsigned* bar, volatile LAS unsigned* st) {
    XcdBarrier b; b.bar = bar; b.x = xb_xcc_id(); b.st = st;
    if (threadIdx.x == 0) (void)xb_add(&bar[XB_XCNT(b.x)], 1u);
    return b;
}
__device__ __forceinline__ void xcd_barrier_complete(unsigned* bar, unsigned x, unsigned& nloc, unsigned& nx) {
    const unsigned G = gridDim.x * gridDim.y * gridDim.z;
    unsigned sum, cnt, mine, sp = 0u;
    for (;;) {
        sum = 0u; cnt = 0u; mine = 0u;
#pragma unroll
        for (unsigned j = 0; j < 16; ++j) { const unsigned c = xb_ld(&bar[XB_XCNT(j)]); sum += c; cnt += (c > 0u) ? 1u : 0u; mine = (j == x) ? c : mine; }
        if (sum == G) break;
        __builtin_amdgcn_s_sleep(1);
        if ((++sp & 255u) == 0u) { if (xb_ld(&bar[XB_TMO])) break; if (sp > XB_SPIN_CAP) { atomicAdd(&bar[XB_TMO], 1u); break; } }
    }
    nloc = mine > 0u ? mine : 1u; nx = cnt > 0u ? cnt : 1u;
}
__device__ __forceinline__ void xcd_barrier_census(const XcdBarrier& b) {
    if (threadIdx.x == 0) { unsigned nloc, nx; xcd_barrier_complete(b.bar, b.x, nloc, nx); b.st[0] = nloc; b.st[1] = nx; }
}
__device__ __forceinline__ void xcd_barrier(const XcdBarrier& b) {
    asm volatile("s_waitcnt vmcnt(0)" ::: "memory");
    __syncthreads();
    if (threadIdx.x == 0) {
        unsigned* bar = b.bar; asm volatile("" : "+s"(bar));
        __builtin_amdgcn_s_waitcnt(0);
        unsigned nloc = b.st[0], nx = b.st[1];
        const unsigned old = xb_add(&bar[XB_XSUB(b.x)], 1u);
        const unsigned gen = old / nloc;
        if (old + 1u == (gen + 1u) * nloc) {
            __builtin_amdgcn_fence(__ATOMIC_RELEASE, "agent");
            asm volatile("s_waitcnt vmcnt(0)" ::: "memory");
            const unsigned og = xb_add(&bar[XB_TOP], 1u);
            const unsigned tg = og / nx;
            if (og + 1u == (tg + 1u) * nx) xb_add(&bar[XB_TOPGEN], 1u);
            else XB_SPIN(xb_ld(&bar[XB_TOPGEN]) == tg, bar);
            __builtin_amdgcn_fence(__ATOMIC_ACQUIRE, "agent");
            xb_add(&bar[XB_XGEN(b.x)], 1u);
            asm volatile("s_waitcnt vmcnt(0)" ::: "memory");
        } else {
            XB_SPIN(xb_ld(&bar[XB_XGEN(b.x)]) == gen, bar);
            __builtin_amdgcn_fence(__ATOMIC_ACQUIRE, "agent");
            asm volatile("s_waitcnt vmcnt(0)" ::: "memory");
        }
    }
    __syncthreads();
}

namespace pg8 {
constexpr int BM = 256, BK = 64, HALF = 128, HTB = HALF * BK * 2, STAGE_BYTES = 8 * HTB, NXCD = 8;
__device__ __forceinline__ int lds_byte(int r, int c) { const int st = (r >> 4) * 2 + (c >> 5), rr = r & 15, cc = c & 31, ob = rr * 64 + cc * 2; return st * 1024 + (ob ^ (((ob >> 9) & 1) << 5)); }
__device__ __forceinline__ void stage_rc(int b, int& R, int& C) { const int st = b / 1024, sb = b % 1024, swz = sb ^ (((sb >> 9) & 1) << 5); R = (st >> 1) * 16 + swz / 64; C = (st & 1) * 32 + (swz % 64) / 2; }
__device__ __forceinline__ int perm32(int rho) { const int n = rho >> 4, i = rho & 15; return 8 * (i >> 2) + 4 * n + (i & 3); }

struct Unit { int pm, pn, e, rb, cnt; };

__device__ __forceinline__ int xcd_remap(int L, int nwg) { const int q = nwg / NXCD, r = nwg % NXCD, xcd = L % NXCD, off = L / NXCD; return (xcd < r ? xcd * (q + 1) : r * (q + 1) + (xcd - r) * q) + off; }

template <class Epi, class Sched, bool GATHER, int FP8 = 0>
__device__ __forceinline__ void gemm_phase(const int tid, LAS unsigned char* lds, LAS int* rowtab, const int lda, const int ldb, const int K, const Sched& S, const Epi& E) {
    const int wid = __builtin_amdgcn_readfirstlane(tid >> 6), lane = tid & 63, wr = wid >> 2, wc = wid & 3, fr = lane & 15, fq = lane >> 4;
    int nt = K / BK;
    if (K <= 2 * BK) asm volatile("" : "+s"(nt));
    int Rr[2], Cc[2];
    constexpr int PM = (int)Epi::PERM;
    unsigned voffB[2][2];
#pragma unroll
    for (int i = 0; i < 2; ++i) { stage_rc(tid * 16 + i * 8192, Rr[i], Cc[i]);
        if constexpr (PM == 2) { const int p = perm32(Rr[i] & 31);
#pragma unroll
            for (int bj = 0; bj < 2; ++bj) voffB[bj][i] = (unsigned)((64 * (Rr[i] >> 5) + 16 * (p >> 3) + 8 * bj + (p & 7)) * ldb + Cc[i]) * 2u; }
        else { const int Rb = PM ? ((Rr[i] & ~31) + perm32(Rr[i] & 31)) : Rr[i]; voffB[0][i] = voffB[1][i] = (unsigned)(Rb * ldb + Cc[i]) * 2u; } }
    const size_t kstep = (size_t)(BK * 2);
    const size_t hstepA = GATHER ? 0 : (size_t)HALF * lda * 2, hstepB = PM == 2 ? 0 : (size_t)HALF * ldb * 2;
    const unsigned ldsw = (unsigned)wid * 1024u;
    const int aoff = lds_byte(wr * 64 + fr, fq * 8), boff = lds_byte(wc * 32 + fr, fq * 8);
#define PG8_SA(b, h) (((b) * 2 + (h)) * HTB)
#define PG8_SB(b, h) ((4 + (b) * 2 + (h)) * HTB)
#define PG8_STAGE(bufoff, gbase, voff) do { _Pragma("unroll") for (int _i = 0; _i < 2; ++_i) \
        __builtin_amdgcn_global_load_lds((const unsigned*)((const char*)(gbase) + (voff)[_i]), (LAS unsigned*)(lds + (bufoff) + ldsw + _i * 8192), 16, 0, 0); } while (0)
#define PG8_LDA(dst, b, h) do { _Pragma("unroll") for (int m = 0; m < 4; ++m) _Pragma("unroll") for (int k = 0; k < 2; ++k) dst[m][k] = *(const LAS bf16x8*)(lds + PG8_SA(b, h) + aoff + m * 2048 + k * 1024); } while (0)
#define PG8_LDB(dst, b, h) do { _Pragma("unroll") for (int n = 0; n < 2; ++n) _Pragma("unroll") for (int k = 0; k < 2; ++k) dst[n][k] = *(const LAS bf16x8*)(lds + PG8_SB(b, h) + boff + n * 2048 + k * 1024); } while (0)
#define PG8_MMA(ai, bj, At, Bt) do { __builtin_amdgcn_s_setprio(1); _Pragma("unroll") for (int m = 0; m < 4; ++m) _Pragma("unroll") for (int n = 0; n < 2; ++n) { \
        if constexpr (FP8) { const v8i bv_ = __builtin_shufflevector(__builtin_bit_cast(v4i, Bt[n][0]), __builtin_bit_cast(v4i, Bt[n][1]), 0, 1, 2, 3, 4, 5, 6, 7); \
                             const v8i av_ = __builtin_shufflevector(__builtin_bit_cast(v4i, At[m][0]), __builtin_bit_cast(v4i, At[m][1]), 0, 1, 2, 3, 4, 5, 6, 7); \
                             if constexpr (FP8 == 2) acc[ai][bj][m][n] = __builtin_amdgcn_mfma_scale_f32_16x16x128_f8f6f4(bv_, av_, acc[ai][bj][m][n], 2, 2, 0, bv_[6], 0, av_[6]); \
                             else acc[ai][bj][m][n] = __builtin_amdgcn_mfma_scale_f32_16x16x128_f8f6f4(bv_, av_, acc[ai][bj][m][n], 0, 0, 0, scale_w, 0, scale_x); } \
        else { _Pragma("unroll") for (int k = 0; k < 2; ++k) acc[ai][bj][m][n] = __builtin_amdgcn_mfma_f32_16x16x32_bf16(Bt[n][k], At[m][k], acc[ai][bj][m][n], 0, 0, 0); } } \
        __builtin_amdgcn_s_setprio(0); } while (0)
#define PG8_WAIT_V(n) asm volatile("s_waitcnt vmcnt(" #n ")" ::: "memory")
#define PG8_WAIT_L(n) asm volatile("s_waitcnt lgkmcnt(" #n ")" ::: "memory")
#define PG8_BAR __builtin_amdgcn_s_barrier()
#define PG8_SCHED __builtin_amdgcn_sched_barrier(0)
    Unit cur, nxt; int ui = 0;
    if (!S.next(0, cur)) return;
    int scale_w = 0x7A7A7A7A, scale_x = 0x7F7F7F7F; asm volatile("" : "+v"(scale_w), "+v"(scale_x));
    unsigned vA[2][2];
    constexpr int NTAB = Sched::NTAB;
    if constexpr (NTAB > 0) {
        if (tid < 256) {
#pragma unroll
            for (int sl = 0; sl < 3; ++sl) if (NTAB & (1 << sl)) rowtab[sl * 256 + tid] = (int)*S.tab_src(cur, sl, tid);
        }
        LDS_WAIT(); __syncthreads();
    }
    if constexpr (GATHER) {
#pragma unroll
        for (int h = 0; h < 2; ++h)
#pragma unroll
            for (int i = 0; i < 2; ++i) vA[h][i] = (unsigned)(S.a_rowidx(cur, rowtab, h * 128 + Rr[i]) * lda + Cc[i]) * 2u;
    } else {
#pragma unroll
        for (int h = 0; h < 2; ++h)
#pragma unroll
            for (int i = 0; i < 2; ++i) vA[h][i] = (unsigned)(Rr[i] * lda + Cc[i]) * 2u;
    }
    bf16x8 At[4][2], B0[2][2], B1[2][2];
    const char* cA = S.a_base(cur); const char* cB = S.b_base(cur);
    PG8_STAGE(PG8_SB(0, 0), cB, voffB[0]); PG8_STAGE(PG8_SB(0, 1), cB + hstepB, voffB[1]); PG8_STAGE(PG8_SA(0, 0), cA, vA[0]); PG8_STAGE(PG8_SA(0, 1), cA + hstepA, vA[1]);
    if (wr == 1) PG8_BAR;
    PG8_WAIT_V(2); PG8_BAR;
    PG8_STAGE(PG8_SB(1, 0), cB + kstep, voffB[0]); PG8_STAGE(PG8_SA(1, 0), cA + kstep, vA[0]); PG8_STAGE(PG8_SB(1, 1), cB + hstepB + kstep, voffB[1]);
    PG8_WAIT_V(6); PG8_BAR;
    for (;;) {
        f32x4 acc[2][2][4][2];
#pragma unroll
        for (int a = 0; a < 2; ++a)
#pragma unroll
            for (int b = 0; b < 2; ++b)
#pragma unroll
                for (int m = 0; m < 4; ++m)
#pragma unroll
                    for (int n = 0; n < 2; ++n) acc[a][b][m][n] = (f32x4){0.f, 0.f, 0.f, 0.f};
        const bool has_next = S.next(ui + 1, nxt);
        const char* nA = has_next ? S.a_base(nxt) : cA; const char* nB = has_next ? S.b_base(nxt) : cB;
        if constexpr (NTAB > 0) {
            if (has_next && tid < 256) {
#pragma unroll
                for (int sl = 0; sl < 3; ++sl) if (NTAB & (1 << sl))
                    __builtin_amdgcn_global_load_lds(S.tab_src(nxt, sl, tid), (LAS unsigned*)((LAS unsigned char*)rowtab + (((ui + 1) % 3) * 3072) + sl * 1024 + wid * 256), 4, 0, 0);
            }
        }
#pragma nounroll
        for (int t = 0; t < nt; t += 2) {
            const bool last = (t == nt - 2);
            if constexpr (PM == 2) asm volatile("" : "+v"(voffB[1][0]), "+v"(voffB[1][1])); else { voffB[1][0] = voffB[0][0]; voffB[1][1] = voffB[0][1]; }
            asm volatile("" : "+v"(vA[0][0]), "+v"(vA[0][1]), "+v"(vA[1][0]), "+v"(vA[1][1]), "+v"(voffB[0][0]), "+v"(voffB[0][1]));
            const char* a1 = cA + (size_t)(t + 1) * kstep;
            const char* a2 = last ? nA : cA + (size_t)(t + 2) * kstep; const char* b2 = last ? nB : cB + (size_t)(t + 2) * kstep;
            const char* a3 = a2 + kstep; const char* b3 = b2 + kstep;
            PG8_LDB(B0, 0, 0); PG8_LDB(B1, 0, 1); PG8_SCHED; PG8_LDA(At, 0, 0); PG8_STAGE(PG8_SA(1, 1), a1 + hstepA, vA[1]);
            if constexpr (GATHER) {
                if (last && has_next) {
                    LAS int* rt = rowtab + ((ui + 1) % 3) * 768;
#pragma unroll
                    for (int h = 0; h < 2; ++h)
#pragma unroll
                        for (int i = 0; i < 2; ++i) vA[h][i] = (unsigned)(S.a_rowidx(nxt, rt, h * 128 + Rr[i]) * lda + Cc[i]) * 2u;
                }
            }
            PG8_WAIT_V(8); PG8_WAIT_L(0); PG8_BAR; PG8_MMA(0, 0, At, B0); PG8_MMA(0, 1, At, B1); PG8_BAR; PG8_SCHED;
            PG8_LDA(At, 0, 1); PG8_STAGE(PG8_SB(0, 0), b2, voffB[0]); PG8_STAGE(PG8_SB(0, 1), b2 + hstepB, voffB[1]); PG8_STAGE(PG8_SA(0, 0), a2, vA[0]);
            PG8_WAIT_V(8); PG8_WAIT_L(0); PG8_BAR; PG8_MMA(1, 0, At, B0); PG8_MMA(1, 1, At, B1); PG8_BAR; PG8_SCHED;
            PG8_LDB(B0, 1, 0); PG8_LDB(B1, 1, 1); PG8_SCHED; PG8_LDA(At, 1, 0); PG8_STAGE(PG8_SA(0, 1), a2 + hstepA, vA[1]);
            PG8_WAIT_V(8); PG8_WAIT_L(0); PG8_BAR; PG8_MMA(0, 0, At, B0); PG8_MMA(0, 1, At, B1); PG8_BAR; PG8_SCHED;
            PG8_LDA(At, 1, 1); PG8_STAGE(PG8_SB(1, 0), b3, voffB[0]); PG8_STAGE(PG8_SB(1, 1), b3 + hstepB, voffB[1]); PG8_STAGE(PG8_SA(1, 0), a3, vA[0]);
            PG8_WAIT_V(8); PG8_WAIT_L(0); PG8_BAR; PG8_MMA(1, 0, At, B0); PG8_MMA(1, 1, At, B1); PG8_BAR; PG8_SCHED;
        }
        if (wr == 0) PG8_BAR;
        { int fr_ = fr, fq_ = fq; asm volatile("" : "+v"(fr_), "+v"(fq_));
          E(acc, cur, wr, wc, fr_, fq_, rowtab + (ui % 3) * 768); }
        if (!has_next) break;
        cur = nxt; cA = nA; cB = nB; ++ui;
        if (wr == 1) PG8_BAR;
    }
    PG8_WAIT_V(0);
    PG8_BAR;
#undef PG8_SA
#undef PG8_SB
#undef PG8_STAGE
#undef PG8_LDA
#undef PG8_LDB
#undef PG8_MMA
#undef PG8_WAIT_V
#undef PG8_WAIT_L
#undef PG8_BAR
#undef PG8_SCHED
}

struct StaticSched {
    const char* A; const char* B; size_t atile, btile; int nM, nN, nwg, G, c;
    size_t acol; int skipctx;
    __device__ __forceinline__ bool next(int i, Unit& u) const {
        const int L = i * G + c; if (L >= nwg) return false;
        const int wgid = xcd_remap(L, nwg);
        constexpr int WGM = 8;
        const int nig = WGM * nN, gid = wgid / nig, fm = gid * WGM, gsz = (nM - fm) < WGM ? (nM - fm) : WGM;
        const int pm0 = fm + ((wgid % nig) % gsz); u.pm = pm0 + skipctx * ((pm0 >> 4) + 1); u.pn = (wgid % nig) / gsz; u.e = 0; u.rb = 0; u.cnt = 0; return true;
    }
    __device__ __forceinline__ const char* a_base(const Unit& u) const { return A + (size_t)u.pm * atile + (size_t)u.pn * acol; }
    __device__ __forceinline__ const char* b_base(const Unit& u) const { return B + (size_t)u.pn * btile; }
    static constexpr int NTAB = 0;
    __device__ __forceinline__ const unsigned* tab_src(const Unit&, int, int) const { return nullptr; }
    __device__ __forceinline__ int a_rowidx(const Unit&, const LAS int*, int) const { return 0; }
};
struct StaticSchedG : StaticSched {
    __device__ __forceinline__ const char* a_base(const Unit& u) const { return A + (size_t)u.pn * acol; }
    __device__ __forceinline__ int a_rowidx(const Unit& u, const LAS int*, int rl) const { return u.pm * 256 + rl; }
};

template <int KIND>
struct MoeSched {
    static constexpr int NTAB = KIND == 1 ? 0x5 : 0x7;
    const char* A; const char* B; size_t atile, btile, bexp; const int* list; const float* glist; const float* bias; int NPN, U, G, c; int pbl, cntl;
    __device__ __forceinline__ bool next(int i, Unit& u) const {
        const int L = i * G + c; if (L >= U) return false;
        const int idx = xcd_remap(L, U);
        const int rbg = idx / NPN; u.pn = idx % NPN; u.pm = rbg;
        const unsigned long long m = __ballot(pbl <= rbg);
        const int e = __builtin_popcount((unsigned)(m & 0xffffffffull)) - 1;
        u.e = e; u.rb = rbg - __builtin_amdgcn_readlane(pbl, e); u.cnt = __builtin_amdgcn_readlane(cntl, e); return true;
    }
    __device__ __forceinline__ const char* a_base(const Unit& u) const { return A; }
    __device__ __forceinline__ int a_rowidx(const Unit& u, const LAS int* tab, int rl) const { return KIND == 1 ? (tab[rl] >> 2) : u.pm * 256 + rl; }
    __device__ __forceinline__ const char* b_base(const Unit& u) const { return B + (size_t)u.e * bexp + (size_t)u.pn * btile; }
    __device__ __forceinline__ const unsigned* tab_src(const Unit& u, int sl, int t) const {
        if (sl == 2) { const int col = KIND == 1 ? ((t >> 7) * DFF + u.pn * 128 + (t & 127)) : (u.pn * 256 + t); return (const unsigned*)(bias + (size_t)u.e * (KIND == 1 ? 2 * DFF : DM) + col); }
        int idx = u.rb * 256 + t; idx = idx < u.cnt ? idx : u.cnt - 1;
        return (sl == 0 ? (const unsigned*)list : (const unsigned*)glist) + (size_t)u.e * NR + idx;
    }
};
}

namespace att {
constexpr int D = 128, NW = 8, QBLK = 32, KVBLK = 64;
constexpr float SCALE = 0.088388347648318440f;
constexpr float THR = 8.f;
constexpr int LDQ = 1024, LDK = 256, LDO = 1024;
constexpr int V8T_TILE_ = 128 * 64;
#ifndef ATT_NS
#define ATT_NS 6
#endif
constexpr int NS = ATT_NS, SLOT = 16384;
#ifndef ATT_SDEPTH
#define ATT_SDEPTH 1
#endif
constexpr int SDEPTH = ATT_SDEPTH;
constexpr size_t SHM_V = KVBLK * D * 2, SHM_K = KVBLK * D * 2, SHM_ATTN = 2 * SHM_V + 2 * SHM_K + NW * 64 * 4;
#define KSWZ(row, colB) ((row) * 256 + ((colB) ^ (((row) & 7) << 4)))
#define SBAR() __builtin_amdgcn_sched_barrier(0)
__device__ __forceinline__ int crow(int r, int hi) { return (r & 3) + 8 * (r >> 2) + 4 * hi; }
__device__ __forceinline__ unsigned cvtpk(float lo, float hi) { unsigned r; asm volatile("v_cvt_pk_bf16_f32 %0, %1, %2" : "=v"(r) : "v"(lo), "v"(hi)); return r; }
__device__ __forceinline__ bf16x8 ld8(const bf16* p) { return *reinterpret_cast<const bf16x8*>(p); }
__device__ __forceinline__ void partialSM(f32x16& p0, f32x16& p1, float& m_reg, float& mn, float& alpha) {
  constexpr float C = SCALE * 1.4426950408889634f;
  float pmax = p0[0]; for (int r = 1; r < 16; ++r) pmax = fmaxf(pmax, p0[r]); for (int r = 0; r < 16; ++r) pmax = fmaxf(pmax, p1[r]);
  { auto rr = __builtin_amdgcn_permlane32_swap(__float_as_uint(pmax), __float_as_uint(pmax), false, false);
    pmax = fmaxf(__uint_as_float(rr[0]), __uint_as_float(rr[1])); }
  if (__builtin_expect(__all(pmax - m_reg <= THR / SCALE), 1)) { mn = m_reg; alpha = 1.f; }
  else { mn = fmaxf(m_reg, pmax); alpha = __builtin_amdgcn_exp2f((m_reg - mn) * C); m_reg = mn; }
  float mnC = -mn * C;
  for (int r = 0; r < 16; ++r) p0[r] = fmaf(p0[r], C, mnC); for (int r = 0; r < 16; ++r) p1[r] = fmaf(p1[r], C, mnC);
  for (int r = 0; r < 16; ++r) p0[r] = __builtin_amdgcn_exp2f(p0[r]);
}
__device__ __forceinline__ void partialSMb(f32x16& p0, f32x16& p1) {
  for (int r = 0; r < 16; ++r) p0[r] = __builtin_amdgcn_exp2f(p0[r]);
}
__device__ __forceinline__ void finishSMb(f32x16& p0, f32x16& p1, float& l_part, bf16x8& pa0, bf16x8& pa1, bf16x8& pa2, bf16x8& pa3) {
  for (int r = 0; r < 16; ++r) p1[r] = __builtin_amdgcn_exp2f(p1[r]);
  float ps = 0; for (int r = 0; r < 16; ++r) ps += p0[r]; for (int r = 0; r < 16; ++r) ps += p1[r];
  l_part += ps;
#define PK4(P, BASE, OUT) do { unsigned a0 = cvtpk(P[BASE + 0], P[BASE + 1]), a1 = cvtpk(P[BASE + 2], P[BASE + 3]);   \
    unsigned b0 = cvtpk(P[BASE + 4], P[BASE + 5]), b1 = cvtpk(P[BASE + 6], P[BASE + 7]);                              \
    auto r0 = __builtin_amdgcn_permlane32_swap(a0, b0, false, false); auto r1 = __builtin_amdgcn_permlane32_swap(a1, b1, false, false); \
    u32x4 w = {r0[0], r1[0], r0[1], r1[1]}; OUT = *reinterpret_cast<bf16x8*>(&w); } while (0)
  PK4(p0, 0, pa0); PK4(p0, 8, pa1); PK4(p1, 0, pa2); PK4(p1, 8, pa3);
#undef PK4
}
typedef short v2s16 __attribute__((ext_vector_type(2)));
__device__ __forceinline__ int cvt_pk4_fp8_sc(float a, float b, float c, float d, float sc) {
  v2s16 w = {0, 0};
  w = __builtin_amdgcn_cvt_scalef32_pk_fp8_f32(w, a, b, sc, false);
  w = __builtin_amdgcn_cvt_scalef32_pk_fp8_f32(w, c, d, sc, true);
  return __builtin_bit_cast(int, w);
}
__device__ __forceinline__ void exp32(f32x16& p0, f32x16& p1) {
  for (int r = 0; r < 16; ++r) p0[r] = __builtin_amdgcn_exp2f(p0[r]);
  for (int r = 0; r < 16; ++r) p1[r] = __builtin_amdgcn_exp2f(p1[r]);
}
__device__ __forceinline__ void finishSM8(const f32x16& p0, const f32x16& p1, float& l_part, v8i& pf, int& E) {
  float ps = 0; for (int r = 0; r < 16; ++r) ps += p0[r]; for (int r = 0; r < 16; ++r) ps += p1[r];
  l_part += ps;
  float pm = fmaxf(p0[0], p1[0]);
  for (int r = 1; r < 16; ++r) pm = fmaxf(fmaxf(pm, p0[r]), p1[r]);
  int e = (int)(__float_as_uint(pm) >> 23) - 7; e = e < 1 ? 1 : e;
  E = e;
  const float sc = __uint_as_float((unsigned)e << 23);
  pf = (v8i){cvt_pk4_fp8_sc(p0[0], p0[1], p0[2], p0[3], sc), cvt_pk4_fp8_sc(p0[4], p0[5], p0[6], p0[7], sc), cvt_pk4_fp8_sc(p0[8], p0[9], p0[10], p0[11], sc), cvt_pk4_fp8_sc(p0[12], p0[13], p0[14], p0[15], sc),
             cvt_pk4_fp8_sc(p1[0], p1[1], p1[2], p1[3], sc), cvt_pk4_fp8_sc(p1[4], p1[5], p1[6], p1[7], sc), cvt_pk4_fp8_sc(p1[8], p1[9], p1[10], p1[11], sc), cvt_pk4_fp8_sc(p1[12], p1[13], p1[14], p1[15], sc)};
}
__device__ __forceinline__ void pv8(f32x16* o, const char* Vs, v8i pf, int E, int r32, int hi) {
  int s1 = 0x7F7F7F7F; asm volatile("" : "+v"(s1));
  const int f = (r32 >> 2) & 3;
  const char* vrow = Vs + r32 * 64;
#pragma unroll
  for (int d0 = 0; d0 < 4; ++d0) {
    const v4i v0 = *reinterpret_cast<const v4i*>(vrow + d0 * 2048 + (((2 * hi) ^ f) << 4)), v1 = *reinterpret_cast<const v4i*>(vrow + d0 * 2048 + (((2 * hi + 1) ^ f) << 4));
    o[d0] = __builtin_amdgcn_mfma_scale_f32_32x32x64_f8f6f4(pf, __builtin_shufflevector(v0, v1, 0, 1, 2, 3, 4, 5, 6, 7), o[d0], 0, 0, 0, E, 0, s1);
  }
}
__device__ __forceinline__ void finishSM(f32x16& p0, f32x16& p1, float alpha, float& l_reg, bf16x8& pa0, bf16x8& pa1, bf16x8& pa2, bf16x8& pa3) {
  for (int r = 0; r < 16; ++r) p1[r] = __builtin_amdgcn_exp2f(p1[r]);
  float ps = 0; for (int r = 0; r < 16; ++r) ps += p0[r]; for (int r = 0; r < 16; ++r) ps += p1[r];
  { auto rr = __builtin_amdgcn_permlane32_swap(__float_as_uint(ps), __float_as_uint(ps), false, false);
    ps = __uint_as_float(rr[0]) + __uint_as_float(rr[1]); }
  l_reg = l_reg * alpha + ps;
#define PK4(P, BASE, OUT) do { unsigned a0 = cvtpk(P[BASE + 0], P[BASE + 1]), a1 = cvtpk(P[BASE + 2], P[BASE + 3]);   \
    unsigned b0 = cvtpk(P[BASE + 4], P[BASE + 5]), b1 = cvtpk(P[BASE + 6], P[BASE + 7]);                              \
    auto r0 = __builtin_amdgcn_permlane32_swap(a0, b0, false, false); auto r1 = __builtin_amdgcn_permlane32_swap(a1, b1, false, false); \
    u32x4 w = {r0[0], r1[0], r0[1], r1[1]}; OUT = *reinterpret_cast<bf16x8*>(&w); } while (0)
  PK4(p0, 0, pa0); PK4(p0, 8, pa1); PK4(p1, 0, pa2); PK4(p1, 8, pa3);
#undef PK4
}
__device__ __forceinline__ void qkt(f32x16& p0, f32x16& p1, const char* Ks, const v8i* qf, int r32, int hi) {
  int sc = 0x7F7F7F7F; asm volatile("" : "+v"(sc));
  p0 = f32x16{}; p1 = f32x16{};
#pragma unroll
  for (int st = 0; st < 2; ++st) {
    const int ua = 4 * hi + 2 * st, f0 = (r32 >> 1) & 7;
    const v4i a0 = *reinterpret_cast<const v4i*>(Ks + r32 * 128 + ((ua ^ f0) << 4)), a1 = *reinterpret_cast<const v4i*>(Ks + r32 * 128 + (((ua + 1) ^ f0) << 4));
    const v4i b0 = *reinterpret_cast<const v4i*>(Ks + (32 + r32) * 128 + ((ua ^ f0) << 4)), b1 = *reinterpret_cast<const v4i*>(Ks + (32 + r32) * 128 + (((ua + 1) ^ f0) << 4));
    p0 = __builtin_amdgcn_mfma_scale_f32_32x32x64_f8f6f4(__builtin_shufflevector(a0, a1, 0, 1, 2, 3, 4, 5, 6, 7), qf[st], p0, 0, 0, 0, sc, 0, sc);
    p1 = __builtin_amdgcn_mfma_scale_f32_32x32x64_f8f6f4(__builtin_shufflevector(b0, b1, 0, 1, 2, 3, 4, 5, 6, 7), qf[st], p1, 0, 0, 0, sc, 0, sc);
  }
}
__device__ __forceinline__ int v_st(int k, int c) { const int kk = (k & ~0xC) | ((k & 4) << 1) | ((k & 8) >> 1); return ((kk >> 3) * 4 + (c >> 5)) * 512 + ((kk & 7) * 32 + (c & 31)) * 2; }
__device__ __forceinline__ int v_rd_base(int lane) { return ((lane & 3) << 3) | (((lane >> 2) & 3) << 6) | (((lane >> 4) & 1) << 5) | (((lane >> 5) & 1) << 8); }
constexpr int v_rd_off(int d0, int ks, int half) { return d0 * 512 + ks * 4096 + half * 2048; }
template <int OFF> __device__ __forceinline__ s16x4 tr_read(int vb) {
  s16x4 r; asm volatile("ds_read_b64_tr_b16 %0, %1 offset:%2" : "=&v"(r) : "v"(vb), "i"(OFF) : "memory"); return r;
}
template <int D0> __device__ __forceinline__ void pv_one(f32x16& od, int vb, bf16x8 pa0, bf16x8 pa1, bf16x8 pa2, bf16x8 pa3) {
  const s16x4 l0 = tr_read<v_rd_off(D0, 0, 0)>(vb), h0 = tr_read<v_rd_off(D0, 0, 1)>(vb), l1 = tr_read<v_rd_off(D0, 1, 0)>(vb), h1 = tr_read<v_rd_off(D0, 1, 1)>(vb);
  const s16x4 l2 = tr_read<v_rd_off(D0, 2, 0)>(vb), h2 = tr_read<v_rd_off(D0, 2, 1)>(vb), l3 = tr_read<v_rd_off(D0, 3, 0)>(vb), h3 = tr_read<v_rd_off(D0, 3, 1)>(vb);
  asm volatile("s_waitcnt lgkmcnt(0)" ::: "memory"); SBAR();
#define PK(L, H) (bf16x8){L[0], L[1], L[2], L[3], H[0], H[1], H[2], H[3]}
  od = __builtin_amdgcn_mfma_f32_32x32x16_bf16(pa0, PK(l0, h0), od, 0, 0, 0);
  od = __builtin_amdgcn_mfma_f32_32x32x16_bf16(pa1, PK(l1, h1), od, 0, 0, 0);
  od = __builtin_amdgcn_mfma_f32_32x32x16_bf16(pa2, PK(l2, h2), od, 0, 0, 0);
  od = __builtin_amdgcn_mfma_f32_32x32x16_bf16(pa3, PK(l3, h3), od, 0, 0, 0);
#undef PK
}
__device__ __forceinline__ void pv_d0(f32x16* o, int vb, bf16x8 pa0, bf16x8 pa1, bf16x8 pa2, bf16x8 pa3) {
  pv_one<0>(o[0], vb, pa0, pa1, pa2, pa3); pv_one<1>(o[1], vb, pa0, pa1, pa2, pa3); pv_one<2>(o[2], vb, pa0, pa1, pa2, pa3); pv_one<3>(o[3], vb, pa0, pa1, pa2, pa3);
}
#define MFMA8(A, B, C, SA, SB) __builtin_amdgcn_mfma_scale_f32_32x32x64_f8f6f4(A, B, C, 0, 0, 0, SA, 0, SB)
#define CAT8(x, y) __builtin_shufflevector(x, y, 0, 1, 2, 3, 4, 5, 6, 7)
template <bool QK, bool PV>
__device__ __forceinline__ void att_step(f32x16& c0, f32x16& c1, const f32x16& q0, const f32x16& q1, f32x16* o, const v8i* qf, const char* Ks, const char* Vs, int r32, int hi, float& l_part) {
  int one = 0x7F7F7F7F; asm volatile("" : "+v"(one));
  const int f0 = (r32 >> 1) & 7, f = (r32 >> 2) & 3;
  const char* kr = Ks + r32 * 128; const char* vr = Vs + r32 * 64;
  v4i ka[4], kb[4];
  if (QK) {
#pragma unroll
    for (int u = 0; u < 4; ++u) { ka[u] = *reinterpret_cast<const v4i*>(kr + (((4 * hi + u) ^ f0) << 4)); kb[u] = *reinterpret_cast<const v4i*>(kr + 4096 + (((4 * hi + u) ^ f0) << 4)); }
  }
  SBAR();
  float ps = 0.f, pm = 0.f; v8i pf; int E = 0; float scf = 0.f;
  if (QK) { c0 = MFMA8(CAT8(ka[0], ka[1]), qf[0], f32x16{}, one, one); SBAR(); }
  if (PV) {
#pragma unroll
    for (int r = 0; r < 16; ++r) ps += q0[r];
    pm = fmaxf(q0[0], q0[1]);
#pragma unroll
    for (int r = 2; r < 16; r += 2) pm = fmaxf(fmaxf(pm, q0[r]), q0[r + 1]);
    SBAR();
  }
  if (QK) { c1 = MFMA8(CAT8(kb[0], kb[1]), qf[0], f32x16{}, one, one); SBAR(); }
  if (PV) {
#pragma unroll
    for (int r = 0; r < 16; ++r) ps += q1[r];
#pragma unroll
    for (int r = 0; r < 16; r += 2) pm = fmaxf(fmaxf(pm, q1[r]), q1[r + 1]);
    l_part += ps;
    int e = (int)(__float_as_uint(pm) >> 23) - 7; e = e < 1 ? 1 : e;
    E = e; scf = __uint_as_float((unsigned)e << 23);
    SBAR();
  }
  if (QK) { c0 = MFMA8(CAT8(ka[2], ka[3]), qf[1], c0, one, one); SBAR(); }
  v4i va[4], vb[4];
  if (PV) {
#pragma unroll
    for (int d0 = 0; d0 < 4; ++d0) { va[d0] = *reinterpret_cast<const v4i*>(vr + d0 * 2048 + (((2 * hi) ^ f) << 4)); vb[d0] = *reinterpret_cast<const v4i*>(vr + d0 * 2048 + (((2 * hi + 1) ^ f) << 4)); }
    pf[0] = cvt_pk4_fp8_sc(q0[0], q0[1], q0[2], q0[3], scf); pf[1] = cvt_pk4_fp8_sc(q0[4], q0[5], q0[6], q0[7], scf);
    pf[2] = cvt_pk4_fp8_sc(q0[8], q0[9], q0[10], q0[11], scf); pf[3] = cvt_pk4_fp8_sc(q0[12], q0[13], q0[14], q0[15], scf);
    SBAR();
  }
  if (QK) { c1 = MFMA8(CAT8(kb[2], kb[3]), qf[1], c1, one, one); SBAR(); }
  if (PV) {
    pf[4] = cvt_pk4_fp8_sc(q1[0], q1[1], q1[2], q1[3], scf); pf[5] = cvt_pk4_fp8_sc(q1[4], q1[5], q1[6], q1[7], scf);
    pf[6] = cvt_pk4_fp8_sc(q1[8], q1[9], q1[10], q1[11], scf); pf[7] = cvt_pk4_fp8_sc(q1[12], q1[13], q1[14], q1[15], scf);
    SBAR();
    o[0] = MFMA8(pf, CAT8(va[0], vb[0]), o[0], E, one); SBAR();
  }
  if (QK) {
#pragma unroll
    for (int r = 0; r < 8; ++r) c0[r] = __builtin_amdgcn_exp2f(c0[r]);
    SBAR();
  }
  if (PV) { o[1] = MFMA8(pf, CAT8(va[1], vb[1]), o[1], E, one); SBAR(); }
  if (QK) {
#pragma unroll
    for (int r = 8; r < 16; ++r) c0[r] = __builtin_amdgcn_exp2f(c0[r]);
    SBAR();
  }
  if (PV) { o[2] = MFMA8(pf, CAT8(va[2], vb[2]), o[2], E, one); SBAR(); }
  if (QK) {
#pragma unroll
    for (int r = 0; r < 8; ++r) c1[r] = __builtin_amdgcn_exp2f(c1[r]);
    SBAR();
  }
  if (PV) { o[3] = MFMA8(pf, CAT8(va[3], vb[3]), o[3], E, one); SBAR(); }
  if (QK) {
#pragma unroll
    for (int r = 8; r < 16; ++r) c1[r] = __builtin_amdgcn_exp2f(c1[r]);
    SBAR();
  }
}
constexpr size_t SHM_RING = (size_t)NS * SLOT, SHM_ATTN3 = SHM_RING + NW * 64 * 4;
__device__ __forceinline__ void attn_dense_body(const int tid, const bf16* __restrict__ Qb, const unsigned char* __restrict__ Kh, const unsigned char* __restrict__ Vh, unsigned char* __restrict__ Ob, int seq, char* lds,
                                                const float* __restrict__ q_g, const f32x2* __restrict__ rope, int t0, float mnC) {
  const int wid = __builtin_amdgcn_readfirstlane(tid >> 6), lane = tid & 63, r32 = lane & 31, hi = lane >> 5;
  float* ws = (float*)(lds + SHM_RING) + wid * 64; float* li_l = ws; float* al_l = ws + 32;
  float l_reg = 0; bf16x8 qr[8]; v8i qf[2];
  const bf16* Qw = Qb + (long)(wid * QBLK + r32) * LDQ + hi * 8;
#pragma unroll
  for (int d0 = 0; d0 < 8; ++d0) qr[d0] = ld8(Qw + d0 * 16);
  unsigned koff, voff;
  { int l_ = lane; asm volatile("" : "+v"(l_)); const int pk_ = wid * 64 + l_, key_ = pk_ >> 3;
    koff = (unsigned)(key_ * 256 + (((pk_ & 7) ^ ((key_ >> 1) & 7)) << 4)); voff = (unsigned)(wid * 1024 + l_ * 16); }
#define DMA_TILE(tile, slot) do { const int tl_ = (tile); \
    __builtin_amdgcn_global_load_lds((const unsigned*)(Kh + (size_t)tl_ * (64 * 256) + koff), (LAS unsigned*)(uintptr_t)(unsigned)((uintptr_t)lds + (slot) * SLOT + wid * 1024), 16, 0, 0); \
    __builtin_amdgcn_global_load_lds((const unsigned*)(Vh + (size_t)tl_ * 8192 + voff), (LAS unsigned*)(uintptr_t)(unsigned)((uintptr_t)lds + (slot) * SLOT + 8192 + wid * 1024), 16, 0, 0); } while (0)
#pragma unroll
  for (int i = 0; i < NS - 2; ++i) DMA_TILE(i, i);
  {
    float ss = 0.f;
#pragma unroll
    for (int d0 = 0; d0 < 8; ++d0)
#pragma unroll
      for (int j = 0; j < 8; ++j) { const float xv = __uint_as_float((unsigned)(unsigned short)qr[d0][j] << 16); ss += xv * xv; }
    ss += __shfl_xor(ss, 32);
    const float inv = rsqrtf(ss * (1.f / 128.f) + 1e-6f) * (SCALE * 1.4426950408889634f);
    const int t = t0 + wid * QBLK + r32;
#pragma unroll
    for (int ax = 0; ax < 2; ++ax) {
      float x[4][8];
#pragma unroll
      for (int dd = 0; dd < 4; ++dd) {
        const int d0 = ax * 4 + dd;
        const f32x4 g0 = *(const f32x4*)(q_g + d0 * 16 + hi * 8), g1 = *(const f32x4*)(q_g + d0 * 16 + hi * 8 + 4);
#pragma unroll
        for (int j = 0; j < 4; ++j) { x[dd][j] = __uint_as_float((unsigned)(unsigned short)qr[d0][j] << 16) * inv * g0[j]; x[dd][4 + j] = __uint_as_float((unsigned)(unsigned short)qr[d0][4 + j] << 16) * inv * g1[j]; }
      }
      if (t0 >= 0) {
        const int pos = ax == 0 ? (t >> 6) : (t & 63);
#pragma unroll
        for (int dd = 0; dd < 2; ++dd)
#pragma unroll
          for (int j = 0; j < 8; j += 2) {
            const f32x4 cs = *(const f32x4*)(rope + pos * 32 + dd * 16 + hi * 8 + j);
            const float a0 = x[dd][j], b0 = x[dd + 2][j], a1 = x[dd][j + 1], b1 = x[dd + 2][j + 1];
            x[dd][j] = a0 * cs.x - b0 * cs.y; x[dd + 2][j] = b0 * cs.x + a0 * cs.y; x[dd][j + 1] = a1 * cs.z - b1 * cs.w; x[dd + 2][j + 1] = b1 * cs.z + a1 * cs.w;
          }
      }
      qf[ax] = (v8i){(int)cvt_pk4_fp8(x[0][0], x[0][1], x[0][2], x[0][3]), (int)cvt_pk4_fp8(x[0][4], x[0][5], x[0][6], x[0][7]), (int)cvt_pk4_fp8(x[1][0], x[1][1], x[1][2], x[1][3]), (int)cvt_pk4_fp8(x[1][4], x[1][5], x[1][6], x[1][7]),
                     (int)cvt_pk4_fp8(x[2][0], x[2][1], x[2][2], x[2][3]), (int)cvt_pk4_fp8(x[2][4], x[2][5], x[2][6], x[2][7]), (int)cvt_pk4_fp8(x[3][0], x[3][1], x[3][2], x[3][3]), (int)cvt_pk4_fp8(x[3][4], x[3][5], x[3][6], x[3][7])};
    }
  }
  f32x16 pA0, pA1, pB0, pB1; const int NT = seq / KVBLK;
  int sc = 0, sp = NS - 1, sd = NS - 2;
#define STEP_HEAD(t_) do { asm volatile("s_waitcnt vmcnt(%0)\n\ts_barrier" :: "n"(2 * (NS - 3)) : "memory"); \
    { int tn_ = (t_) + NS - 2; tn_ = tn_ < NT ? tn_ : NT - 1; DMA_TILE(tn_, sd); } SBAR(); } while (0)
#define STEP_TAIL() do { sd = sp; sp = sc; sc = sc == NS - 1 ? 0 : sc + 1; } while (0)
#define PIN2(a, b) asm volatile("" : "+v"(a), "+v"(b))
#define STEP(PC0, PC1, PP0, PP1, t_) do { STEP_HEAD(t_); \
    att_step<true, true>(PC0, PC1, PP0, PP1, o, qf, lds + sc * SLOT, lds + sp * SLOT + 8192, r32, hi, l_reg); \
    PIN2(PC0, PC1); PIN2(o[0], o[1]); PIN2(o[2], o[3]); \
    STEP_TAIL(); } while (0)
  f32x16 o[4];
  STEP_HEAD(0);
  att_step<true, false>(pA0, pA1, pB0, pB1, o, qf, lds + sc * SLOT, lds, r32, hi, l_reg); PIN2(pA0, pA1);
  STEP_TAIL();
#pragma unroll
  for (int d = 0; d < 4; ++d) o[d] = f32x16{};
  for (int t = 1; t + 1 < NT; t += 2) {
    STEP(pB0, pB1, pA0, pA1, t);
    STEP(pA0, pA1, pB0, pB1, t + 1);
  }
  STEP(pB0, pB1, pA0, pA1, NT - 1);
  att_step<false, true>(pA0, pA1, pB0, pB1, o, qf, lds, lds + sp * SLOT + 8192, r32, hi, l_reg);
  asm volatile("s_waitcnt vmcnt(0)" ::: "memory");
  l_reg += __shfl_xor(l_reg, 32);
  if (hi == 0) li_l[r32] = l_reg; asm volatile("s_waitcnt lgkmcnt(0)" ::: "memory");
  float rli[16];
#pragma unroll
  for (int r = 0; r < 16; ++r) rli[r] = __builtin_amdgcn_rcpf(li_l[crow(r, hi)]);
  asm volatile("s_waitcnt lgkmcnt(0)\n\ts_barrier" ::: "memory");
  {
    int l2 = lane; asm volatile("" : "+v"(l2));
    char* stg = lds + 4 * SLOT + wid * 4096;
    char* sp_ = stg + (4 * (l2 >> 5)) * 128 + (l2 & 31);
#pragma unroll
    for (int r = 0; r < 16; r += 2) {
#pragma unroll
      for (int d0 = 0; d0 < 4; ++d0) {
        const int w = __builtin_amdgcn_cvt_pk_fp8_f32(o[d0][r] * rli[r], o[d0][r + 1] * rli[r + 1], 0, false);
        *(unsigned char*)(sp_ + crow(r, 0) * 128 + d0 * 32) = (unsigned char)w;
        *(unsigned char*)(sp_ + crow(r + 1, 0) * 128 + d0 * 32) = (unsigned char)(w >> 8);
      }
    }
    asm volatile("s_waitcnt lgkmcnt(0)" ::: "memory");
    unsigned char* Ow = Ob + (size_t)(wid * QBLK) * 1024;
#pragma unroll
    for (int i = 0; i < 4; ++i) {
      const int rowl = (l2 >> 3) + 8 * i;
      const u32x4 v = *reinterpret_cast<const u32x4*>(stg + rowl * 128 + (l2 & 7) * 16);
      *reinterpret_cast<u32x4*>(Ow + (size_t)rowl * 1024 + (l2 & 7) * 16) = v;
    }
    asm volatile("s_waitcnt lgkmcnt(0)" ::: "memory");
  }
#undef DMA_TILE
#undef STEP
#undef STEP_HEAD
#undef STEP_TAIL
#undef PIN2
}
}

struct Args { const float* in[N_IN]; float* out; unsigned char* ws; int ph_lo, ph_hi; };
typedef const Args __attribute__((address_space(4)))* KArgs;

__device__ __forceinline__ const float* mods_ptr(KArgs a, int layer, int mrow) { return (const float*)(a->ws + WS_MODS) + ((size_t)layer * 9 + mrow) * NMOD; }
__device__ __forceinline__ int mrow_of(int row) { const int b = row / SEG, s = row - b * SEG; return s < CTXL ? 8 : b; }


#ifndef MOE1_FMT
#define MOE1_FMT 2
#endif
typedef __bf16 v32bf16 __attribute__((ext_vector_type(32)));
typedef unsigned v6u32 __attribute__((ext_vector_type(6)));
typedef unsigned v16u32 __attribute__((ext_vector_type(16)));
__device__ __forceinline__ void fp6_chunk_store(const v16u32 x, unsigned char* rowp, int c) {
    float m = 0.f;
#pragma unroll
    for (int i = 0; i < 16; ++i) m = fmaxf(fmaxf(m, fabsf(__uint_as_float(x[i] << 16))), fabsf(__uint_as_float(x[i] & 0xffff0000u)));
    int E = (int)(__float_as_uint(m * 1.0666667f) >> 23) - 2; E = E < 1 ? 1 : E;
    const v6u32 r = __builtin_amdgcn_cvt_scalef32_pk32_fp6_bf16(__builtin_bit_cast(v32bf16, x), __uint_as_float((unsigned)E << 23));
    unsigned char* o = rowp + (c >> 2) * 128 + (c & 3) * 16;
    *(GAS u32x4*)o = (u32x4){r[0], r[1], r[2], r[3]};
    *(GAS u32x4*)(o + 64) = (u32x4){r[4], r[5], (unsigned)E, 0u};
}
__device__ __forceinline__ void tr_item(const float* __restrict__ W, int ldw, bf16* __restrict__ WT, int ldt, int k0, int n0, int drow0, LAS unsigned char* scr, int lane) {
    const int n4 = lane & 15, kg = lane >> 4;
    f32x4 v[4][4];
#pragma unroll
    for (int i = 0; i < 4; ++i)
#pragma unroll
        for (int kk = 0; kk < 4; ++kk) v[i][kk] = __builtin_nontemporal_load((const GAS f32x4*)(W + (size_t)(k0 + 4 * (kg + 4 * i) + kk) * ldw + n0 + 4 * n4));
#pragma unroll
    for (int i = 0; i < 4; ++i)
#pragma unroll
        for (int j = 0; j < 4; ++j) {
            u32x2 w; w.x = cvt_pk_bf16(v[i][0][j], v[i][1][j]); w.y = cvt_pk_bf16(v[i][2][j], v[i][3][j]);
            *(LAS u32x2*)(scr + ((4 * n4 + j) * 17 + (kg + 4 * i)) * 8) = w;
        }
    LDS_WAIT(); asm volatile("" ::: "memory");
#pragma unroll
    for (int q = 0; q < 16; ++q) {
        const int n = (lane >> 4) + 4 * q;
        const u32x2 w = *(const LAS u32x2*)(scr + (n * 17 + (lane & 15)) * 8);
        __builtin_nontemporal_store(w, (GAS u32x2*)(WT + (size_t)(drow0 + n) * ldt + k0 + 4 * (lane & 15)));
    }
    LDS_WAIT(); asm volatile("" ::: "memory");
}
__device__ __forceinline__ void tr_item8(const float* __restrict__ W, int ldw, unsigned char* __restrict__ WT, int ldt, int k0, int n0, int drow0, LAS unsigned char* scr, int lane, float scale) {
    const int n4 = lane & 15, kg = lane >> 4;
#pragma unroll
    for (int hf = 0; hf < 2; ++hf) {
        f32x4 v[4][4];
#pragma unroll
        for (int i = 0; i < 4; ++i)
#pragma unroll
            for (int kk = 0; kk < 4; ++kk) v[i][kk] = __builtin_nontemporal_load((const GAS f32x4*)(W + (size_t)(k0 + 64 * hf + 4 * (kg + 4 * i) + kk) * ldw + n0 + 4 * n4));
#pragma unroll
        for (int i = 0; i < 4; ++i)
#pragma unroll
            for (int j = 0; j < 4; ++j)
                *(LAS unsigned*)(scr + (4 * n4 + j) * 136 + 64 * hf + 4 * (kg + 4 * i)) = cvt_pk4_fp8(v[i][0][j] * scale, v[i][1][j] * scale, v[i][2][j] * scale, v[i][3][j] * scale);
    }
    LDS_WAIT(); asm volatile("" ::: "memory");
#pragma unroll
    for (int q = 0; q < 16; ++q) {
        const int n = (lane >> 4) + 4 * q;
        const u32x2 w = *(const LAS u32x2*)(scr + n * 136 + 8 * (lane & 15));
        __builtin_nontemporal_store(w, (GAS u32x2*)(WT + (size_t)(drow0 + n) * ldt + k0 + 8 * (lane & 15)));
    }
    LDS_WAIT(); asm volatile("" ::: "memory");
}
__device__ __forceinline__ void tr_item6(const float* __restrict__ W, int ldw, unsigned char* __restrict__ WT, int k0, int n0, int drow0, LAS unsigned char* scr, int lane) {
    const int n4 = lane & 15, kg = lane >> 4;
    v6u32 rr[4]; unsigned ee[4];
#pragma unroll
    for (int hf = 0; hf < 2; ++hf) {
        f32x4 v[4][4];
#pragma unroll
        for (int i = 0; i < 4; ++i)
#pragma unroll
            for (int kk = 0; kk < 4; ++kk) v[i][kk] = __builtin_nontemporal_load((const GAS f32x4*)(W + (size_t)(k0 + 64 * hf + 4 * (kg + 4 * i) + kk) * ldw + n0 + 4 * n4));
#pragma unroll
        for (int i = 0; i < 4; ++i)
#pragma unroll
            for (int j = 0; j < 4; ++j) {
                u32x2 w; w.x = cvt_pk_bf16(v[i][0][j], v[i][1][j]); w.y = cvt_pk_bf16(v[i][2][j], v[i][3][j]);
                *(LAS u32x2*)(scr + ((4 * n4 + j) * 17 + (kg + 4 * i)) * 8) = w;
            }
        LDS_WAIT(); asm volatile("" ::: "memory");
#pragma unroll
        for (int ch = 0; ch < 2; ++ch) {
            v16u32 x;
#pragma unroll
            for (int i = 0; i < 8; ++i) { const u32x2 w = *(const LAS u32x2*)(scr + (lane * 17 + 8 * ch + i) * 8); x[2 * i] = w.x; x[2 * i + 1] = w.y; }
            float m = 0.f;
#pragma unroll
            for (int i = 0; i < 16; ++i) m = fmaxf(fmaxf(m, fabsf(__uint_as_float(x[i] << 16))), fabsf(__uint_as_float(x[i] & 0xffff0000u)));
            int E = (int)(__float_as_uint(m * 1.0666667f) >> 23) - 2; E = E < 1 ? 1 : E;
            rr[2 * hf + ch] = __builtin_amdgcn_cvt_scalef32_pk32_fp6_bf16(__builtin_bit_cast(v32bf16, x), __uint_as_float((unsigned)E << 23)); ee[2 * hf + ch] = (unsigned)E;
        }
        LDS_WAIT(); asm volatile("" ::: "memory");
    }
#pragma unroll
    for (int q = 0; q < 4; ++q) {
        LAS unsigned char* o = scr + lane * 136 + 16 * q;
        *(LAS u32x2*)o = (u32x2){rr[q][0], rr[q][1]}; *(LAS u32x2*)(o + 8) = (u32x2){rr[q][2], rr[q][3]};
        *(LAS u32x2*)(o + 64) = (u32x2){rr[q][4], rr[q][5]}; *(LAS u32x2*)(o + 72) = (u32x2){ee[q], 0u};
    }
    LDS_WAIT(); asm volatile("" ::: "memory");
#pragma unroll
    for (int q = 0; q < 16; ++q) {
        const int n = (lane >> 4) + 4 * q;
        const u32x2 w = *(const LAS u32x2*)(scr + n * 136 + 8 * (lane & 15));
        __builtin_nontemporal_store(w, (GAS u32x2*)(WT + (size_t)(drow0 + n) * 1024 + k0 + 8 * (lane & 15)));
    }
    LDS_WAIT(); asm volatile("" ::: "memory");
}
__device__ __forceinline__ int glu_row(int n, int F) { const int hf = n >= F ? 1 : 0, m = n - hf * F; return (m >> 7) * 256 + hf * 128 + (m & 127); }

constexpr int CONV_SPLIT = 1;
constexpr int CONV_SCAN_SHARE = 36864;
__device__ __forceinline__ void convert_weights(KArgs a, LAS unsigned char* scr, int lane, int w, int nw, bool small, int l0, int l1, int it_lo, int it_hi) {
    unsigned char* ws = a->ws;
    constexpr int IT_POOL = 8 * 8, IT_GLU = 8 * 32, IT_QKV = 8 * 24, IT_WO = 8 * 16, IT_W1 = 8 * 32, IT_W2 = 8 * 16;
    const int n_small = small ? IT_POOL + IT_GLU + IT_QKV + IT_WO : 0;
    const int n_w1 = (l1 - l0) * 32 * IT_W1, n_w2 = (l1 - l0) * 32 * IT_W2;
    const int it_end = min(it_hi, n_small + n_w1 + n_w2);
    for (int it = it_lo + w; it < it_end; it += nw) {
        int r = it;
        if (r < n_small) {
            if (r < IT_POOL) { const int mat = r >> 3, q = r & 7, kb = q >> 2, nb = q & 3;
                tr_item8(a->in[I_POOLW] + (size_t)mat * 65536, 256, ws + WS_POOLW + (size_t)mat * 65536, 256, kb * 128, nb * 64, nb * 64, scr, lane, W8_SCALE); continue; }
            r -= IT_POOL;
            if (r < IT_GLU) { const int kb = r >> 5, nb = r & 31;
                tr_item8(a->in[I_GLUW], 2048, ws + WS_GLUW, 1024, kb * 128, nb * 64, glu_row(nb * 64, 1024), scr, lane, W8_SCALE); continue; }
            r -= IT_GLU;
            if (r < IT_QKV) { const int kb = r / 24, nb = r % 24;
                tr_item8(a->in[I_WQKV], 1536, ws + WS_WQKV, 1024, kb * 128, nb * 64, nb * 64, scr, lane, W8_SCALE); continue; }
            r -= IT_QKV;
            { const int kb = r >> 4, nb = r & 15;
                tr_item8(a->in[I_WO], 1024, ws + WS_WO, 1024, kb * 128, nb * 64, nb * 64, scr, lane, W8_SCALE); continue; }
        }
        r -= n_small;
        if (r < n_w1) { const int mat = l0 * 32 + (r >> 8), q = r & 255, kb = q >> 5, nb = q & 31;
            if constexpr (MOE1_FMT == 2) tr_item6(a->in[I_W1] + (size_t)mat * 1024 * 2048, 2048, ws + WS_W1T + (size_t)mat * 2048 * 1024, kb * 128, nb * 64, glu_row(nb * 64, 1024), scr, lane);
            else tr_item8(a->in[I_W1] + (size_t)mat * 1024 * 2048, 2048, ws + WS_W1T + (size_t)mat * 2048 * 1024, 1024, kb * 128, nb * 64, glu_row(nb * 64, 1024), scr, lane, W8_SCALE);
            continue; }
        r -= n_w1;
        { const int mat = l0 * 32 + (r >> 7), q = r & 127, kb = q >> 4, nb = q & 15;
            tr_item8(a->in[I_W2] + (size_t)mat * 1024 * 1024, 1024, ws + WS_W2T + (size_t)mat * 1024 * 1024, 1024, kb * 128, nb * 64, nb * 64, scr, lane, W8_SCALE); }
    }
}

__device__ __forceinline__ void prologue(KArgs a, LAS unsigned char* lds, int tid, int lane, int wave) {
    const int G = gridDim.x, bx = blockIdx.x;
    unsigned char* ws = a->ws;
    __syncthreads();
    {
        LAS float* sv = (LAS float*)lds;
        LAS float* red = (LAS float*)(lds + 9 * 1024 * 4);
        bool staged = false;
        for (int it = bx; it < 4 * 48; it += G) {
            if (!staged) {
                for (int i = tid; i < 9 * 1024; i += NTHR) { const int r = i >> 10, k = i & 1023; const float c = r < 8 ? a->in[I_C][r * 1024 + k] : a->in[I_CCTX][k]; sv[i] = c * sigmoidf_(c); }
                staged = true;
            }
            __syncthreads();
            const int layer = it / 48, col0 = (it % 48) * 128;
            const float* W = a->in[I_ADAW] + (size_t)layer * 1024 * NMOD + col0 + 2 * lane;
            f32x2 acc[9];
#pragma unroll
            for (int r = 0; r < 9; ++r) acc[r] = (f32x2){0.f, 0.f};
            const int kb = wave * 128;
#pragma unroll 8
            for (int k = 0; k < 128; ++k) {
                const f32x2 w = __builtin_nontemporal_load((const GAS f32x2*)(W + (size_t)(kb + k) * NMOD));
#pragma unroll
                for (int r = 0; r < 9; ++r) { const float s = sv[r * 1024 + kb + k]; acc[r].x += s * w.x; acc[r].y += s * w.y; }
            }
#pragma unroll
            for (int r = 0; r < 9; ++r) { red[(wave * 9 + r) * 128 + 2 * lane] = acc[r].x; red[(wave * 9 + r) * 128 + 2 * lane + 1] = acc[r].y; }
            __syncthreads();
            float* mods = (float*)(ws + WS_MODS);
            for (int i = tid; i < 9 * 128; i += NTHR) {
                const int r = i >> 7, cc = i & 127; float s = 0.f;
#pragma unroll
                for (int w = 0; w < 8; ++w) s += red[(w * 9 + r) * 128 + cc];
                mods[((size_t)layer * 9 + r) * NMOD + col0 + cc] = s + a->in[I_ADAB][layer * NMOD + col0 + cc];
            }
        }
        __syncthreads();
    }
    const int gt = bx * NTHR + tid, NGT = G * NTHR;
    for (int i = gt; i < 64 * 32; i += NGT) {
        const int pos = i >> 5, f = i & 31; const float inv = powf(10000.f, -(float)f / 32.f); const float ang = (float)pos * inv;
        ((f32x2*)(ws + WS_ROPE))[i] = (f32x2){cosf(ang), sinf(ang)};
    }
    for (int i = gt; i < 4 * 32 * 512; i += NGT) {
        const int layer = i >> 14, e = (i >> 9) & 31, c = (i & 511) * 2;
        ((unsigned*)(ws + WS_RT))[i] = cvt_pk_bf16(a->in[I_RW][((size_t)layer * 1024 + c) * 32 + e], a->in[I_RW][((size_t)layer * 1024 + c + 1) * 32 + e]);
    }
    for (int i = gt; i < 2 * 64 * 64; i += NGT) {
        const int d = i >> 12, g = (i >> 6) & 63;
        const float lr = a->in[I_LAMRE][i], li = a->in[I_LAMIM][i], dt = expf(a->in[I_LOGDT][d * 64 + g]);
        const float zr = lr * dt, zi = li * dt, mag = expf(zr);
        ((f32x2*)(ws + WS_S5LAM))[i] = (f32x2){mag * cosf(zi), mag * sinf(zi)};
    }
    for (int i = gt; i < 2 * 64 * 4 * 64; i += NGT) {
        const int l = i & 63, nt_ = (i >> 6) & 3, g = (i >> 8) & 63, d = i >> 14;
        const int p = (nt_ >> 1) * 32 + (l & 31), im = nt_ & 1, dg = d * 64 + g;
        const float lr = a->in[I_LAMRE][dg * 64 + p], li = a->in[I_LAMIM][dg * 64 + p], dt = expf(a->in[I_LOGDT][dg]);
        const float zr = lr * dt, zi = li * dt, mag = expf(zr), ar = mag * cosf(zi), ai = mag * sinf(zi), den = lr * lr + li * li;
        const float cr = ((ar - 1.f) * lr + ai * li) / den, ci = (ai * lr - (ar - 1.f) * li) / den;
        float o[8];
#pragma unroll
        for (int j = 0; j < 8; ++j) { const int h = 8 * (l >> 5) + j; const float br = a->in[I_BRE][((size_t)dg * 64 + p) * 16 + h], bi = a->in[I_BIM][((size_t)dg * 64 + p) * 16 + h];
            o[j] = im ? (cr * bi + ci * br) : (cr * br - ci * bi); }
        u32x4 w; w.x = cvt_pk_bf16(o[0], o[1]); w.y = cvt_pk_bf16(o[2], o[3]); w.z = cvt_pk_bf16(o[4], o[5]); w.w = cvt_pk_bf16(o[6], o[7]);
        ((u32x4*)(ws + WS_S5BF))[i] = w;
    }
    for (int i = gt; i < 2 * 64 * 4 * 64; i += NGT) {
        const int l = i & 63, ks = (i >> 6) & 3, g = (i >> 8) & 63, d = i >> 14, dg = d * 64 + g, hp = l & 15;
        float o[8];
#pragma unroll
        for (int j = 0; j < 8; ++j) { const int k = 32 * ks + 8 * (l >> 4) + j, p = k >> 1;
            o[j] = (k & 1) ? -a->in[I_CIM][((size_t)dg * 16 + hp) * 64 + p] : a->in[I_CRE][((size_t)dg * 16 + hp) * 64 + p]; }
        u32x4 w; w.x = cvt_pk_bf16(o[0], o[1]); w.y = cvt_pk_bf16(o[2], o[3]); w.z = cvt_pk_bf16(o[4], o[5]); w.w = cvt_pk_bf16(o[6], o[7]);
        ((u32x4*)(ws + WS_S5CF))[i] = w;
    }
    const int gw = bx * NWAVES + wave, NGW = G * NWAVES;
    convert_weights(a, lds + wave * 8704, lane, gw, NGW, true, 0, CONV_SPLIT, 0, 1 << 30);
}

template <bool BLOCKED> __device__ __forceinline__ int colof(int lane, int j) { return BLOCKED ? 16 * lane + 4 * j : 256 * j + 4 * lane; }

__device__ __forceinline__ const void* x_row_ptr(KArgs a, int layer, int row, int b, int s) {
    if (layer == 0) return s < CTXL ? a->in[I_CTX] + ((size_t)b * CTXL + s) * DM : a->in[I_X] + ((size_t)b * SEQ + (s - CTXL)) * DM;
    return (const bf16*)(a->ws + WS_XS) + (size_t)row * DM;
}
__device__ __forceinline__ f32x4 bf4_to_f32(u32x2 w) { return (f32x4){bf_lo(w.x), bf_hi(w.x), bf_lo(w.y), bf_hi(w.y)}; }
__device__ __forceinline__ u32x2 f32_to_bf4(f32x4 v) { u32x2 w; w.x = cvt_pk_bf16(v.x, v.y); w.y = cvt_pk_bf16(v.z, v.w); return w; }
template <bool BLOCKED>
__device__ __forceinline__ void row_loads(KArgs a, const void* xr, bool f32src, int row, int lane, bool combine, f32x4 (&v)[4], unsigned (&yw)[4][4]) {
    if (f32src) {
#pragma unroll
        for (int j = 0; j < 4; ++j) v[j] = *(const GAS f32x4*)((const float*)xr + colof<BLOCKED>(lane, j));
    } else {
#pragma unroll
        for (int j = 0; j < 4; ++j) v[j] = bf4_to_f32(*(const GAS u32x2*)((const bf16*)xr + colof<BLOCKED>(lane, j)));
    }
    if (combine) {
        const unsigned char* yb = a->ws + WS_YB + (size_t)row * 4 * DM;
#pragma unroll
        for (int j = 0; j < 4; ++j)
#pragma unroll
            for (int k = 0; k < 4; ++k) yw[j][k] = *(const GAS unsigned*)(yb + (size_t)k * DM + colof<BLOCKED>(lane, j));
    }
}
__device__ __forceinline__ f32x4 y8_sum(const unsigned (&w)[4]) {
    f32x4 s = (f32x4){0.f, 0.f, 0.f, 0.f};
#pragma unroll
    for (int k = 0; k < 4; ++k) { const f32x2 lo = __builtin_amdgcn_cvt_pk_f32_fp8(w[k], false), hi = __builtin_amdgcn_cvt_pk_f32_fp8(w[k], true); s.x += lo.x; s.y += lo.y; s.z += hi.x; s.w += hi.y; }
    return s * (1.0f / Y8_SCALE);
}
template <bool BLOCKED>
__device__ __forceinline__ void row_combine(KArgs a, int row, int lane, const float* gate_prev, f32x4 (&v)[4], const unsigned (&yw)[4][4]) {
    bf16* xw = (bf16*)(a->ws + WS_XS) + (size_t)row * DM;
#pragma unroll
    for (int j = 0; j < 4; ++j) {
        const int c = colof<BLOCKED>(lane, j);
        const f32x4 s = y8_sum(yw[j]);
        const f32x4 g = *(const GAS f32x4*)(gate_prev + c);
        v[j] = v[j] + g * s;
        *(GAS u32x2*)(xw + c) = f32_to_bf4(v[j]);
    }
}
template <bool BLOCKED>
__device__ __forceinline__ void load_x_row(KArgs a, int row, int lane, bool combine, const float* gate_prev, f32x4 (&v)[4]) {
    unsigned yw[4][4];
    row_loads<BLOCKED>(a, (const bf16*)(a->ws + WS_XS) + (size_t)row * DM, false, row, lane, combine, v, yw);
    if (combine) row_combine<BLOCKED>(a, row, lane, gate_prev, v, yw);
}
template <bool BLOCKED>
__device__ __forceinline__ void norm_mod(f32x4 (&v)[4], int lane, const float* g, const float* shift, const float* scale) {
    float ss = 0.f;
#pragma unroll
    for (int j = 0; j < 4; ++j) ss += (v[j].x * v[j].x + v[j].y * v[j].y) + (v[j].z * v[j].z + v[j].w * v[j].w);
    const float inv = rsqrtf(wave_sum(ss) * (1.f / DM) + NORM_EPS);
#pragma unroll
    for (int j = 0; j < 4; ++j) {
        const int c = colof<BLOCKED>(lane, j);
        const f32x4 gg = *(const GAS f32x4*)(g + c), sh = *(const GAS f32x4*)(shift + c), sc = *(const GAS f32x4*)(scale + c);
        v[j] = (v[j] * inv) * gg * (sc + 1.f) + sh;
    }
}

template <bool BLOCKED>
__device__ __forceinline__ void norm1_finish(KArgs a, int layer, int row, int b, int s, int lane, bool combine, f32x4 (&v)[4], const unsigned (&yw)[4][4]) {
    const int mrow = s < CTXL ? 8 : b;
    const float* md = mods_ptr(a, layer, mrow);
    if (combine) row_combine<BLOCKED>(a, row, lane, mods_ptr(a, layer - 1, mrow) + 5 * DM, v, yw);
    norm_mod<BLOCKED>(v, lane, a->in[I_N1G] + layer * DM, md, md + DM);
    if constexpr (!BLOCKED) {
        if (layer % 3 == 2) {
            unsigned char* o8 = a->ws + WS_B1 + (size_t)row * DM;
#pragma unroll
            for (int j = 0; j < 4; ++j) *(GAS unsigned*)(o8 + 256 * j + 4 * lane) = cvt_pk4_fp8(v[j].x, v[j].y, v[j].z, v[j].w);
        } else {
            bf16* o = (bf16*)(a->ws + WS_B1) + (size_t)row * DM;
#pragma unroll
            for (int j = 0; j < 4; ++j) { u32x2 w; w.x = cvt_pk_bf16(v[j].x, v[j].y); w.y = cvt_pk_bf16(v[j].z, v[j].w); *(GAS u32x2*)(o + 256 * j + 4 * lane) = w; }
        }
    } else {
        bf16* o = (bf16*)(a->ws + WS_B1) + (((size_t)b * 64 + lane) * SEG + s) * 16;
        u32x4 w0, w1;
        w0.x = cvt_pk_bf16(v[0].x, v[0].y); w0.y = cvt_pk_bf16(v[0].z, v[0].w); w0.z = cvt_pk_bf16(v[1].x, v[1].y); w0.w = cvt_pk_bf16(v[1].z, v[1].w);
        w1.x = cvt_pk_bf16(v[2].x, v[2].y); w1.y = cvt_pk_bf16(v[2].z, v[2].w); w1.z = cvt_pk_bf16(v[3].x, v[3].y); w1.w = cvt_pk_bf16(v[3].z, v[3].w);
        *(GAS u32x4*)o = w0; *(GAS u32x4*)(o + 8) = w1;
    }
}
template <bool BLOCKED>
__device__ __forceinline__ void phase_norm1(KArgs a, int layer, int lane, int wave) {
    const int gw = blockIdx.x * NWAVES + wave, NGW = gridDim.x * NWAVES;
    const bool combine = layer > 0, last = layer == MK_LAYERS - 1;
    for (int rowA = gw; rowA < NR; rowA += 2 * NGW) {
        const int rowB = rowA + NGW;
        const int bA = rowA / SEG, sA = rowA - bA * SEG, bB = rowB / SEG, sB = rowB - bB * SEG;
        const bool doA = !(last && sA < CTXL), doB = rowB < NR && !(last && sB < CTXL);
        f32x4 vA[4], vB[4]; unsigned yA[4][4], yB[4][4];
        if (doA) row_loads<BLOCKED>(a, x_row_ptr(a, layer, rowA, bA, sA), layer == 0, rowA, lane, combine, vA, yA);
        if (doB) row_loads<BLOCKED>(a, x_row_ptr(a, layer, rowB, bB, sB), layer == 0, rowB, lane, combine, vB, yB);
        if (doA) norm1_finish<BLOCKED>(a, layer, rowA, bA, sA, lane, combine, vA, yA);
        if (doB) norm1_finish<BLOCKED>(a, layer, rowB, bB, sB, lane, combine, vB, yB);
    }
}

__device__ __forceinline__ void phase_pooldiff(KArgs a, LAS unsigned char* lds, int layer, int tid, int lane, int wave) {
    const bool last = layer == MK_LAYERS - 1;
    const bf16* H = (const bf16*)(a->ws + WS_B1); bf16* Dd = (bf16*)(a->ws + WS_B2);
    constexpr int NCH = NR / 32;
    const int nch = last ? NB * 128 : NCH;
    for (int c = blockIdx.x; c < nch; c += gridDim.x) {
        const int b = last ? (c >> 7) : c / 136, cc = last ? 8 + (c & 127) : c - b * 136, s0 = cc * 32;
        const int seg_lo = cc < 8 ? 0 : CTXL, seg_hi = cc < 8 ? CTXL : SEG;
        const int st_lo = max(s0 - 8, seg_lo), st_hi = min(s0 + 40, seg_hi);
        __syncthreads();
        for (int p = tid; p < (st_hi - st_lo) * 128; p += NTHR) {
            const int r = p >> 7, q = p & 127;
            *(LAS u32x4*)(lds + (size_t)(st_lo + r - (s0 - 8)) * 2048 + q * 16) = *(const GAS u32x4*)(H + ((size_t)b * SEG + st_lo + r) * DM + q * 8);
        }
        __syncthreads();
#pragma unroll 1
        for (int rr = 0; rr < 4; ++rr) {
            const int s = s0 + wave * 4 + rr;
#pragma unroll
            for (int j = 0; j < 4; ++j) {
                const int half = 1 << j;
                const int lo = max(s - half, seg_lo), hi = min(s + half, seg_hi);
                f32x4 sum = (f32x4){0.f, 0.f, 0.f, 0.f};
                for (int t = lo; t < hi; ++t) { const u32x2 w = *(const LAS u32x2*)(lds + (size_t)(t - (s0 - 8)) * 2048 + (256 * j + 4 * lane) * 2); sum.x += bf_lo(w.x); sum.y += bf_hi(w.x); sum.z += bf_lo(w.y); sum.w += bf_hi(w.y); }
                const u32x2 w = *(const LAS u32x2*)(lds + (size_t)(s - (s0 - 8)) * 2048 + (256 * j + 4 * lane) * 2);
                const float ic = 1.f / (float)(hi - lo);
                *(GAS unsigned*)((unsigned char*)Dd + ((size_t)b * SEG + s) * DM + 256 * j + 4 * lane) = cvt_pk4_fp8(sum.x * ic - bf_lo(w.x), sum.y * ic - bf_hi(w.x), sum.z * ic - bf_lo(w.y), sum.w * ic - bf_hi(w.y));
            }
        }
    }
    __syncthreads();
}

__device__ __forceinline__ void phase_norm1_pooldiff(KArgs a, LAS unsigned char* lds, int layer, int tid, int lane, int wave) {
    const bool last = layer == MK_LAYERS - 1, combine = layer > 0;
    bf16* Dd = (bf16*)(a->ws + WS_B2);
    constexpr int NCH = NR / 32;
    const int nch = last ? NB * 128 : NCH;
    for (int c = blockIdx.x; c < nch; c += gridDim.x) {
        const int b = last ? (c >> 7) : c / 136, cc = last ? 8 + (c & 127) : c - b * 136, s0 = cc * 32;
        const int seg_lo = cc < 8 ? 0 : CTXL, seg_hi = cc < 8 ? CTXL : SEG, mrow = cc < 8 ? 8 : b;
        const int st_lo = max(s0 - 8, seg_lo), st_hi = min(s0 + 40, seg_hi);
        const float* md = mods_ptr(a, layer, mrow);
        __syncthreads();
#pragma unroll 1
        for (int i = 0; i < 6; i += 3) {
            int sR[3], rowR[3]; bool doR[3];
            f32x4 vR[3][4]; unsigned yR[3][4][4];
#pragma unroll
            for (int q = 0; q < 3; ++q) { sR[q] = s0 - 8 + wave + 8 * (i + q); doR[q] = sR[q] >= st_lo && sR[q] < st_hi; rowR[q] = b * SEG + sR[q]; }
#pragma unroll
            for (int q = 0; q < 3; ++q) if (doR[q]) row_loads<false>(a, x_row_ptr(a, layer, rowR[q], b, sR[q]), layer == 0, rowR[q], lane, combine, vR[q], yR[q]);
#pragma unroll
            for (int q = 0; q < 3; ++q) {
                if (!doR[q]) continue;
                f32x4 (&v)[4] = vR[q]; const unsigned (&yw)[4][4] = yR[q]; const int s = sR[q], row = rowR[q];
                if (combine) {
                    const float* gate_prev = mods_ptr(a, layer - 1, mrow) + 5 * DM;
                    const bool own = s >= s0 && s < s0 + 32;
                    bf16* xw = (bf16*)(a->ws + WS_B1) + (size_t)row * DM;
#pragma unroll
                    for (int j = 0; j < 4; ++j) { const int cidx = 256 * j + 4 * lane; v[j] = v[j] + *(const GAS f32x4*)(gate_prev + cidx) * y8_sum(yw[j]); if (own) *(GAS u32x2*)(xw + cidx) = f32_to_bf4(v[j]); }
                }
                norm_mod<false>(v, lane, a->in[I_N1G] + layer * DM, md, md + DM);
#pragma unroll
                for (int j = 0; j < 4; ++j) *(LAS u32x2*)(lds + (size_t)(s - (s0 - 8)) * 2048 + (256 * j + 4 * lane) * 2) = f32_to_bf4(v[j]);
            }
        }
        LDS_WAIT(); __syncthreads();
#pragma unroll 1
        for (int rr = 0; rr < 4; ++rr) {
            const int s = s0 + wave * 4 + rr;
#pragma unroll
            for (int j = 0; j < 4; ++j) {
                const int half = 1 << j;
                const int lo = max(s - half, seg_lo), hi = min(s + half, seg_hi);
                f32x4 sum = (f32x4){0.f, 0.f, 0.f, 0.f};
                for (int t = lo; t < hi; ++t) { const u32x2 w = *(const LAS u32x2*)(lds + (size_t)(t - (s0 - 8)) * 2048 + (256 * j + 4 * lane) * 2); sum.x += bf_lo(w.x); sum.y += bf_hi(w.x); sum.z += bf_lo(w.y); sum.w += bf_hi(w.y); }
                const u32x2 w = *(const LAS u32x2*)(lds + (size_t)(s - (s0 - 8)) * 2048 + (256 * j + 4 * lane) * 2);
                const float ic = 1.f / (float)(hi - lo);
                *(GAS unsigned*)((unsigned char*)Dd + ((size_t)b * SEG + s) * DM + 256 * j + 4 * lane) = cvt_pk4_fp8(sum.x * ic - bf_lo(w.x), sum.y * ic - bf_hi(w.x), sum.z * ic - bf_lo(w.y), sum.w * ic - bf_hi(w.y));
            }
        }
    }
    __syncthreads();
}

__device__ __forceinline__ void phase_s5_readout(KArgs a, int layer, int lane, int wave) {
    const int gw = blockIdx.x * NWAVES + wave, NGW = gridDim.x * NWAVES;
    const float* g1 = a->in[I_N1G] + layer * DM; const float* dsk = a->in[I_SSMD];
    const bf16* YG = (const bf16*)(a->ws + WS_YG);
    for (int row = gw; row < NR; row += NGW) {
        const int b = row / SEG, s = row - b * SEG, mrow = s < CTXL ? 8 : b;
        const float* md = mods_ptr(a, layer, mrow);
        f32x4 v[4];
        load_x_row<true>(a, row, lane, false, nullptr, v);
        norm_mod<true>(v, lane, g1, md, md + DM);
        const unsigned yoff = (unsigned)(b * 64 * SEG + s) * 16u + (unsigned)lane * (unsigned)(SEG * 16);
        const bf16* y0 = YG + yoff;
        const bf16* y1 = YG + yoff + (unsigned)(NB * 64 * SEG * 16);
        u32x4 ya[2], yb[2];
        ya[0] = *(const GAS u32x4*)y0; ya[1] = *(const GAS u32x4*)(y0 + 8); yb[0] = *(const GAS u32x4*)y1; yb[1] = *(const GAS u32x4*)(y1 + 8);
        unsigned pk[4];
#pragma unroll
        for (int j = 0; j < 4; ++j) {
            const unsigned a0 = ya[j >> 1][(j & 1) * 2], a1 = ya[j >> 1][(j & 1) * 2 + 1], b0 = yb[j >> 1][(j & 1) * 2], b1 = yb[j >> 1][(j & 1) * 2 + 1];
            const f32x4 ysum = (f32x4){bf_lo(a0) + bf_lo(b0), bf_hi(a0) + bf_hi(b0), bf_lo(a1) + bf_lo(b1), bf_hi(a1) + bf_hi(b1)};
            const f32x4 dd = *(const GAS f32x4*)(dsk + 16 * lane + 4 * j);
            f32x4 y = ysum + dd * v[j];
            float o[4];
#pragma unroll
            for (int i = 0; i < 4; ++i) { const float t = y[i]; o[i] = t * __builtin_amdgcn_rcpf(1.0f + __builtin_amdgcn_exp2f(-2.3022082f * (t + 0.044715f * t * t * t))); }
            pk[j] = cvt_pk4_fp8(o[0], o[1], o[2], o[3]);
        }
        *(GAS u32x4*)(a->ws + WS_B2 + (size_t)row * DM + 16 * lane) = (u32x4){pk[0], pk[1], pk[2], pk[3]};
    }
}

__device__ __forceinline__ void qk_head(bf16* p, unsigned char* p8, const float* g, const f32x2* rope, int t, bool latent, int q8) {
    const int ax = q8 >> 2, f0 = (q8 & 3) * 8, d1 = ax * 64 + f0;
    const u32x4 w1 = *(const GAS u32x4*)(p + d1), w2 = *(const GAS u32x4*)(p + d1 + 32);
    float x1[8], x2[8];
#pragma unroll
    for (int j = 0; j < 4; ++j) { x1[2 * j] = bf_lo(w1[j]); x1[2 * j + 1] = bf_hi(w1[j]); x2[2 * j] = bf_lo(w2[j]); x2[2 * j + 1] = bf_hi(w2[j]); }
    float ss = 0.f;
#pragma unroll
    for (int j = 0; j < 8; ++j) ss += x1[j] * x1[j] + x2[j] * x2[j];
    ss += __shfl_xor(ss, 1); ss += __shfl_xor(ss, 2); ss += __shfl_xor(ss, 4);
    const float inv = rsqrtf(ss * (1.f / 128.f) + NORM_EPS);
    const int pos = ax == 0 ? (t >> 6) : (t & 63);
    float y1[8], y2[8];
#pragma unroll
    for (int j = 0; j < 4; ++j) {
        const f32x2 ga = *(const GAS f32x2*)(g + d1 + 2 * j), gb = *(const GAS f32x2*)(g + d1 + 32 + 2 * j);
        float a0 = x1[2 * j] * inv * ga.x, a1 = x1[2 * j + 1] * inv * ga.y, b0 = x2[2 * j] * inv * gb.x, b1 = x2[2 * j + 1] * inv * gb.y;
        if (latent) {
            const f32x4 cs = *(const GAS f32x4*)(rope + pos * 32 + f0 + 2 * j);
            const float r0 = a0 * cs.x - b0 * cs.y, s0 = b0 * cs.x + a0 * cs.y, r1 = a1 * cs.z - b1 * cs.w, s1 = b1 * cs.z + a1 * cs.w;
            a0 = r0; b0 = s0; a1 = r1; b1 = s1;
        }
        y1[2 * j] = a0; y1[2 * j + 1] = a1; y2[2 * j] = b0; y2[2 * j + 1] = b1;
    }
    const int off = 64 * (q8 & 1) + 32 * ax + 8 * ((q8 & 3) >> 1);
    *(GAS u32x2*)(p8 + off) = (u32x2){cvt_pk4_fp8(y1[0], y1[1], y1[2], y1[3]), cvt_pk4_fp8(y1[4], y1[5], y1[6], y1[7])};
    *(GAS u32x2*)(p8 + off + 16) = (u32x2){cvt_pk4_fp8(y2[0], y2[1], y2[2], y2[3]), cvt_pk4_fp8(y2[4], y2[5], y2[6], y2[7])};
}
constexpr int V8T_TILE = 128 * 64;
__device__ __forceinline__ void phase_qkpost(KArgs a, LAS unsigned char* lds, int tid, int lane, int wave) {
    const int gw = blockIdx.x * NWAVES + wave, NGW = gridDim.x * NWAVES;
    const f32x2* rope = (const f32x2*)(a->ws + WS_ROPE);
    for (int row4 = gw * 4; row4 < NR; row4 += NGW * 4) {
        const int row = row4 + (lane >> 4), l16 = lane & 15;
        int s = (row4 - (row4 / SEG) * SEG) + (lane >> 4); if (s >= SEG) s -= SEG;
        const bool latent = s >= CTXL; const int t = s - CTXL;
        qk_head((bf16*)(a->ws + WS_KB) + (size_t)row * 256 + (l16 >> 3) * 128, a->ws + WS_B3 + (size_t)row * 256 + (l16 >> 3) * 128, a->in[I_KG], rope, t, latent, l16 & 7);
    }
    const bf16* Vb = (const bf16*)(a->ws + WS_VB); unsigned char* VT = a->ws + WS_YG;
    for (int item = blockIdx.x; item < NB * 2 * 68; item += gridDim.x) {
        const int b = item / 136, rem = item - b * 136, kvh = rem / 68, j = rem - kvh * 68;
        __syncthreads();
#pragma unroll
        for (int i = 0; i < 2; ++i) { const int p = tid + i * NTHR, key = p >> 4, piece = p & 15;
            *(LAS u32x4*)(lds + key * 272 + piece * 16) = *(const GAS u32x4*)(Vb + ((size_t)b * SEG + j * 64 + key) * 256 + kvh * 128 + piece * 8); }
        LDS_WAIT(); __syncthreads();
        const int d = tid >> 2, c = tid & 3, hh = c >> 1, kb = c & 1;
        float v[16];
#pragma unroll
        for (int t = 0; t < 16; ++t) { const int key = 32 * kb + (t & 3) + 8 * (t >> 2) + 4 * hh; v[t] = __uint_as_float((unsigned)*(const LAS unsigned short*)(lds + key * 272 + d * 2) << 16); }
        *(GAS u32x4*)(VT + (size_t)item * V8T_TILE + d * 64 + ((c ^ ((d >> 2) & 3)) << 4)) = (u32x4){cvt_pk4_fp8(v[0], v[1], v[2], v[3]), cvt_pk4_fp8(v[4], v[5], v[6], v[7]), cvt_pk4_fp8(v[8], v[9], v[10], v[11]), cvt_pk4_fp8(v[12], v[13], v[14], v[15])};
    }
    __syncthreads();
}

__device__ __forceinline__ void phase_final(KArgs a, int lane, int wave) {
    const int gw = blockIdx.x * NWAVES + wave, NGW = gridDim.x * NWAVES;
    for (int row = gw; row < NR; row += NGW) {
        const int b = row / SEG, s = row - b * SEG;
        if (s < CTXL) continue;
        f32x4 v[4];
        const bool comb = MK_LAYERS > 0;
        load_x_row<false>(a, row, lane, comb, comb ? mods_ptr(a, MK_LAYERS - 1, b) + 5 * DM : nullptr, v);
        float* o = a->out + ((size_t)b * SEQ + (s - CTXL)) * DM;
#pragma unroll
        for (int j = 0; j < 4; ++j) *(GAS f32x4*)(o + 256 * j + 4 * lane) = v[j];
    }
}

__device__ __forceinline__ int s5_token(int d, int j) { return d == 0 ? j : (j < CTXL ? (CTXL - 1 - j) : (SEG + CTXL - 1 - j)); }
__device__ __forceinline__ void phase_s5_scan(KArgs a, LAS unsigned char* lds, int lane, int wave) {
    if (wave >= 4) {
        convert_weights(a, lds + 4 * 8704 + (wave - 4) * 8704, lane, blockIdx.x * 4 + (wave - 4), gridDim.x * 4, false, CONV_SPLIT, MK_LAYERS, 0, CONV_SCAN_SHARE);
        return;
    }
    const int G = gridDim.x;
    __builtin_amdgcn_s_setprio(3);
    LAS unsigned* Hs = (LAS unsigned*)(lds + wave * 8704);
    const int hi = lane >> 5, c = lane & 31;
    const int rho = lane & 31, posA = 16 * ((rho >> 2) & 1) + (rho & 3) + 4 * (rho >> 3);
    for (int sid = blockIdx.x * 4 + wave; sid < NB * 64 * 2; sid += G * 4) {
        const int d = sid & 1, g = (sid >> 1) & 63, b = sid >> 7, dg = d * 64 + g;
        const bf16* U = (const bf16*)(a->ws + WS_B1) + ((size_t)b * 64 + g) * SEG * 16;
        unsigned* Y = (unsigned*)(a->ws + WS_YG) + ((size_t)(d * NB + b) * 64 + g) * SEG * 8;
        bf16x8 bfr[4], cfr[4];
#pragma unroll
        for (int n = 0; n < 4; ++n) { bfr[n] = *(const GAS bf16x8*)(a->ws + WS_S5BF + ((size_t)(dg * 4 + n) * 64 + lane) * 16); cfr[n] = *(const GAS bf16x8*)(a->ws + WS_S5CF + ((size_t)(dg * 4 + n) * 64 + lane) * 16); }
        const f32x2 lam0 = ((const f32x2*)(a->ws + WS_S5LAM))[dg * 64 + c], lam1 = ((const f32x2*)(a->ws + WS_S5LAM))[dg * 64 + 32 + c];
        float car[2][2] = {{0.f, 0.f}, {0.f, 0.f}};
        bf16x8 uf[4];
#pragma unroll
        for (int q = 0; q < 4; ++q) uf[q] = *(const GAS bf16x8*)(U + (size_t)s5_token(d, 32 * q + posA) * 16 + 8 * hi);
        for (int jb = 0; jb < SEG; jb += 128) {
#pragma unroll
          for (int q = 0; q < 4; ++q) {
            const int j0 = jb + 32 * q;
            const bf16x8 ufr = uf[q];
            if (j0 + 128 < SEG) uf[q] = *(const GAS bf16x8*)(U + (size_t)s5_token(d, j0 + 128 + posA) * 16 + 8 * hi);
            f32x16 x[4];
#pragma unroll
            for (int n = 0; n < 4; ++n) { x[n] = f32x16{}; x[n] = __builtin_amdgcn_mfma_f32_32x32x16_bf16(ufr, bfr[n], x[n], 0, 0, 0); }
#pragma unroll
            for (int pp = 0; pp < 2; ++pp) {
                const float ar = pp ? lam1.x : lam0.x, ai = pp ? lam1.y : lam0.y;
                float sr = hi == 0 ? car[pp][0] : 0.f, si = hi == 0 ? car[pp][1] : 0.f;
#pragma unroll
                for (int r = 0; r < 16; ++r) {
                    const float nr = fmaf(ar, sr, fmaf(-ai, si, x[2 * pp][r])), ni = fmaf(ar, si, fmaf(ai, sr, x[2 * pp + 1][r]));
                    sr = nr; si = ni; x[2 * pp][r] = sr; x[2 * pp + 1][r] = si;
                }
                float wr_ = __shfl(sr, c), wi_ = __shfl(si, c);
                if (hi == 0) { wr_ = 0.f; wi_ = 0.f; }
#pragma unroll
                for (int r = 0; r < 16; ++r) {
                    const float tr = fmaf(ar, wr_, -ai * wi_), ti = fmaf(ar, wi_, ai * wr_); wr_ = tr; wi_ = ti;
                    x[2 * pp][r] += wr_; x[2 * pp + 1][r] += wi_;
                }
                car[pp][0] = __shfl(x[2 * pp][15], c + 32); car[pp][1] = __shfl(x[2 * pp + 1][15], c + 32);
#pragma unroll
                for (int r = 0; r < 16; ++r) Hs[(16 * hi + r) * 68 + c + 32 * pp] = cvt_pk_bf16(x[2 * pp][r], x[2 * pp + 1][r]);
            }
            LDS_WAIT(); asm volatile("" ::: "memory");
#pragma unroll
            for (int mt = 0; mt < 2; ++mt) {
                f32x4 y = (f32x4){0.f, 0.f, 0.f, 0.f};
#pragma unroll
                for (int ks = 0; ks < 4; ++ks) {
                    const bf16x8 af = *(const LAS bf16x8*)(Hs + (16 * mt + (lane & 15)) * 68 + 16 * ks + 4 * (lane >> 4));
                    y = __builtin_amdgcn_mfma_f32_16x16x32_bf16(af, cfr[ks], y, 0, 0, 0);
                }
#pragma unroll
                for (int i = 0; i < 4; ++i) { const int pos = 16 * mt + 4 * (lane >> 4) + i; const float nb_ = __shfl_xor(y[i], 1);
                    if ((lane & 1) == 0) Y[(size_t)s5_token(d, j0 + pos) * 8 + ((lane & 15) >> 1)] = cvt_pk_bf16(y[i], nb_); }
            }
            LDS_WAIT(); asm volatile("" ::: "memory");
          }
        }
    }
    __builtin_amdgcn_s_setprio(0);
    convert_weights(a, lds + wave * 8704, lane, blockIdx.x * 4 + wave, gridDim.x * 4, false, CONV_SPLIT, MK_LAYERS, CONV_SCAN_SHARE, 1 << 30);
}

constexpr int RW_STRIDE = 2064;
__device__ __forceinline__ void phase_router(KArgs a, LAS unsigned char* lds, int layer, int tid, int lane, int wave) {
    const int G = gridDim.x, bx = blockIdx.x;
    const bool last = layer >= MK_LAYERS - 2;
    LAS unsigned char* Wl = lds;
    LAS int* ent_e = (LAS int*)(lds + RSCR_OFF); LAS float* ent_g = (LAS float*)(lds + RSCR_OFF + RPB_MAX * 16);
    LAS int* lcount = (LAS int*)(lds + RSCR_OFF + RPB_MAX * 32); LAS int* lbase = lcount + 32; LAS int* lfill = lcount + 64;
    { const u32x4* src = (const u32x4*)(a->ws + WS_RT) + (size_t)layer * 4096;
      for (int p = tid; p < 4096; p += NTHR) *(LAS u32x4*)(Wl + (p >> 7) * RW_STRIDE + (p & 127) * 16) = src[p]; }
    if (tid < 32) { lcount[tid] = 0; lfill[tid] = 0; }
    __syncthreads();
    const bool lat_deal = last && G == NB * 32;
    const int rpb = lat_deal ? 128 : (NR + G - 1) / G, row0 = lat_deal ? (bx >> 5) * SEG + CTXL + (bx & 31) * 128 : bx * rpb, row1 = lat_deal ? row0 + 128 : min(NR, row0 + rpb), nrows = row1 - row0;
    const float* g2 = a->in[I_N2G] + layer * DM; const float* rb = a->in[I_RB] + layer * 32;
    LAS unsigned char* Hl = lds + 32 * RW_STRIDE;
    const int s_row0 = row0 - (row0 / SEG) * SEG;
    const int hi = lane >> 5, tk = lane & 31;
    u32x2 xw[4][4];
#define RT_LOAD(g_) do { _Pragma("unroll") for (int q_ = 0; q_ < 4; ++q_) { const int lr_ = 32 * (g_) + 8 * q_ + wave; if (lr_ < nrows) { \
        const bf16* xr_ = (const bf16*)(a->ws + WS_XS) + (size_t)(row0 + lr_) * DM; _Pragma("unroll") for (int j_ = 0; j_ < 4; ++j_) xw[q_][j_] = *(const GAS u32x2*)(xr_ + 256 * j_ + 4 * lane); } } } while (0)
    RT_LOAD(0);
    const int ngroups = (nrows + 31) >> 5;
    for (int g = 0; g < ngroups; ++g) {
#pragma unroll
        for (int q = 0; q < 4; ++q) {
            const int lr = 32 * g + 8 * q + wave;
            if (lr < nrows) {
                int sl = s_row0 + lr; int bb = row0 / SEG; if (sl >= SEG) { sl -= SEG; bb += 1; }
                if (!(last && sl < CTXL)) {
                    const float* md = mods_ptr(a, layer, sl < CTXL ? 8 : bb);
                    f32x4 v[4];
#pragma unroll
                    for (int j = 0; j < 4; ++j) v[j] = bf4_to_f32(xw[q][j]);
                    norm_mod<false>(v, lane, g2, md + 3 * DM, md + 4 * DM);
                    unsigned char* o8 = a->ws + WS_B3F + (size_t)(row0 + lr) * DM;
#pragma unroll
                    for (int j = 0; j < 4; ++j) { *(LAS u32x2*)(Hl + (8 * q + wave) * RW_STRIDE + (256 * j + 4 * lane) * 2) = f32_to_bf4(v[j]);
                        if constexpr (MOE1_FMT != 2) *(GAS unsigned*)(o8 + 256 * j + 4 * lane) = cvt_pk4_fp8(v[j].x, v[j].y, v[j].z, v[j].w); }
                }
            }
        }
        if (g + 1 < ngroups) RT_LOAD(g + 1);
        LDS_WAIT(); __syncthreads();
        if constexpr (MOE1_FMT == 2) {
#pragma unroll
            for (int ps = 0; ps < 2; ++ps) {
                const int lr32 = 4 * wave + 2 * ps + (lane >> 5), lr = 32 * g + lr32, c = lane & 31;
                if (lr < nrows) {
                    const LAS unsigned char* hp = Hl + lr32 * RW_STRIDE + c * 64;
                    const u32x4 w0 = *(const LAS u32x4*)hp, w1 = *(const LAS u32x4*)(hp + 16), w2 = *(const LAS u32x4*)(hp + 32), w3 = *(const LAS u32x4*)(hp + 48);
                    const v16u32 x = {w0.x, w0.y, w0.z, w0.w, w1.x, w1.y, w1.z, w1.w, w2.x, w2.y, w2.z, w2.w, w3.x, w3.y, w3.z, w3.w};
                    fp6_chunk_store(x, a->ws + WS_B3F + (size_t)(row0 + lr) * DM, c);
                }
            }
        }
        if (wave == (g & 7)) {
            const int lrow = 32 * g + tk; const bool inrange = lrow < nrows;
            bool valid = inrange; { int sl_ = s_row0 + lrow; if (sl_ >= SEG) sl_ -= SEG; if (last && sl_ < CTXL) valid = false; }
            const LAS unsigned char* hp = Hl + tk * RW_STRIDE + 16 * hi;
            const LAS unsigned char* wp = Wl + tk * RW_STRIDE + 16 * hi;
            f32x16 acc = f32x16{}, acc1 = f32x16{};
#pragma unroll 4
            for (int s0 = 0; s0 < 64; s0 += 2) {
                const bf16x8 af0 = *(const LAS bf16x8*)(wp + 32 * s0), bf0 = *(const LAS bf16x8*)(hp + 32 * s0), af1 = *(const LAS bf16x8*)(wp + 32 * s0 + 32), bf1 = *(const LAS bf16x8*)(hp + 32 * s0 + 32);
                acc = __builtin_amdgcn_mfma_f32_32x32x16_bf16(af0, bf0, acc, 0, 0, 0); acc1 = __builtin_amdgcn_mfma_f32_32x32x16_bf16(af1, bf1, acc1, 0, 0, 0); }
            acc = acc + acc1;
            float NEG = -3.0e38f; asm volatile("" : "+v"(NEG));
            float v[16];
#pragma unroll
            for (int r = 0; r < 16; ++r) v[r] = acc[r] + rb[(r & 3) + 8 * (r >> 2) + 4 * hi];
            float cv[8]; int ce[8];
#pragma unroll
            for (int k = 0; k < 4; ++k) {
                float best = NEG; int bi = 0;
#pragma unroll
                for (int r = 0; r < 16; ++r) if (v[r] > best) { best = v[r]; bi = r; }
#pragma unroll
                for (int r = 0; r < 16; ++r) if (r == bi) v[r] = NEG;
                cv[k] = best; ce[k] = (bi & 3) + 8 * (bi >> 2) + 4 * hi;
            }
#pragma unroll
            for (int k = 0; k < 4; ++k) { cv[4 + k] = __shfl_xor(cv[k], 32); ce[4 + k] = __shfl_xor(ce[k], 32); }
            float sv[4]; int se[4];
#pragma unroll
            for (int k = 0; k < 4; ++k) {
                float best = NEG; int be = 64, bi = 0;
#pragma unroll
                for (int q = 0; q < 8; ++q) if (cv[q] > best || (cv[q] == best && ce[q] < be)) { best = cv[q]; be = ce[q]; bi = q; }
#pragma unroll
                for (int q = 0; q < 8; ++q) if (q == bi) cv[q] = NEG;
                sv[k] = best; se[k] = be;
            }
            if (hi == 0 && inrange) {
                const float e1 = __expf(sv[1] - sv[0]), e2 = __expf(sv[2] - sv[0]), e3 = __expf(sv[3] - sv[0]);
                const float isum = 1.f / (1.f + e1 + e2 + e3);
                const int inv = valid ? 0 : -1;
                ent_e[lrow * 4 + 0] = se[0] | inv; ent_g[lrow * 4 + 0] = isum;
                ent_e[lrow * 4 + 1] = se[1] | inv; ent_g[lrow * 4 + 1] = e1 * isum;
                ent_e[lrow * 4 + 2] = se[2] | inv; ent_g[lrow * 4 + 2] = e2 * isum;
                ent_e[lrow * 4 + 3] = se[3] | inv; ent_g[lrow * 4 + 3] = e3 * isum;
                if (valid) {
#pragma unroll
                    for (int k = 0; k < 4; ++k) atomicAdd((int*)&lcount[se[k]], 1);
                }
            }
        }
        LDS_WAIT(); __syncthreads();
    }
#undef RT_LOAD
    __syncthreads();
    unsigned* cnt = (unsigned*)(a->ws + WS_CTL) + CW_CNT + layer * 32;
    if (tid < 32) lbase[tid] = (int)__hip_atomic_fetch_add(cnt + tid, (unsigned)lcount[tid], __ATOMIC_RELAXED, __HIP_MEMORY_SCOPE_AGENT);
    __syncthreads();
    int* list = (int*)(a->ws + WS_LIST); float* gate = (float*)(a->ws + WS_GATE);
    for (int i = tid; i < (row1 - row0) * 4; i += NTHR) {
        const int e = ent_e[i];
        if (e >= 0) { const int pos = lbase[e] + atomicAdd((int*)&lfill[e], 1); const int ent = (row0 + (i >> 2)) * 4 + (i & 3); list[(size_t)e * NR + pos] = ent; gate[(size_t)e * NR + pos] = ent_g[i]; }
    }
    __syncthreads();
}

typedef f32x4 AccT[2][2][4][2];
struct EpiResid {
    static constexpr int PERM = 2;
    bf16* xs; const float* mods_layer; const float* pscale;
    const float* in_x; const float* in_ctx;
    const bf16* src_bf;
    __device__ __forceinline__ void operator()(const AccT& acc, const pg8::Unit& u, int wr, int wc, int fr, int fq, const LAS int* tab) const {
        const int tile = u.pm, bb = tile / 17, tt = tile - bb * 17, mrow = tt == 0 ? 8 : bb;
        const float* gate = mods_layer + (size_t)mrow * NMOD + 2 * DM;
        const float* srcf = in_x ? (tt == 0 ? in_ctx + (size_t)bb * CTXL * DM : in_x + ((size_t)bb * SEQ + (tt - 1) * 256) * DM) : nullptr;
        bf16* dst = xs + (size_t)tile * 256 * DM; const bf16* srcb = (src_bf ? src_bf : xs) + (size_t)tile * 256 * DM;
        const int col0 = u.pn * 256 + wc * 64 + fq * 16;
        f32x4 gv[2][2];
#pragma unroll
        for (int bj = 0; bj < 2; ++bj)
#pragma unroll
            for (int n = 0; n < 2; ++n) { gv[bj][n] = *(const GAS f32x4*)(gate + col0 + 8 * bj + 4 * n); if (pscale) gv[bj][n] = gv[bj][n] * *(const GAS f32x4*)(pscale + col0 + 8 * bj + 4 * n); }
#pragma unroll
        for (int ai = 0; ai < 2; ++ai)
#pragma unroll
            for (int m = 0; m < 4; ++m) {
                const size_t o = (size_t)(ai * 128 + wr * 64 + m * 16 + fr) * DM + col0;
                f32x4 x[2][2];
                if (srcf) {
#pragma unroll
                    for (int bj = 0; bj < 2; ++bj)
#pragma unroll
                        for (int n = 0; n < 2; ++n) x[bj][n] = *(const GAS f32x4*)(srcf + o + 8 * bj + 4 * n);
                } else {
#pragma unroll
                    for (int bj = 0; bj < 2; ++bj) { const u32x4 w = *(const GAS u32x4*)(srcb + o + 8 * bj); x[bj][0] = bf4_to_f32((u32x2){w.x, w.y}); x[bj][1] = bf4_to_f32((u32x2){w.z, w.w}); }
                }
#pragma unroll
                for (int bj = 0; bj < 2; ++bj) { const u32x2 lo = f32_to_bf4(x[bj][0] + gv[bj][0] * acc[ai][bj][m][0]), hi2 = f32_to_bf4(x[bj][1] + gv[bj][1] * acc[ai][bj][m][1]);
                    *(GAS u32x4*)(dst + o + 8 * bj) = (u32x4){lo.x, lo.y, hi2.x, hi2.y}; }
            }
    }
};
struct EpiGlu {
    static constexpr int PERM = 1;
    bf16* xs; const float* mods_layer; const float* bias;
    __device__ __forceinline__ void operator()(const AccT& acc, const pg8::Unit& u, int wr, int wc, int fr, int fq, const LAS int* tab) const {
        const int tile = u.pm, mrow = (tile % 17 == 0) ? 8 : tile / 17;
        const float* gate = mods_layer + (size_t)mrow * NMOD + 2 * DM;
        const int col0 = u.pn * 128 + wc * 32 + 8 * fq;
        f32x4 gv[2], bv[2], bg[2];
#pragma unroll
        for (int n = 0; n < 2; ++n) { gv[n] = *(const GAS f32x4*)(gate + col0 + 4 * n); bv[n] = *(const GAS f32x4*)(bias + col0 + 4 * n); bg[n] = *(const GAS f32x4*)(bias + DM + col0 + 4 * n); }
#pragma unroll
        for (int ai = 0; ai < 2; ++ai)
#pragma unroll
            for (int m = 0; m < 4; ++m) {
                bf16* p = xs + (size_t)(tile * 256 + ai * 128 + wr * 64 + m * 16 + fr) * DM + col0;
                const u32x4 w = *(const GAS u32x4*)p;
                f32x4 x[2] = {bf4_to_f32((u32x2){w.x, w.y}), bf4_to_f32((u32x2){w.z, w.w})};
                u32x2 ow[2];
#pragma unroll
                for (int n = 0; n < 2; ++n) {
                    const f32x4 val = acc[ai][0][m][n] + bv[n], gt = acc[ai][1][m][n] + bg[n];
                    f32x4 o; o.x = val.x * sigmoidf_(gt.x); o.y = val.y * sigmoidf_(gt.y); o.z = val.z * sigmoidf_(gt.z); o.w = val.w * sigmoidf_(gt.w);
                    ow[n] = f32_to_bf4(x[n] + gv[n] * o);
                }
                *(GAS u32x4*)p = (u32x4){ow[0].x, ow[0].y, ow[1].x, ow[1].y};
            }
    }
};
struct EpiQkv {
    static constexpr int PERM = 2;
    bf16* q; bf16* k; bf16* v;
    __device__ __forceinline__ void operator()(const AccT& acc, const pg8::Unit& u, int wr, int wc, int fr, int fq, const LAS int* tab) const {
        bf16* base = u.pn < 4 ? q + u.pn * 256 : (u.pn == 4 ? k : v); const int ldc = u.pn < 4 ? 1024 : 256;
#pragma unroll
        for (int ai = 0; ai < 2; ++ai)
#pragma unroll
            for (int m = 0; m < 4; ++m) { bf16* rowp = base + (size_t)(u.pm * 256 + ai * 128 + wr * 64 + m * 16 + fr) * ldc + wc * 64 + 16 * fq;
#pragma unroll
                for (int bj = 0; bj < 2; ++bj) { const f32x4 v0 = acc[ai][bj][m][0], v1 = acc[ai][bj][m][1];
                    u32x4 w; w.x = cvt_pk_bf16(v0[0], v0[1]); w.y = cvt_pk_bf16(v0[2], v0[3]); w.z = cvt_pk_bf16(v1[0], v1[1]); w.w = cvt_pk_bf16(v1[2], v1[3]);
                    *(GAS u32x4*)(rowp + bj * 8) = w; } }
    }
};
struct EpiMoe1 {
    static constexpr int PERM = 1;
    unsigned char* act;
    __device__ __forceinline__ void operator()(const AccT& acc, const pg8::Unit& u, int wr, int wc, int fr, int fq, const LAS int* tab) const {
        const int cl = wc * 32 + 8 * fq, col0 = u.pn * 128 + cl;
        const LAS float* bt = (const LAS float*)(tab + 512);
        float c7 = 7.0f, ck = -2.4554669595930156f; asm volatile("" : "+v"(c7), "+v"(ck));
        f32x4 bg[2], bl[2];
#pragma unroll
        for (int n = 0; n < 2; ++n) { bg[n] = *(const LAS f32x4*)(bt + cl + 4 * n); bl[n] = *(const LAS f32x4*)(bt + 128 + cl + 4 * n); }
#pragma unroll
        for (int ai = 0; ai < 2; ++ai)
#pragma unroll
            for (int m = 0; m < 4; ++m) {
                float o[8];
#pragma unroll
                for (int n = 0; n < 2; ++n)
#pragma unroll
                    for (int jp = 0; jp < 2; ++jp) {
                        f32x2 g = (f32x2){acc[ai][0][m][n][2 * jp], acc[ai][0][m][n][2 * jp + 1]} + (f32x2){bg[n][2 * jp], bg[n][2 * jp + 1]};
                        f32x2 l = (f32x2){acc[ai][1][m][n][2 * jp], acc[ai][1][m][n][2 * jp + 1]} + (f32x2){bl[n][2 * jp], bl[n][2 * jp + 1]};
                        g.x = fminf(g.x, c7); g.y = fminf(g.y, c7);
                        l.x = __builtin_amdgcn_fmed3f(l.x, -c7, c7); l.y = __builtin_amdgcn_fmed3f(l.y, -c7, c7);
                        f32x2 t = g * ck;
                        t.x = __builtin_amdgcn_exp2f(t.x); t.y = __builtin_amdgcn_exp2f(t.y);
                        t = t + 1.0f;
                        t.x = __builtin_amdgcn_rcpf(t.x); t.y = __builtin_amdgcn_rcpf(t.y);
                        const f32x2 r = (g * t) * (l + 1.0f);
                        o[4 * n + 2 * jp] = r.x; o[4 * n + 2 * jp + 1] = r.y;
                    }
                u32x2 w; w.x = cvt_pk4_fp8(o[0], o[1], o[2], o[3]); w.y = cvt_pk4_fp8(o[4], o[5], o[6], o[7]);
                *(GAS u32x2*)(act + (size_t)(u.pm * 256 + ai * 128 + wr * 64 + m * 16 + fr) * DFF + col0) = w;
            }
    }
};
struct EpiNull {
    static constexpr int PERM = 1;
    float* sink;
    __device__ __forceinline__ void operator()(const AccT& acc, const pg8::Unit& u, int wr, int wc, int fr, int fq, const LAS int* tab) const {
        f32x4 s = (f32x4){0.f, 0.f, 0.f, 0.f};
#pragma unroll
        for (int ai = 0; ai < 2; ++ai)
#pragma unroll
            for (int bj = 0; bj < 2; ++bj)
#pragma unroll
                for (int m = 0; m < 4; ++m)
#pragma unroll
                    for (int n = 0; n < 2; ++n) s = s + acc[ai][bj][m][n];
        sink[(size_t)(u.pm * 256 + wr * 64 + fr) * 64 + wc * 16 + fq * 4 + (u.pn & 3)] = (s.x + s.y) + (s.z + s.w);
    }
};
struct EpiMoe2 {
    static constexpr int PERM = 2;
    unsigned char* yb;
    __device__ __forceinline__ void operator()(const AccT& acc, const pg8::Unit& u, int wr, int wc, int fr, int fq, const LAS int* tab) const {
        const int cl = wc * 64 + 16 * fq, col0 = u.pn * 256 + cl;
        const LAS float* bt = (const LAS float*)(tab + 512); const LAS float* gt = (const LAS float*)(tab + 256);
        f32x4 bv[2][2];
#pragma unroll
        for (int bj = 0; bj < 2; ++bj)
#pragma unroll
            for (int n = 0; n < 2; ++n) bv[bj][n] = *(const LAS f32x4*)(bt + cl + 8 * bj + 4 * n);
#pragma unroll
        for (int ai = 0; ai < 2; ++ai)
#pragma unroll
            for (int m = 0; m < 4; ++m) {
                const int rl = ai * 128 + wr * 64 + m * 16 + fr;
                const int ent = (u.rb * 256 + rl < u.cnt) ? tab[rl] : NR * 4; const float g = gt[rl] * Y8_SCALE;
                u32x4 w;
#pragma unroll
                for (int bj = 0; bj < 2; ++bj) { const f32x4 v0 = (acc[ai][bj][m][0] + bv[bj][0]) * g, v1 = (acc[ai][bj][m][1] + bv[bj][1]) * g;
                    w[2 * bj] = cvt_pk4_fp8(v0[0], v0[1], v0[2], v0[3]); w[2 * bj + 1] = cvt_pk4_fp8(v1[0], v1[1], v1[2], v1[3]); }
                *(GAS u32x4*)(yb + (size_t)ent * DM + col0) = w;
            }
    }
};

constexpr int PH_PER_LAYER = 8, PH_FINAL = 1 + MK_LAYERS * PH_PER_LAYER, N_PHASES = PH_FINAL + 1;

__global__ void __launch_bounds__(NTHR, 2) mega_fwd(Args args_byval) {
    KArgs args = (KArgs)__builtin_amdgcn_kernarg_segment_ptr();
    extern __shared__ __attribute__((aligned(16))) unsigned char lds_raw[];
    LAS unsigned char* lds = (LAS unsigned char*)lds_raw;
    int tid = threadIdx.x, lane = tid & 63, wave = __builtin_amdgcn_readfirstlane(tid >> 6);
    const int G = gridDim.x, bx = blockIdx.x;
    volatile LAS unsigned* MISC = (volatile LAS unsigned*)(lds + MISC_OFF);
    if (tid < 16) MISC[tid] = 0u;
    __syncthreads();
    unsigned* ctl = (unsigned*)(args->ws + WS_CTL);
    XcdBarrier bar; bar.bar = ctl + CW_BAR; bar.x = 0; bar.st = nullptr;
    if (!MK_SPLIT) bar = xcd_barrier_post(ctl + CW_BAR, MISC);
    const int lo = args->ph_lo, hi = args->ph_hi;
#define IN(k) (lo <= (k) && (k) < hi)
#define SEAM(k) do { if (!MK_SPLIT && (k) + 1 < hi) xcd_barrier(bar); } while (0)
    LAS int* rowtab = (LAS int*)(lds + ROWTAB_OFF);

    if (IN(0)) { if (EN(0)) for (int rep = 0; rep < NREP(0); ++rep) prologue(args, lds, tid, lane, wave); }
    if (!MK_SPLIT) xcd_barrier_census(bar);
    if (IN(0)) SEAM(0);

    for (int layer = 0; layer < MK_LAYERS; ++layer) {
        const int kind = layer % 3, base = 1 + layer * PH_PER_LAYER;
        asm volatile("" : "+s"(args));
        tid = threadIdx.x; asm volatile("" : "+v"(tid)); lane = tid & 63; wave = __builtin_amdgcn_readfirstlane(tid >> 6);
        const float* mods_layer = (const float*)(args->ws + WS_MODS) + (size_t)layer * 9 * NMOD;
        bf16* xs = (bf16*)(args->ws + WS_XS);
        if (IN(base + 0)) {
            if (EN(1)) { if (kind == 1) phase_norm1<true>(args, layer, lane, wave); else if (kind == 2) phase_norm1<false>(args, layer, lane, wave); }
            if (kind != 0) SEAM(base + 0);
        }
        if (IN(base + 1)) {
            if (kind == 0) { if (EN(2)) phase_norm1_pooldiff(args, lds, layer, tid, lane, wave); }
            else if (kind == 1) { if (EN(3)) for (int rep = 0; rep < NREP(3); ++rep) phase_s5_scan(args, lds, lane, wave); }
            else if (EN(4)) for (int rep = 0; rep < NREP(4); ++rep) {
                pg8::StaticSchedG S{{(const char*)(args->ws + WS_B1), (const char*)(args->ws + WS_WQKV), (size_t)256 * DM, (size_t)256 * DM, NTILE, 6, NTILE * 6, G, bx, 0, 0}};
                EpiQkv E{(bf16*)(args->ws + WS_B2), (bf16*)(args->ws + WS_KB), (bf16*)(args->ws + WS_VB)};
                pg8::gemm_phase<EpiQkv, pg8::StaticSchedG, true, true>(tid, lds, rowtab, DM / 2, DM / 2, DM / 2, S, E);
            }
            SEAM(base + 1);
        }
        if (IN(base + 2)) {
            if (kind == 0) { if (EN(5)) for (int rep = 0; rep < NREP(5); ++rep) {
                const int j = layer / 3;
                pg8::StaticSchedG S{{(const char*)(args->ws + WS_B2), (const char*)(args->ws + WS_POOLW) + (size_t)j * 4 * 65536, (size_t)256 * DM, (size_t)256 * 256, NTILE, 4, NTILE * 4, G, bx, (size_t)256, 0}};
                EpiResid E{rep + 1 < NREP(5) ? (bf16*)(args->ws + WS_YG) : xs, mods_layer, args->in[I_POOLS] + j * DM, layer == 0 ? args->in[I_X] : nullptr, args->in[I_CTX], layer == 0 ? nullptr : (const bf16*)(args->ws + WS_B1)};
                pg8::gemm_phase<EpiResid, pg8::StaticSchedG, true, true>(tid, lds, rowtab, DM / 2, 128, 128, S, E);
            } } else if (kind == 1) { if (EN(6)) for (int rep = 0; rep < NREP(6); ++rep) phase_s5_readout(args, layer, lane, wave); }
            else { if (EN(7)) phase_qkpost(args, lds, tid, lane, wave); }
            SEAM(base + 2);
        }
        if (IN(base + 3) && kind != 0) {
            if (kind == 1) { if (EN(8)) for (int rep = 0; rep < NREP(8); ++rep) {
                pg8::StaticSchedG S{{(const char*)(args->ws + WS_B2), (const char*)(args->ws + WS_GLUW), (size_t)256 * DM, (size_t)256 * DM, NTILE, 8, NTILE * 8, G, bx, 0, 0}};
                EpiGlu E{rep + 1 < NREP(8) ? (bf16*)(args->ws + WS_YG) : xs, mods_layer, args->in[I_GLUB]};
                pg8::gemm_phase<EpiGlu, pg8::StaticSchedG, true, true>(tid, lds, rowtab, DM / 2, DM / 2, DM / 2, S, E);
            } } else if (EN(9)) for (int rep = 0; rep < NREP(9); ++rep) {
                const bf16* Q = (const bf16*)(args->ws + WS_B2); const unsigned char* Kb = args->ws + WS_B3  ; const unsigned char* Vt = args->ws + WS_YG  ; unsigned char* O = args->ws + WS_B1;
                const int vcu = (G % 8 == 0) ? (bx % 8) * (G / 8) + bx / 8 : bx;
                float gqm = fmaxf(fabsf(args->in[I_QG][lane]), fabsf(args->in[I_QG][lane + 64])), gkm = fmaxf(fabsf(args->in[I_KG][lane]), fabsf(args->in[I_KG][lane + 64]));
#pragma unroll
                for (int o_ = 1; o_ < 64; o_ <<= 1) { gqm = fmaxf(gqm, __shfl_xor(gqm, o_)); gkm = fmaxf(gkm, __shfl_xor(gkm, o_)); }
                const float mnC = __uint_as_float(__builtin_amdgcn_readfirstlane(__float_as_uint(-(128.0f * 1.02f) * gqm * gkm * (att::SCALE * 1.4426950408889634f))));
                for (int u = vcu; u < 1024; u += G) {
                    const int grp = u >> 6, b = grp >> 1, kvh = grp & 1, h = kvh * 4 + ((u & 63) >> 4), qb = u & 15;
                    const size_t qrow = (size_t)b * SEG + CTXL + qb * 256, krow = (size_t)b * SEG;
                    att::attn_dense_body(tid, Q + qrow * DM + h * 128, Kb + krow * 256 + kvh * 128, Vt + (size_t)(b * 2 + kvh) * 68 * att::V8T_TILE_, O + qrow * DM + h * 128, SEG, (char*)lds_raw, args->in[I_QG], (const f32x2*)(args->ws + WS_ROPE), qb * 256, mnC);
                }
                if constexpr (MK_LAYERS > 4) if (MK_LAYERS - layer > 2) for (int u = vcu; u < 64; u += G) {
                    const int b = u >> 3, h = u & 7, kvh = h >> 2;
                    const size_t qrow = (size_t)b * SEG;
                    att::attn_dense_body(tid, Q + qrow * DM + h * 128, Kb + qrow * 256 + kvh * 128, Vt + (size_t)(b * 2 + kvh) * 68 * att::V8T_TILE_, O + qrow * DM + h * 128, CTXL, (char*)lds_raw, args->in[I_QG], (const f32x2*)(args->ws + WS_ROPE), -1, mnC);
                }
            }
            SEAM(base + 3);
        }
        if (IN(base + 4) && kind == 2) { if (EN(10)) for (int rep = 0; rep < NREP(10); ++rep) {
            pg8::StaticSchedG S{{(const char*)(args->ws + WS_B1), (const char*)(args->ws + WS_WO), (size_t)256 * DM, (size_t)256 * DM, 128, 4, 128 * 4, G, bx, 0, 1}};
            EpiResid E{rep + 1 < NREP(10) ? (bf16*)(args->ws + WS_YG) : xs, mods_layer, nullptr, nullptr, nullptr, nullptr};
            pg8::gemm_phase<EpiResid, pg8::StaticSchedG, true, true>(tid, lds, rowtab, DM / 2, DM / 2, DM / 2, S, E); }
            SEAM(base + 4);
        }
        if (IN(base + 5)) { if (EN(11)) phase_router(args, lds, layer, tid, lane, wave); SEAM(base + 5); }
        if (IN(base + 6) || IN(base + 7)) {
            const unsigned* cnt = (const unsigned*)(args->ws + WS_CTL) + CW_CNT + layer * 32;
            const int cntl = (int)__hip_atomic_load(cnt + (lane & 31), __ATOMIC_RELAXED, __HIP_MEMORY_SCOPE_AGENT);
            const int nrb = (cntl + 255) >> 8;
            int incl = nrb;
#pragma unroll
            for (int o = 1; o < 32; o <<= 1) { const int t = __shfl_up(incl, o, 32); if ((lane & 31) >= o) incl += t; }
            const int pbl = incl - nrb, TB = __builtin_amdgcn_readlane(incl, 31);
            if (IN(base + 6)) { if (EN(12)) for (int rep = 0; rep < NREP(12); ++rep) {
                pg8::MoeSched<1> S{(const char*)(args->ws + WS_B3F), (const char*)(args->ws + WS_W1T) + (size_t)layer * 32 * 2048 * 1024, 0, (size_t)256 * DM, (size_t)2048 * 1024,
                                (const int*)(args->ws + WS_LIST), (const float*)(args->ws + WS_GATE), args->in[I_B1] + (size_t)layer * 32 * 2048, 8, TB * 8, G, bx, pbl, cntl};
                EpiMoe1 E{args->ws + WS_ACT};
                pg8::gemm_phase<EpiMoe1, pg8::MoeSched<1>, true, MOE1_FMT>(tid, lds, rowtab, DM / 2, DM / 2, DM / 2, S, E); }
                if (MK_PROBE_NULL) {
                    pg8::MoeSched<1> S{(const char*)(args->ws + WS_B3F), (const char*)(args->ws + WS_W1T) + (size_t)layer * 32 * 2048 * 1024, 0, (size_t)256 * DM, (size_t)2048 * 1024,
                                    (const int*)(args->ws + WS_LIST), (const float*)(args->ws + WS_GATE), args->in[I_B1] + (size_t)layer * 32 * 2048, 8, TB * 8, G, bx, pbl, cntl};
                    EpiNull E{(float*)(args->ws + WS_YG)};
                    pg8::gemm_phase<EpiNull, pg8::MoeSched<1>, true, MOE1_FMT>(tid, lds, rowtab, DM / 2, DM / 2, DM / 2, S, E);
                }
                SEAM(base + 6);
            }
            if (IN(base + 7)) { if (EN(13)) for (int rep = 0; rep < NREP(13); ++rep) {
                pg8::MoeSched<2> S{(const char*)(args->ws + WS_ACT), (const char*)(args->ws + WS_W2T) + (size_t)layer * 32 * 1024 * 1024, (size_t)256 * DFF, (size_t)256 * DFF, (size_t)1024 * 1024,
                                (const int*)(args->ws + WS_LIST), (const float*)(args->ws + WS_GATE), args->in[I_B2] + (size_t)layer * 32 * DM, 4, TB * 4, G, bx, pbl, cntl};
                EpiMoe2 E{args->ws + WS_YB};
                pg8::gemm_phase<EpiMoe2, pg8::MoeSched<2>, true, true>(tid, lds, rowtab, DFF / 2, DFF / 2, DFF / 2, S, E); }
                SEAM(base + 7);
            }
        }
    }
    if (IN(PH_FINAL)) { if (EN(14)) phase_final(args, lane, wave); }
#undef IN
#undef SEAM
}

extern "C" void kernel_launch(void* const* d_in, const int* in_sizes, int n_in, void* d_out, int out_size, void* d_ws, size_t ws_size, hipStream_t stream) {
    static int grid = 0;
    if (grid == 0) {
        if (n_in != N_IN || out_size != NB * SEQ * DM || ws_size < WS_END) { fprintf(stderr, "kernel_launch: shape/workspace mismatch: n_in %d out %d ws %zu (need %zu)\n", n_in, out_size, ws_size, (size_t)WS_END); grid = -1; return; }
        int dev = 0, cus = 0, per_cu = 0;
        if (hipGetDevice(&dev) != hipSuccess || hipDeviceGetAttribute(&cus, hipDeviceAttributeMultiprocessorCount, dev) != hipSuccess) { grid = -1; return; }
        if (hipFuncSetAttribute((const void*)mega_fwd, hipFuncAttributeMaxDynamicSharedMemorySize, LDS_BYTES) != hipSuccess) { fprintf(stderr, "kernel_launch: hipFuncSetAttribute failed\n"); grid = -1; return; }
        if (hipOccupancyMaxActiveBlocksPerMultiprocessor(&per_cu, (const void*)mega_fwd, NTHR, LDS_BYTES) != hipSuccess || per_cu < 1) { fprintf(stderr, "kernel_launch: occupancy query reports %d blocks per CU\n", per_cu); }
        (void)hipGetLastError();
        grid = cus;
        if (grid > 256) grid = 256;
    }
    if (grid < 0) return;
    (void)hipMemsetAsync((char*)d_ws + WS_CTL, 0, CTL_BYTES, stream);
    Args a{};
    for (int i = 0; i < N_IN; ++i) a.in[i] = (const float*)d_in[i];
    a.out = (float*)d_out; a.ws = (unsigned char*)d_ws;
#if MK_SPLIT
    for (int p = 0; p < N_PHASES; ++p) { a.ph_lo = p; a.ph_hi = p + 1; hipLaunchKernelGGL(mega_fwd, dim3(grid), dim3(NTHR), LDS_BYTES, stream, a); }
#else
    a.ph_lo = 0; a.ph_hi = N_PHASES;
    hipLaunchKernelGGL(mega_fwd, dim3(grid), dim3(NTHR), LDS_BYTES, stream, a);
#endif
    const hipError_t le = hipPeekAtLastError();
    if (le != hipSuccess) fprintf(stderr, "kernel_launch: launch failed: %s\n", hipGetErrorName(le));
}
```

```cpp
#include <hip/hip_runtime.h>
#include <cstdio>
#include <cstdint>

#ifndef MK_SPLIT
#define MK_SPLIT 0
#endif
#ifndef MK_LAYERS
#define MK_LAYERS 4
#endif
#ifndef MK_EN
#define MK_EN 0xFFFFF
#endif
#define EN(n) ((MK_EN >> (n)) & 1)
#ifndef MK_REP
#define MK_REP 0
#endif
#ifndef MK_PROBE_NULL
#define MK_PROBE_NULL 0
#endif
#define NREP(n) (1 + ((MK_REP >> (n)) & 1))

#define GAS __attribute__((address_space(1)))
#define LAS __attribute__((address_space(3)))
typedef unsigned short bf16;
typedef float f32x4 __attribute__((ext_vector_type(4)));
typedef float f32x2 __attribute__((ext_vector_type(2)));
typedef float f32x16 __attribute__((ext_vector_type(16)));
typedef float f32x8 __attribute__((ext_vector_type(8)));
typedef short bf16x8 __attribute__((ext_vector_type(8)));
typedef short s16x4 __attribute__((ext_vector_type(4)));
typedef unsigned u32x4 __attribute__((ext_vector_type(4)));
typedef unsigned u32x2 __attribute__((ext_vector_type(2)));
typedef int v8i __attribute__((ext_vector_type(8)));
typedef int v4i __attribute__((ext_vector_type(4)));
constexpr float W8_SCALE = 32.0f;
constexpr float Y8_SCALE = 8.0f;

constexpr int DM = 1024, NB = 8, SEQ = 4096, CTXL = 256, SEG = SEQ + CTXL  , NR = NB * SEG  , NTILE = NR / 256  ;
constexpr int NE = 32, TOPK = 4, DFF = 1024, NMOD = 6 * DM;
constexpr int CAPROWS = NR * TOPK + NE * 256;
constexpr float NORM_EPS = 1e-6f;
constexpr int NWAVES = 8, NTHR = 512;

enum { I_X = 0, I_C, I_CTX, I_CCTX, I_ADAW, I_ADAB, I_N1G, I_N2G, I_POOLW, I_POOLS, I_LAMRE, I_LAMIM, I_LOGDT, I_BRE, I_BIM, I_CRE, I_CIM, I_SSMD, I_GLUW, I_GLUB,
       I_WQKV, I_QG, I_KG, I_WO, I_RW, I_RB, I_W1, I_B1, I_W2, I_B2, N_IN };

constexpr size_t al256(size_t x) { return (x + 255) & ~(size_t)255; }
constexpr size_t WS_CTL = 0, CTL_BYTES = 1u << 20;
constexpr size_t WS_MODS = WS_CTL + CTL_BYTES;
constexpr size_t WS_ROPE = al256(WS_MODS + (size_t)4 * 9 * NMOD * 4);
constexpr size_t WS_S5LAM = al256(WS_ROPE + 64 * 32 * 8);
constexpr size_t WS_S5BF = al256(WS_S5LAM + 2 * 64 * 64 * 8);
constexpr size_t WS_S5CF = al256(WS_S5BF + (size_t)2 * 64 * 4 * 64 * 16);
constexpr size_t WS_RT = al256(WS_S5CF + (size_t)2 * 64 * 4 * 64 * 16);
constexpr size_t WS_POOLW = al256(WS_RT + (size_t)4 * 32 * 1024 * 4);
constexpr size_t WS_GLUW = al256(WS_POOLW + (size_t)2 * 4 * 256 * 256 * 2);
constexpr size_t WS_WQKV = al256(WS_GLUW + (size_t)2048 * 1024 * 2);
constexpr size_t WS_WO = al256(WS_WQKV + (size_t)1536 * 1024 * 2);
constexpr size_t WS_GATE = al256(WS_WO + (size_t)1024 * 1024 * 2);
constexpr size_t WS_LIST = al256(WS_GATE + (size_t)32 * NR * 4);
constexpr size_t WS_XS = al256(WS_LIST + (size_t)32 * NR * 4);
constexpr size_t WS_B1 = al256(WS_XS + (size_t)NR * DM * 4);
constexpr size_t WS_B2 = al256(WS_B1 + (size_t)NR * DM * 2);
constexpr size_t WS_B3 = al256(WS_B2 + (size_t)NR * DM * 2);
constexpr size_t WS_KB = al256(WS_B3 + (size_t)NR * DM * 2);
constexpr size_t WS_VB = al256(WS_KB + (size_t)NR * 256 * 2);
constexpr size_t WS_YG = al256(WS_VB + (size_t)NR * 256 * 2);
constexpr size_t WS_ACT = al256(WS_YG + (size_t)2 * NR * DM * 4);
constexpr size_t WS_YB = al256(WS_ACT + (size_t)CAPROWS * DFF * 2);
constexpr size_t WS_B3F = al256(WS_YB + (size_t)(NR * 4 + 1) * DM * 2);
constexpr size_t WS_W1T = al256(WS_B3F + (size_t)NR * DM);
constexpr size_t WS_W2T = al256(WS_W1T + (size_t)4 * 32 * 2048 * 1024);
constexpr size_t WS_END = al256(WS_W2T + (size_t)4 * 32 * 1024 * 1024);

constexpr int CW_CNT = 64;
constexpr int CW_BAR = 4096;

constexpr int RING_BYTES = 131072;
constexpr int ROWTAB_OFF = RING_BYTES;
constexpr int RSCR_OFF = 132096;
constexpr int LDS_BYTES = 147456;
constexpr int MISC_OFF = LDS_BYTES - 64;
constexpr int RPB_MAX = 280;
constexpr int RPART_OFF = RSCR_OFF + RPB_MAX * 4 * 8 + 3 * 32 * 4 + 64;
static_assert(RPART_OFF + 16 * 64 * 4 <= MISC_OFF, "LDS map");

__device__ __forceinline__ unsigned cvt_pk_bf16(float lo, float hi) { unsigned r; asm volatile("v_cvt_pk_bf16_f32 %0, %1, %2" : "=v"(r) : "v"(lo), "v"(hi)); return r; }
__device__ __forceinline__ unsigned cvt_pk4_fp8(float a, float b, float c, float d) { unsigned w = 0; w = __builtin_amdgcn_cvt_pk_fp8_f32(a, b, w, false); w = __builtin_amdgcn_cvt_pk_fp8_f32(c, d, w, true); return w; }
__device__ __forceinline__ float bf_lo(unsigned w) { return __uint_as_float(w << 16); }
__device__ __forceinline__ float bf_hi(unsigned w) { return __uint_as_float(w & 0xffff0000u); }
__device__ __forceinline__ float wave_sum(float v) {
#pragma unroll
    for (int o = 1; o < 64; o <<= 1) v += __shfl_xor(v, o);
    return v;
}
__device__ __forceinline__ float sigmoidf_(float x) { return 1.0f / (1.0f + __expf(-x)); }
#define LDS_WAIT() asm volatile("s_waitcnt lgkmcnt(0)" ::: "memory")
#define VM_WAIT() asm volatile("s_waitcnt vmcnt(0)" ::: "memory")

#define XB_TMO      128
#define XB_XCNT(j)  (256  + 64 * (j))
#define XB_XSUB(j)  (1280 + 64 * (j))
#define XB_XGEN(j)  (2304 + 64 * (j))
#define XB_TOP      3328
#define XB_TOPGEN   3392
#define XCD_BAR_WORDS 3456
#define XB_SPIN_CAP (1u << 18)
__device__ __forceinline__ unsigned xb_ld(unsigned* p)              { return __hip_atomic_load(p, __ATOMIC_RELAXED, __HIP_MEMORY_SCOPE_AGENT); }
__device__ __forceinline__ unsigned xb_add(unsigned* p, unsigned v) { return __hip_atomic_fetch_add(p, v, __ATOMIC_RELAXED, __HIP_MEMORY_SCOPE_AGENT); }
__device__ __forceinline__ unsigned xb_xcc_id() { return (unsigned)__builtin_amdgcn_s_getreg((3 << 11) | 20) & 0xFu; }
#define XB_SPIN(cond, bar) do { unsigned _sp = 0; while (cond) { __builtin_amdgcn_s_sleep(1); \
    if ((++_sp & 255u) == 0u) { if (xb_ld(&(bar)[XB_TMO])) break; if (_sp > XB_SPIN_CAP) { atomicAdd(&(bar)[XB_TMO], 1u); break; } } } } while (0)
struct XcdBarrier { unsigned* bar; unsigned x; volatile LAS unsigned* st; };
__device__ __forceinline__ XcdBarrier xcd_barrier_post(unsigned* bar, volatile LAS unsigned* st) {
    XcdBarrier b; b.bar = bar; b.x = xb_xcc_id(); b.st = st;
    if (threadIdx.x == 0) (void)xb_add(&bar[XB_XCNT(b.x)], 1u);
    return b;
}
__device__ __forceinline__ void xcd_barrier_complete(unsigned* bar, unsigned x, unsigned& nloc, unsigned& nx) {
    const unsigned G = gridDim.x * gridDim.y * gridDim.z;
    unsigned sum, cnt, mine, sp = 0u;
    for (;;) {
        sum = 0u; cnt = 0u; mine = 0u;
#pragma unroll
        for (unsigned j = 0; j < 16; ++j) { const unsigned c = xb_ld(&bar[XB_XCNT(j)]); sum += c; cnt += (c > 0u) ? 1u : 0u; mine = (j == x) ? c : mine; }
        if (sum == G) break;
        __builtin_amdgcn_s_sleep(1);
        if ((++sp & 255u) == 0u) { if (xb_ld(&bar[XB_TMO])) break; if (sp > XB_SPIN_CAP) { atomicAdd(&bar[XB_TMO], 1u); break; } }
    }
    nloc = mine > 0u ? mine : 1u; nx = cnt > 0u ? cnt : 1u;
}
__device__ __forceinline__ void xcd_barrier_census(const XcdBarrier& b) {
    if (threadIdx.x == 0) { unsigned nloc, nx; xcd_barrier_complete(b.bar, b.x, nloc, nx); b.st[0] = nloc; b.st[1] = nx; }
}
__device__ __forceinline__ void xcd_barrier(const XcdBarrier& b) {
    asm volatile("s_waitcnt vmcnt(0)" ::: "memory");
    __syncthreads();
    if (threadIdx.x == 0) {
        unsigned* bar = b.bar; asm volatile("" : "+s"(bar));
        __builtin_amdgcn_s_waitcnt(0);
        unsigned nloc = b.st[0], nx = b.st[1];
        const unsigned old = xb_add(&bar[XB_XSUB(b.x)], 1u);
        const unsigned gen = old / nloc;
        if (old + 1u == (gen + 1u) * nloc) {
            __builtin_amdgcn_fence(__ATOMIC_RELEASE, "agent");
            asm volatile("s_waitcnt vmcnt(0)" ::: "memory");
            const unsigned og = xb_add(&bar[XB_TOP], 1u);
            const unsigned tg = og / nx;
            if (og + 1u == (tg + 1u) * nx) xb_add(&bar[XB_TOPGEN], 1u);
            else XB_SPIN(xb_ld(&bar[XB_TOPGEN]) == tg, bar);
            __builtin_amdgcn_fence(__ATOMIC_ACQUIRE, "agent");
            xb_add(&bar[XB_XGEN(b.x)], 1u);
            asm volatile("s_waitcnt vmcnt(0)" ::: "memory");
        } else {
            XB_SPIN(xb_ld(&bar[XB_XGEN(b.x)]) == gen, bar);
            __builtin_amdgcn_fence(__ATOMIC_ACQUIRE, "agent");
            asm volatile("s_waitcnt vmcnt(0)" ::: "memory");
        }
    }
    __syncthreads();
}

namespace pg8 {
constexpr int BM = 256, BK = 64, HALF = 128, HTB = HALF * BK * 2, STAGE_BYTES = 8 * HTB, NXCD = 8;
__device__ __forceinline__ int lds_byte(int r, int c) { const int st = (r >> 4) * 2 + (c >> 5), rr = r & 15, cc = c & 31, ob = rr * 64 + cc * 2; return st * 1024 + (ob ^ (((ob >> 9) & 1) << 5)); }
__device__ __forceinline__ void stage_rc(int b, int& R, int& C) { const int st = b / 1024, sb = b % 1024, swz = sb ^ (((sb >> 9) & 1) << 5); R = (st >> 1) * 16 + swz / 64; C = (st & 1) * 32 + (swz % 64) / 2; }
__device__ __forceinline__ int perm32(int rho) { const int n = rho >> 4, i = rho & 15; return 8 * (i >> 2) + 4 * n + (i & 3); }

struct Unit { int pm, pn, e, rb, cnt; };

__device__ __forceinline__ int xcd_remap(int L, int nwg) { const int q = nwg / NXCD, r = nwg % NXCD, xcd = L % NXCD, off = L / NXCD; return (xcd < r ? xcd * (q + 1) : r * (q + 1) + (xcd - r) * q) + off; }

template <class Epi, class Sched, bool GATHER, int FP8 = 0>
__device__ __forceinline__ void gemm_phase(const int tid, LAS unsigned char* lds, LAS int* rowtab, const int lda, const int ldb, const int K, const Sched& S, const Epi& E) {
    const int wid = __builtin_amdgcn_readfirstlane(tid >> 6), lane = tid & 63, wr = wid >> 2, wc = wid & 3, fr = lane & 15, fq = lane >> 4;
    int nt = K / BK;
    if (K <= 2 * BK) asm volatile("" : "+s"(nt));
    int Rr[2], Cc[2];
    constexpr int PM = (int)Epi::PERM;
    unsigned voffB[2][2];
#pragma unroll
    for (int i = 0; i < 2; ++i) { stage_rc(tid * 16 + i * 8192, Rr[i], Cc[i]);
        if constexpr (PM == 2) { const int p = perm32(Rr[i] & 31);
#pragma unroll
            for (int bj = 0; bj < 2; ++bj) voffB[bj][i] = (unsigned)((64 * (Rr[i] >> 5) + 16 * (p >> 3) + 8 * bj + (p & 7)) * ldb + Cc[i]) * 2u; }
        else { const int Rb = PM ? ((Rr[i] & ~31) + perm32(Rr[i] & 31)) : Rr[i]; voffB[0][i] = voffB[1][i] = (unsigned)(Rb * ldb + Cc[i]) * 2u; } }
    const size_t kstep = (size_t)(BK * 2);
    const size_t hstepA = GATHER ? 0 : (size_t)HALF * lda * 2, hstepB = PM == 2 ? 0 : (size_t)HALF * ldb * 2;
    const unsigned ldsw = (unsigned)wid * 1024u;
    const int aoff = lds_byte(wr * 64 + fr, fq * 8), boff = lds_byte(wc * 32 + fr, fq * 8);
#define PG8_SA(b, h) (((b) * 2 + (h)) * HTB)
#define PG8_SB(b, h) ((4 + (b) * 2 + (h)) * HTB)
#define PG8_STAGE(bufoff, gbase, voff) do { _Pragma("unroll") for (int _i = 0; _i < 2; ++_i) \
        __builtin_amdgcn_global_load_lds((const unsigned*)((const char*)(gbase) + (voff)[_i]), (LAS unsigned*)(lds + (bufoff) + ldsw + _i * 8192), 16, 0, 0); } while (0)
#define PG8_LDA(dst, b, h) do { _Pragma("unroll") for (int m = 0; m < 4; ++m) _Pragma("unroll") for (int k = 0; k < 2; ++k) dst[m][k] = *(const LAS bf16x8*)(lds + PG8_SA(b, h) + aoff + m * 2048 + k * 1024); } while (0)
#define PG8_LDB(dst, b, h) do { _Pragma("unroll") for (int n = 0; n < 2; ++n) _Pragma("unroll") for (int k = 0; k < 2; ++k) dst[n][k] = *(const LAS bf16x8*)(lds + PG8_SB(b, h) + boff + n * 2048 + k * 1024); } while (0)
#define PG8_MMA(ai, bj, At, Bt) do { __builtin_amdgcn_s_setprio(1); _Pragma("unroll") for (int m = 0; m < 4; ++m) _Pragma("unroll") for (int n = 0; n < 2; ++n) { \
        if constexpr (FP8) { const v8i bv_ = __builtin_shufflevector(__builtin_bit_cast(v4i, Bt[n][0]), __builtin_bit_cast(v4i, Bt[n][1]), 0, 1, 2, 3, 4, 5, 6, 7); \
                             const v8i av_ = __builtin_shufflevector(__builtin_bit_cast(v4i, At[m][0]), __builtin_bit_cast(v4i, At[m][1]), 0, 1, 2, 3, 4, 5, 6, 7); \
                             if constexpr (FP8 == 2) acc[ai][bj][m][n] = __builtin_amdgcn_mfma_scale_f32_16x16x128_f8f6f4(bv_, av_, acc[ai][bj][m][n], 2, 2, 0, bv_[6], 0, av_[6]); \
                             else acc[ai][bj][m][n] = __builtin_amdgcn_mfma_scale_f32_16x16x128_f8f6f4(bv_, av_, acc[ai][bj][m][n], 0, 0, 0, scale_w, 0, scale_x); } \
        else { _Pragma("unroll") for (int k = 0; k < 2; ++k) acc[ai][bj][m][n] = __builtin_amdgcn_mfma_f32_16x16x32_bf16(Bt[n][k], At[m][k], acc[ai][bj][m][n], 0, 0, 0); } } \
        __builtin_amdgcn_s_setprio(0); } while (0)
#define PG8_WAIT_V(n) asm volatile("s_waitcnt vmcnt(" #n ")" ::: "memory")
#define PG8_WAIT_L(n) asm volatile("s_waitcnt lgkmcnt(" #n ")" ::: "memory")
#define PG8_BAR __builtin_amdgcn_s_barrier()
#define PG8_SCHED __builtin_amdgcn_sched_barrier(0)
    Unit cur, nxt; int ui = 0;
    if (!S.next(0, cur)) return;
    int scale_w = 0x7A7A7A7A, scale_x = 0x7F7F7F7F; asm volatile("" : "+v"(scale_w), "+v"(scale_x));
    unsigned vA[2][2];
    constexpr int NTAB = Sched::NTAB;
    if constexpr (NTAB > 0) {
        if (tid < 256) {
#pragma unroll
            for (int sl = 0; sl < 3; ++sl) if (NTAB & (1 << sl)) rowtab[sl * 256 + tid] = (int)*S.tab_src(cur, sl, tid);
        }
        LDS_WAIT(); __syncthreads();
    }
    if constexpr (GATHER) {
#pragma unroll
        for (int h = 0; h < 2; ++h)
#pragma unroll
            for (int i = 0; i < 2; ++i) vA[h][i] = (unsigned)(S.a_rowidx(cur, rowtab, h * 128 + Rr[i]) * lda + Cc[i]) * 2u;
    } else {
#pragma unroll
        for (int h = 0; h < 2; ++h)
#pragma unroll
            for (int i = 0; i < 2; ++i) vA[h][i] = (unsigned)(Rr[i] * lda + Cc[i]) * 2u;
    }
    bf16x8 At[4][2], B0[2][2], B1[2][2];
    const char* cA = S.a_base(cur); const char* cB = S.b_base(cur);
    PG8_STAGE(PG8_SB(0, 0), cB, voffB[0]); PG8_STAGE(PG8_SB(0, 1), cB + hstepB, voffB[1]); PG8_STAGE(PG8_SA(0, 0), cA, vA[0]); PG8_STAGE(PG8_SA(0, 1), cA + hstepA, vA[1]);
    if (wr == 1) PG8_BAR;
    PG8_WAIT_V(2); PG8_BAR;
    PG8_STAGE(PG8_SB(1, 0), cB + kstep, voffB[0]); PG8_STAGE(PG8_SA(1, 0), cA + kstep, vA[0]); PG8_STAGE(PG8_SB(1, 1), cB + hstepB + kstep, voffB[1]);
    PG8_WAIT_V(6); PG8_BAR;
    for (;;) {
        f32x4 acc[2][2][4][2];
#pragma unroll
        for (int a = 0; a < 2; ++a)
#pragma unroll
            for (int b = 0; b < 2; ++b)
#pragma unroll
                for (int m = 0; m < 4; ++m)
#pragma unroll
                    for (int n = 0; n < 2; ++n) acc[a][b][m][n] = (f32x4){0.f, 0.f, 0.f, 0.f};
        const bool has_next = S.next(ui + 1, nxt);
        const char* nA = has_next ? S.a_base(nxt) : cA; const char* nB = has_next ? S.b_base(nxt) : cB;
        if constexpr (NTAB > 0) {
            if (has_next && tid < 256) {
#pragma unroll
                for (int sl = 0; sl < 3; ++sl) if (NTAB & (1 << sl))
                    __builtin_amdgcn_global_load_lds(S.tab_src(nxt, sl, tid), (LAS unsigned*)((LAS unsigned char*)rowtab + (((ui + 1) % 3) * 3072) + sl * 1024 + wid * 256), 4, 0, 0);
            }
        }
#pragma nounroll
        for (int t = 0; t < nt; t += 2) {
            const bool last = (t == nt - 2);
            if constexpr (PM == 2) asm volatile("" : "+v"(voffB[1][0]), "+v"(voffB[1][1])); else { voffB[1][0] = voffB[0][0]; voffB[1][1] = voffB[0][1]; }
            asm volatile("" : "+v"(vA[0][0]), "+v"(vA[0][1]), "+v"(vA[1][0]), "+v"(vA[1][1]), "+v"(voffB[0][0]), "+v"(voffB[0][1]));
            const char* a1 = cA + (size_t)(t + 1) * kstep;
            const char* a2 = last ? nA : cA + (size_t)(t + 2) * kstep; const char* b2 = last ? nB : cB + (size_t)(t + 2) * kstep;
            const char* a3 = a2 + kstep; const char* b3 = b2 + kstep;
            PG8_LDB(B0, 0, 0); PG8_LDB(B1, 0, 1); PG8_SCHED; PG8_LDA(At, 0, 0); PG8_STAGE(PG8_SA(1, 1), a1 + hstepA, vA[1]);
            if constexpr (GATHER) {
                if (last && has_next) {
                    LAS int* rt = rowtab + ((ui + 1) % 3) * 768;
#pragma unroll
                    for (int h = 0; h < 2; ++h)
#pragma unroll
                        for (int i = 0; i < 2; ++i) vA[h][i] = (unsigned)(S.a_rowidx(nxt, rt, h * 128 + Rr[i]) * lda + Cc[i]) * 2u;
                }
            }
            PG8_WAIT_V(8); PG8_WAIT_L(0); PG8_BAR; PG8_MMA(0, 0, At, B0); PG8_MMA(0, 1, At, B1); PG8_BAR; PG8_SCHED;
            PG8_LDA(At, 0, 1); PG8_STAGE(PG8_SB(0, 0), b2, voffB[0]); PG8_STAGE(PG8_SB(0, 1), b2 + hstepB, voffB[1]); PG8_STAGE(PG8_SA(0, 0), a2, vA[0]);
            PG8_WAIT_V(8); PG8_WAIT_L(0); PG8_BAR; PG8_MMA(1, 0, At, B0); PG8_MMA(1, 1, At, B1); PG8_BAR; PG8_SCHED;
            PG8_LDB(B0, 1, 0); PG8_LDB(B1, 1, 1); PG8_SCHED; PG8_LDA(At, 1, 0); PG8_STAGE(PG8_SA(0, 1), a2 + hstepA, vA[1]);
            PG8_WAIT_V(8); PG8_WAIT_L(0); PG8_BAR; PG8_MMA(0, 0, At, B0); PG8_MMA(0, 1, At, B1); PG8_BAR; PG8_SCHED;
            PG8_LDA(At, 1, 1); PG8_STAGE(PG8_SB(1, 0), b3, voffB[0]); PG8_STAGE(PG8_SB(1, 1), b3 + hstepB, voffB[1]); PG8_STAGE(PG8_SA(1, 0), a3, vA[0]);
            PG8_WAIT_V(8); PG8_WAIT_L(0); PG8_BAR; PG8_MMA(1, 0, At, B0); PG8_MMA(1, 1, At, B1); PG8_BAR; PG8_SCHED;
        }
        if (wr == 0) PG8_BAR;
        { int fr_ = fr, fq_ = fq; asm volatile("" : "+v"(fr_), "+v"(fq_));
          E(acc, cur, wr, wc, fr_, fq_, rowtab + (ui % 3) * 768); }
        if (!has_next) break;
        cur = nxt; cA = nA; cB = nB; ++ui;
        if (wr == 1) PG8_BAR;
    }
    PG8_WAIT_V(0);
    PG8_BAR;
#undef PG8_SA
#undef PG8_SB
#undef PG8_STAGE
#undef PG8_LDA
#undef PG8_LDB
#undef PG8_MMA
#undef PG8_WAIT_V
#undef PG8_WAIT_L
#undef PG8_BAR
#undef PG8_SCHED
}

struct StaticSched {
    const char* A; const char* B; size_t atile, btile; int nM, nN, nwg, G, c;
    size_t acol; int skipctx;
    __device__ __forceinline__ bool next(int i, Unit& u) const {
        const int L = i * G + c; if (L >= nwg) return false;
        const int wgid = xcd_remap(L, nwg);
        constexpr int WGM = 8;
        const int nig = WGM * nN, gid = wgid / nig, fm = gid * WGM, gsz = (nM - fm) < WGM ? (nM - fm) : WGM;
        const int pm0 = fm + ((wgid % nig) % gsz); u.pm = pm0 + skipctx * ((pm0 >> 4) + 1); u.pn = (wgid % nig) / gsz; u.e = 0; u.rb = 0; u.cnt = 0; return true;
    }
    __device__ __forceinline__ const char* a_base(const Unit& u) const { return A + (size_t)u.pm * atile + (size_t)u.pn * acol; }
    __device__ __forceinline__ const char* b_base(const Unit& u) const { return B + (size_t)u.pn * btile; }
    static constexpr int NTAB = 0;
    __device__ __forceinline__ const unsigned* tab_src(const Unit&, int, int) const { return nullptr; }
    __device__ __forceinline__ int a_rowidx(const Unit&, const LAS int*, int) const { return 0; }
};
struct StaticSchedG : StaticSched {
    __device__ __forceinline__ const char* a_base(const Unit& u) const { return A + (size_t)u.pn * acol; }
    __device__ __forceinline__ int a_rowidx(const Unit& u, const LAS int*, int rl) const { return u.pm * 256 + rl; }
};

template <int KIND>
struct MoeSched {
    static constexpr int NTAB = KIND == 1 ? 0x5 : 0x7;
    const char* A; const char* B; size_t atile, btile, bexp; const int* list; const float* glist; const float* bias; int NPN, U, G, c; int pbl, cntl;
    __device__ __forceinline__ bool next(int i, Unit& u) const {
        const int L = i * G + c; if (L >= U) return false;
        const int idx = xcd_remap(L, U);
        const int rbg = idx / NPN; u.pn = idx % NPN; u.pm = rbg;
        const unsigned long long m = __ballot(pbl <= rbg);
        const int e = __builtin_popcount((unsigned)(m & 0xffffffffull)) - 1;
        u.e = e; u.rb = rbg - __builtin_amdgcn_readlane(pbl, e); u.cnt = __builtin_amdgcn_readlane(cntl, e); return true;
    }
    __device__ __forceinline__ const char* a_base(const Unit& u) const { return A; }
    __device__ __forceinline__ int a_rowidx(const Unit& u, const LAS int* tab, int rl) const { return KIND == 1 ? (tab[rl] >> 2) : u.pm * 256 + rl; }
    __device__ __forceinline__ const char* b_base(const Unit& u) const { return B + (size_t)u.e * bexp + (size_t)u.pn * btile; }
    __device__ __forceinline__ const unsigned* tab_src(const Unit& u, int sl, int t) const {
        if (sl == 2) { const int col = KIND == 1 ? ((t >> 7) * DFF + u.pn * 128 + (t & 127)) : (u.pn * 256 + t); return (const unsigned*)(bias + (size_t)u.e * (KIND == 1 ? 2 * DFF : DM) + col); }
        int idx = u.rb * 256 + t; idx = idx < u.cnt ? idx : u.cnt - 1;
        return (sl == 0 ? (const unsigned*)list : (const unsigned*)glist) + (size_t)u.e * NR + idx;
    }
};
}

namespace att {
constexpr int D = 128, NW = 8, QBLK = 32, KVBLK = 64;
constexpr float SCALE = 0.088388347648318440f;
constexpr float THR = 8.f;
constexpr int LDQ = 1024, LDK = 256, LDO = 1024;
constexpr int V8T_TILE_ = 128 * 64;
#ifndef ATT_NS
#define ATT_NS 6
#endif
constexpr int NS = ATT_NS, SLOT = 16384;
#ifndef ATT_SDEPTH
#define ATT_SDEPTH 1
#endif
constexpr int SDEPTH = ATT_SDEPTH;
constexpr size_t SHM_V = KVBLK * D * 2, SHM_K = KVBLK * D * 2, SHM_ATTN = 2 * SHM_V + 2 * SHM_K + NW * 64 * 4;
#define KSWZ(row, colB) ((row) * 256 + ((colB) ^ (((row) & 7) << 4)))
#define SBAR() __builtin_amdgcn_sched_barrier(0)
__device__ __forceinline__ int crow(int r, int hi) { return (r & 3) + 8 * (r >> 2) + 4 * hi; }
__device__ __forceinline__ unsigned cvtpk(float lo, float hi) { unsigned r; asm volatile("v_cvt_pk_bf16_f32 %0, %1, %2" : "=v"(r) : "v"(lo), "v"(hi)); return r; }
__device__ __forceinline__ bf16x8 ld8(const bf16* p) { return *reinterpret_cast<const bf16x8*>(p); }
__device__ __forceinline__ void partialSM(f32x16& p0, f32x16& p1, float& m_reg, float& mn, float& alpha) {
  constexpr float C = SCALE * 1.4426950408889634f;
  float pmax = p0[0]; for (int r = 1; r < 16; ++r) pmax = fmaxf(pmax, p0[r]); for (int r = 0; r < 16; ++r) pmax = fmaxf(pmax, p1[r]);
  { auto rr = __builtin_amdgcn_permlane32_swap(__float_as_uint(pmax), __float_as_uint(pmax), false, false);
    pmax = fmaxf(__uint_as_float(rr[0]), __uint_as_float(rr[1])); }
  if (__builtin_expect(__all(pmax - m_reg <= THR / SCALE), 1)) { mn = m_reg; alpha = 1.f; }
  else { mn = fmaxf(m_reg, pmax); alpha = __builtin_amdgcn_exp2f((m_reg - mn) * C); m_reg = mn; }
  float mnC = -mn * C;
  for (int r = 0; r < 16; ++r) p0[r] = fmaf(p0[r], C, mnC); for (int r = 0; r < 16; ++r) p1[r] = fmaf(p1[r], C, mnC);
  for (int r = 0; r < 16; ++r) p0[r] = __builtin_amdgcn_exp2f(p0[r]);
}
__device__ __forceinline__ void partialSMb(f32x16& p0, f32x16& p1) {
  for (int r = 0; r < 16; ++r) p0[r] = __builtin_amdgcn_exp2f(p0[r]);
}
__device__ __forceinline__ void finishSMb(f32x16& p0, f32x16& p1, float& l_part, bf16x8& pa0, bf16x8& pa1, bf16x8& pa2, bf16x8& pa3) {
  for (int r = 0; r < 16; ++r) p1[r] = __builtin_amdgcn_exp2f(p1[r]);
  float ps = 0; for (int r = 0; r < 16; ++r) ps += p0[r]; for (int r = 0; r < 16; ++r) ps += p1[r];
  l_part += ps;
#define PK4(P, BASE, OUT) do { unsigned a0 = cvtpk(P[BASE + 0], P[BASE + 1]), a1 = cvtpk(P[BASE + 2], P[BASE + 3]);   \
    unsigned b0 = cvtpk(P[BASE + 4], P[BASE + 5]), b1 = cvtpk(P[BASE + 6], P[BASE + 7]);                              \
    auto r0 = __builtin_amdgcn_permlane32_swap(a0, b0, false, false); auto r1 = __builtin_amdgcn_permlane32_swap(a1, b1, false, false); \
    u32x4 w = {r0[0], r1[0], r0[1], r1[1]}; OUT = *reinterpret_cast<bf16x8*>(&w); } while (0)
  PK4(p0, 0, pa0); PK4(p0, 8, pa1); PK4(p1, 0, pa2); PK4(p1, 8, pa3);
#undef PK4
}
typedef short v2s16 __attribute__((ext_vector_type(2)));
__device__ __forceinline__ int cvt_pk4_fp8_sc(float a, float b, float c, float d, float sc) {
  v2s16 w = {0, 0};
  w = __builtin_amdgcn_cvt_scalef32_pk_fp8_f32(w, a, b, sc, false);
  w = __builtin_amdgcn_cvt_scalef32_pk_fp8_f32(w, c, d, sc, true);
  return __builtin_bit_cast(int, w);
}
__device__ __forceinline__ void exp32(f32x16& p0, f32x16& p1) {
  for (int r = 0; r < 16; ++r) p0[r] = __builtin_amdgcn_exp2f(p0[r]);
  for (int r = 0; r < 16; ++r) p1[r] = __builtin_amdgcn_exp2f(p1[r]);
}
__device__ __forceinline__ void finishSM8(const f32x16& p0, const f32x16& p1, float& l_part, v8i& pf, int& E) {
  float ps = 0; for (int r = 0; r < 16; ++r) ps += p0[r]; for (int r = 0; r < 16; ++r) ps += p1[r];
  l_part += ps;
  float pm = fmaxf(p0[0], p1[0]);
  for (int r = 1; r < 16; ++r) pm = fmaxf(fmaxf(pm, p0[r]), p1[r]);
  int e = (int)(__float_as_uint(pm) >> 23) - 7; e = e < 1 ? 1 : e;
  E = e;
  const float sc = __uint_as_float((unsigned)e << 23);
  pf = (v8i){cvt_pk4_fp8_sc(p0[0], p0[1], p0[2], p0[3], sc), cvt_pk4_fp8_sc(p0[4], p0[5], p0[6], p0[7], sc), cvt_pk4_fp8_sc(p0[8], p0[9], p0[10], p0[11], sc), cvt_pk4_fp8_sc(p0[12], p0[13], p0[14], p0[15], sc),
             cvt_pk4_fp8_sc(p1[0], p1[1], p1[2], p1[3], sc), cvt_pk4_fp8_sc(p1[4], p1[5], p1[6], p1[7], sc), cvt_pk4_fp8_sc(p1[8], p1[9], p1[10], p1[11], sc), cvt_pk4_fp8_sc(p1[12], p1[13], p1[14], p1[15], sc)};
}
__device__ __forceinline__ void pv8(f32x16* o, const char* Vs, v8i pf, int E, int r32, int hi) {
  int s1 = 0x7F7F7F7F; asm volatile("" : "+v"(s1));
  const int f = (r32 >> 2) & 3;
  const char* vrow = Vs + r32 * 64;
#pragma unroll
  for (int d0 = 0; d0 < 4; ++d0) {
    const v4i v0 = *reinterpret_cast<const v4i*>(vrow + d0 * 2048 + (((2 * hi) ^ f) << 4)), v1 = *reinterpret_cast<const v4i*>(vrow + d0 * 2048 + (((2 * hi + 1) ^ f) << 4));
    o[d0] = __builtin_amdgcn_mfma_scale_f32_32x32x64_f8f6f4(pf, __builtin_shufflevector(v0, v1, 0, 1, 2, 3, 4, 5, 6, 7), o[d0], 0, 0, 0, E, 0, s1);
  }
}
__device__ __forceinline__ void finishSM(f32x16& p0, f32x16& p1, float alpha, float& l_reg, bf16x8& pa0, bf16x8& pa1, bf16x8& pa2, bf16x8& pa3) {
  for (int r = 0; r < 16; ++r) p1[r] = __builtin_amdgcn_exp2f(p1[r]);
  float ps = 0; for (int r = 0; r < 16; ++r) ps += p0[r]; for (int r = 0; r < 16; ++r) ps += p1[r];
  { auto rr = __builtin_amdgcn_permlane32_swap(__float_as_uint(ps), __float_as_uint(ps), false, false);
    ps = __uint_as_float(rr[0]) + __uint_as_float(rr[1]); }
  l_reg = l_reg * alpha + ps;
#define PK4(P, BASE, OUT) do { unsigned a0 = cvtpk(P[BASE + 0], P[BASE + 1]), a1 = cvtpk(P[BASE + 2], P[BASE + 3]);   \
    unsigned b0 = cvtpk(P[BASE + 4], P[BASE + 5]), b1 = cvtpk(P[BASE + 6], P[BASE + 7]);                              \
    auto r0 = __builtin_amdgcn_permlane32_swap(a0, b0, false, false); auto r1 = __builtin_amdgcn_permlane32_swap(a1, b1, false, false); \
    u32x4 w = {r0[0], r1[0], r0[1], r1[1]}; OUT = *reinterpret_cast<bf16x8*>(&w); } while (0)
  PK4(p0, 0, pa0); PK4(p0, 8, pa1); PK4(p1, 0, pa2); PK4(p1, 8, pa3);
#undef PK4
}
__device__ __forceinline__ void qkt(f32x16& p0, f32x16& p1, const char* Ks, const v8i* qf, int r32, int hi) {
  int sc = 0x7F7F7F7F; asm volatile("" : "+v"(sc));
  p0 = f32x16{}; p1 = f32x16{};
#pragma unroll
  for (int st = 0; st < 2; ++st) {
    const int ua = 4 * hi + 2 * st, f0 = (r32 >> 1) & 7;
    const v4i a0 = *reinterpret_cast<const v4i*>(Ks + r32 * 128 + ((ua ^ f0) << 4)), a1 = *reinterpret_cast<const v4i*>(Ks + r32 * 128 + (((ua + 1) ^ f0) << 4));
    const v4i b0 = *reinterpret_cast<const v4i*>(Ks + (32 + r32) * 128 + ((ua ^ f0) << 4)), b1 = *reinterpret_cast<const v4i*>(Ks + (32 + r32) * 128 + (((ua + 1) ^ f0) << 4));
    p0 = __builtin_amdgcn_mfma_scale_f32_32x32x64_f8f6f4(__builtin_shufflevector(a0, a1, 0, 1, 2, 3, 4, 5, 6, 7), qf[st], p0, 0, 0, 0, sc, 0, sc);
    p1 = __builtin_amdgcn_mfma_scale_f32_32x32x64_f8f6f4(__builtin_shufflevector(b0, b1, 0, 1, 2, 3, 4, 5, 6, 7), qf[st], p1, 0, 0, 0, sc, 0, sc);
  }
}
__device__ __forceinline__ int v_st(int k, int c) { const int kk = (k & ~0xC) | ((k & 4) << 1) | ((k & 8) >> 1); return ((kk >> 3) * 4 + (c >> 5)) * 512 + ((kk & 7) * 32 + (c & 31)) * 2; }
__device__ __forceinline__ int v_rd_base(int lane) { return ((lane & 3) << 3) | (((lane >> 2) & 3) << 6) | (((lane >> 4) & 1) << 5) | (((lane >> 5) & 1) << 8); }
constexpr int v_rd_off(int d0, int ks, int half) { return d0 * 512 + ks * 4096 + half * 2048; }
template <int OFF> __device__ __forceinline__ s16x4 tr_read(int vb) {
  s16x4 r; asm volatile("ds_read_b64_tr_b16 %0, %1 offset:%2" : "=&v"(r) : "v"(vb), "i"(OFF) : "memory"); return r;
}
template <int D0> __device__ __forceinline__ void pv_one(f32x16& od, int vb, bf16x8 pa0, bf16x8 pa1, bf16x8 pa2, bf16x8 pa3) {
  const s16x4 l0 = tr_read<v_rd_off(D0, 0, 0)>(vb), h0 = tr_read<v_rd_off(D0, 0, 1)>(vb), l1 = tr_read<v_rd_off(D0, 1, 0)>(vb), h1 = tr_read<v_rd_off(D0, 1, 1)>(vb);
  const s16x4 l2 = tr_read<v_rd_off(D0, 2, 0)>(vb), h2 = tr_read<v_rd_off(D0, 2, 1)>(vb), l3 = tr_read<v_rd_off(D0, 3, 0)>(vb), h3 = tr_read<v_rd_off(D0, 3, 1)>(vb);
  asm volatile("s_waitcnt lgkmcnt(0)" ::: "memory"); SBAR();
#define PK(L, H) (bf16x8){L[0], L[1], L[2], L[3], H[0], H[1], H[2], H[3]}
  od = __builtin_amdgcn_mfma_f32_32x32x16_bf16(pa0, PK(l0, h0), od, 0, 0, 0);
  od = __builtin_amdgcn_mfma_f32_32x32x16_bf16(pa1, PK(l1, h1), od, 0, 0, 0);
  od = __builtin_amdgcn_mfma_f32_32x32x16_bf16(pa2, PK(l2, h2), od, 0, 0, 0);
  od = __builtin_amdgcn_mfma_f32_32x32x16_bf16(pa3, PK(l3, h3), od, 0, 0, 0);
#undef PK
}
__device__ __forceinline__ void pv_d0(f32x16* o, int vb, bf16x8 pa0, bf16x8 pa1, bf16x8 pa2, bf16x8 pa3) {
  pv_one<0>(o[0], vb, pa0, pa1, pa2, pa3); pv_one<1>(o[1], vb, pa0, pa1, pa2, pa3); pv_one<2>(o[2], vb, pa0, pa1, pa2, pa3); pv_one<3>(o[3], vb, pa0, pa1, pa2, pa3);
}
#define MFMA8(A, B, C, SA, SB) __builtin_amdgcn_mfma_scale_f32_32x32x64_f8f6f4(A, B, C, 0, 0, 0, SA, 0, SB)
#define CAT8(x, y) __builtin_shufflevector(x, y, 0, 1, 2, 3, 4, 5, 6, 7)
template <bool QK, bool PV>
__device__ __forceinline__ void att_step(f32x16& c0, f32x16& c1, const f32x16& q0, const f32x16& q1, f32x16* o, const v8i* qf, const char* Ks, const char* Vs, int r32, int hi, float& l_part) {
  int one = 0x7F7F7F7F; asm volatile("" : "+v"(one));
  const int f0 = (r32 >> 1) & 7, f = (r32 >> 2) & 3;
  const char* kr = Ks + r32 * 128; const char* vr = Vs + r32 * 64;
  v4i ka[4], kb[4];
  if (QK) {
#pragma unroll
    for (int u = 0; u < 4; ++u) { ka[u] = *reinterpret_cast<const v4i*>(kr + (((4 * hi + u) ^ f0) << 4)); kb[u] = *reinterpret_cast<const v4i*>(kr + 4096 + (((4 * hi + u) ^ f0) << 4)); }
  }
  SBAR();
  float ps = 0.f, pm = 0.f; v8i pf; int E = 0; float scf = 0.f;
  if (QK) { c0 = MFMA8(CAT8(ka[0], ka[1]), qf[0], f32x16{}, one, one); SBAR(); }
  if (PV) {
#pragma unroll
    for (int r = 0; r < 16; ++r) ps += q0[r];
    pm = fmaxf(q0[0], q0[1]);
#pragma unroll
    for (int r = 2; r < 16; r += 2) pm = fmaxf(fmaxf(pm, q0[r]), q0[r + 1]);
    SBAR();
  }
  if (QK) { c1 = MFMA8(CAT8(kb[0], kb[1]), qf[0], f32x16{}, one, one); SBAR(); }
  if (PV) {
#pragma unroll
    for (int r = 0; r < 16; ++r) ps += q1[r];
#pragma unroll
    for (int r = 0; r < 16; r += 2) pm = fmaxf(fmaxf(pm, q1[r]), q1[r + 1]);
    l_part += ps;
    int e = (int)(__float_as_uint(pm) >> 23) - 7; e = e < 1 ? 1 : e;
    E = e; scf = __uint_as_float((unsigned)e << 23);
    SBAR();
  }
  if (QK) { c0 = MFMA8(CAT8(ka[2], ka[3]), qf[1], c0, one, one); SBAR(); }
  v4i va[4], vb[4];
  if (PV) {
#pragma unroll
    for (int d0 = 0; d0 < 4; ++d0) { va[d0] = *reinterpret_cast<const v4i*>(vr + d0 * 2048 + (((2 * hi) ^ f) << 4)); vb[d0] = *reinterpret_cast<const v4i*>(vr + d0 * 2048 + (((2 * hi + 1) ^ f) << 4)); }
    pf[0] = cvt_pk4_fp8_sc(q0[0], q0[1], q0[2], q0[3], scf); pf[1] = cvt_pk4_fp8_sc(q0[4], q0[5], q0[6], q0[7], scf);
    pf[2] = cvt_pk4_fp8_sc(q0[8], q0[9], q0[10], q0[11], scf); pf[3] = cvt_pk4_fp8_sc(q0[12], q0[13], q0[14], q0[15], scf);
    SBAR();
  }
  if (QK) { c1 = MFMA8(CAT8(kb[2], kb[3]), qf[1], c1, one, one); SBAR(); }
  if (PV) {
    pf[4] = cvt_pk4_fp8_sc(q1[0], q1[1], q1[2], q1[3], scf); pf[5] = cvt_pk4_fp8_sc(q1[4], q1[5], q1[6], q1[7], scf);
    pf[6] = cvt_pk4_fp8_sc(q1[8], q1[9], q1[10], q1[11], scf); pf[7] = cvt_pk4_fp8_sc(q1[12], q1[13], q1[14], q1[15], scf);
    SBAR();
    o[0] = MFMA8(pf, CAT8(va[0], vb[0]), o[0], E, one); SBAR();
  }
  if (QK) {
#pragma unroll
    for (int r = 0; r < 8; ++r) c0[r] = __builtin_amdgcn_exp2f(c0[r]);
    SBAR();
  }
  if (PV) { o[1] = MFMA8(pf, CAT8(va[1], vb[1]), o[1], E, one); SBAR(); }
  if (QK) {
#pragma unroll
    for (int r = 8; r < 16; ++r) c0[r] = __builtin_amdgcn_exp2f(c0[r]);
    SBAR();
  }
  if (PV) { o[2] = MFMA8(pf, CAT8(va[2], vb[2]), o[2], E, one); SBAR(); }
  if (QK) {
#pragma unroll
    for (int r = 0; r < 8; ++r) c1[r] = __builtin_amdgcn_exp2f(c1[r]);
    SBAR();
  }
  if (PV) { o[3] = MFMA8(pf, CAT8(va[3], vb[3]), o[3], E, one); SBAR(); }
  if (QK) {
#pragma unroll
    for (int r = 8; r < 16; ++r) c1[r] = __builtin_amdgcn_exp2f(c1[r]);
    SBAR();
  }
}
constexpr size_t SHM_RING = (size_t)NS * SLOT, SHM_ATTN3 = SHM_RING + NW * 64 * 4;
__device__ __forceinline__ void attn_dense_body(const int tid, const bf16* __restrict__ Qb, const unsigned char* __restrict__ Kh, const unsigned char* __restrict__ Vh, unsigned char* __restrict__ Ob, int seq, char* lds,
                                                const float* __restrict__ q_g, const f32x2* __restrict__ rope, int t0, float mnC) {
  const int wid = __builtin_amdgcn_readfirstlane(tid >> 6), lane = tid & 63, r32 = lane & 31, hi = lane >> 5;
  float* ws = (float*)(lds + SHM_RING) + wid * 64; float* li_l = ws; float* al_l = ws + 32;
  float l_reg = 0; bf16x8 qr[8]; v8i qf[2];
  const bf16* Qw = Qb + (long)(wid * QBLK + r32) * LDQ + hi * 8;
#pragma unroll
  for (int d0 = 0; d0 < 8; ++d0) qr[d0] = ld8(Qw + d0 * 16);
  unsigned koff, voff;
  { int l_ = lane; asm volatile("" : "+v"(l_)); const int pk_ = wid * 64 + l_, key_ = pk_ >> 3;
    koff = (unsigned)(key_ * 256 + (((pk_ & 7) ^ ((key_ >> 1) & 7)) << 4)); voff = (unsigned)(wid * 1024 + l_ * 16); }
#define DMA_TILE(tile, slot) do { const int tl_ = (tile); \
    __builtin_amdgcn_global_load_lds((const unsigned*)(Kh + (size_t)tl_ * (64 * 256) + koff), (LAS unsigned*)(uintptr_t)(unsigned)((uintptr_t)lds + (slot) * SLOT + wid * 1024), 16, 0, 0); \
    __builtin_amdgcn_global_load_lds((const unsigned*)(Vh + (size_t)tl_ * 8192 + voff), (LAS unsigned*)(uintptr_t)(unsigned)((uintptr_t)lds + (slot) * SLOT + 8192 + wid * 1024), 16, 0, 0); } while (0)
#pragma unroll
  for (int i = 0; i < NS - 2; ++i) DMA_TILE(i, i);
  {
    float ss = 0.f;
#pragma unroll
    for (int d0 = 0; d0 < 8; ++d0)
#pragma unroll
      for (int j = 0; j < 8; ++j) { const float xv = __uint_as_float((unsigned)(unsigned short)qr[d0][j] << 16); ss += xv * xv; }
    ss += __shfl_xor(ss, 32);
    const float inv = rsqrtf(ss * (1.f / 128.f) + 1e-6f) * (SCALE * 1.4426950408889634f);
    const int t = t0 + wid * QBLK + r32;
#pragma unroll
    for (int ax = 0; ax < 2; ++ax) {
      float x[4][8];
#pragma unroll
      for (int dd = 0; dd < 4; ++dd) {
        const int d0 = ax * 4 + dd;
        const f32x4 g0 = *(const f32x4*)(q_g + d0 * 16 + hi * 8), g1 = *(const f32x4*)(q_g + d0 * 16 + hi * 8 + 4);
#pragma unroll
        for (int j = 0; j < 4; ++j) { x[dd][j] = __uint_as_float((unsigned)(unsigned short)qr[d0][j] << 16) * inv * g0[j]; x[dd][4 + j] = __uint_as_float((unsigned)(unsigned short)qr[d0][4 + j] << 16) * inv * g1[j]; }
      }
      if (t0 >= 0) {
        const int pos = ax == 0 ? (t >> 6) : (t & 63);
#pragma unroll
        for (int dd = 0; dd < 2; ++dd)
#pragma unroll
          for (int j = 0; j < 8; j += 2) {
            const f32x4 cs = *(const f32x4*)(rope + pos * 32 + dd * 16 + hi * 8 + j);
            const float a0 = x[dd][j], b0 = x[dd + 2][j], a1 = x[dd][j + 1], b1 = x[dd + 2][j + 1];
            x[dd][j] = a0 * cs.x - b0 * cs.y; x[dd + 2][j] = b0 * cs.x + a0 * cs.y; x[dd][j + 1] = a1 * cs.z - b1 * cs.w; x[dd + 2][j + 1] = b1 * cs.z + a1 * cs.w;
          }
      }
      qf[ax] = (v8i){(int)cvt_pk4_fp8(x[0][0], x[0][1], x[0][2], x[0][3]), (int)cvt_pk4_fp8(x[0][4], x[0][5], x[0][6], x[0][7]), (int)cvt_pk4_fp8(x[1][0], x[1][1], x[1][2], x[1][3]), (int)cvt_pk4_fp8(x[1][4], x[1][5], x[1][6], x[1][7]),
                     (int)cvt_pk4_fp8(x[2][0], x[2][1], x[2][2], x[2][3]), (int)cvt_pk4_fp8(x[2][4], x[2][5], x[2][6], x[2][7]), (int)cvt_pk4_fp8(x[3][0], x[3][1], x[3][2], x[3][3]), (int)cvt_pk4_fp8(x[3][4], x[3][5], x[3][6], x[3][7])};
    }
  }
  f32x16 pA0, pA1, pB0, pB1; const int NT = seq / KVBLK;
  int sc = 0, sp = NS - 1, sd = NS - 2;
#define STEP_HEAD(t_) do { asm volatile("s_waitcnt vmcnt(%0)\n\ts_barrier" :: "n"(2 * (NS - 3)) : "memory"); \
    { int tn_ = (t_) + NS - 2; tn_ = tn_ < NT ? tn_ : NT - 1; DMA_TILE(tn_, sd); } SBAR(); } while (0)
#define STEP_TAIL() do { sd = sp; sp = sc; sc = sc == NS - 1 ? 0 : sc + 1; } while (0)
#define PIN2(a, b) asm volatile("" : "+v"(a), "+v"(b))
#define STEP(PC0, PC1, PP0, PP1, t_) do { STEP_HEAD(t_); \
    att_step<true, true>(PC0, PC1, PP0, PP1, o, qf, lds + sc * SLOT, lds + sp * SLOT + 8192, r32, hi, l_reg); \
    PIN2(PC0, PC1); PIN2(o[0], o[1]); PIN2(o[2], o[3]); \
    STEP_TAIL(); } while (0)
  f32x16 o[4];
  STEP_HEAD(0);
  att_step<true, false>(pA0, pA1, pB0, pB1, o, qf, lds + sc * SLOT, lds, r32, hi, l_reg); PIN2(pA0, pA1);
  STEP_TAIL();
#pragma unroll
  for (int d = 0; d < 4; ++d) o[d] = f32x16{};
  for (int t = 1; t + 1 < NT; t += 2) {
    STEP(pB0, pB1, pA0, pA1, t);
    STEP(pA0, pA1, pB0, pB1, t + 1);
  }
  STEP(pB0, pB1, pA0, pA1, NT - 1);
  att_step<false, true>(pA0, pA1, pB0, pB1, o, qf, lds, lds + sp * SLOT + 8192, r32, hi, l_reg);
  asm volatile("s_waitcnt vmcnt(0)" ::: "memory");
  l_reg += __shfl_xor(l_reg, 32);
  if (hi == 0) li_l[r32] = l_reg; asm volatile("s_waitcnt lgkmcnt(0)" ::: "memory");
  float rli[16];
#pragma unroll
  for (int r = 0; r < 16; ++r) rli[r] = __builtin_amdgcn_rcpf(li_l[crow(r, hi)]);
  asm volatile("s_waitcnt lgkmcnt(0)\n\ts_barrier" ::: "memory");
  {
    int l2 = lane; asm volatile("" : "+v"(l2));
    char* stg = lds + 4 * SLOT + wid * 4096;
    char* sp_ = stg + (4 * (l2 >> 5)) * 128 + (l2 & 31);
#pragma unroll
    for (int r = 0; r < 16; r += 2) {
#pragma unroll
      for (int d0 = 0; d0 < 4; ++d0) {
        const int w = __builtin_amdgcn_cvt_pk_fp8_f32(o[d0][r] * rli[r], o[d0][r + 1] * rli[r + 1], 0, false);
        *(unsigned char*)(sp_ + crow(r, 0) * 128 + d0 * 32) = (unsigned char)w;
        *(unsigned char*)(sp_ + crow(r + 1, 0) * 128 + d0 * 32) = (unsigned char)(w >> 8);
      }
    }
    asm volatile("s_waitcnt lgkmcnt(0)" ::: "memory");
    unsigned char* Ow = Ob + (size_t)(wid * QBLK) * 1024;
#pragma unroll
    for (int i = 0; i < 4; ++i) {
      const int rowl = (l2 >> 3) + 8 * i;
      const u32x4 v = *reinterpret_cast<const u32x4*>(stg + rowl * 128 + (l2 & 7) * 16);
      *reinterpret_cast<u32x4*>(Ow + (size_t)rowl * 1024 + (l2 & 7) * 16) = v;
    }
    asm volatile("s_waitcnt lgkmcnt(0)" ::: "memory");
  }
#undef DMA_TILE
#undef STEP
#undef STEP_HEAD
#undef STEP_TAIL
#undef PIN2
}
}

struct Args { const float* in[N_IN]; float* out; unsigned char* ws; int ph_lo, ph_hi; };
typedef const Args __attribute__((address_space(4)))* KArgs;

__device__ __forceinline__ const float* mods_ptr(KArgs a, int layer, int mrow) { return (const float*)(a->ws + WS_MODS) + ((size_t)layer * 9 + mrow) * NMOD; }
__device__ __forceinline__ int mrow_of(int row) { const int b = row / SEG, s = row - b * SEG; return s < CTXL ? 8 : b; }


#ifndef MOE1_FMT
#define MOE1_FMT 2
#endif
typedef __bf16 v32bf16 __attribute__((ext_vector_type(32)));
typedef unsigned v6u32 __attribute__((ext_vector_type(6)));
typedef unsigned v16u32 __attribute__((ext_vector_type(16)));
__device__ __forceinline__ void fp6_chunk_store(const v16u32 x, unsigned char* rowp, int c) {
    float m = 0.f;
#pragma unroll
    for (int i = 0; i < 16; ++i) m = fmaxf(fmaxf(m, fabsf(__uint_as_float(x[i] << 16))), fabsf(__uint_as_float(x[i] & 0xffff0000u)));
    int E = (int)(__float_as_uint(m * 1.0666667f) >> 23) - 2; E = E < 1 ? 1 : E;
    const v6u32 r = __builtin_amdgcn_cvt_scalef32_pk32_fp6_bf16(__builtin_bit_cast(v32bf16, x), __uint_as_float((unsigned)E << 23));
    unsigned char* o = rowp + (c >> 2) * 128 + (c & 3) * 16;
    *(GAS u32x4*)o = (u32x4){r[0], r[1], r[2], r[3]};
    *(GAS u32x4*)(o + 64) = (u32x4){r[4], r[5], (unsigned)E, 0u};
}
__device__ __forceinline__ void tr_item(const float* __restrict__ W, int ldw, bf16* __restrict__ WT, int ldt, int k0, int n0, int drow0, LAS unsigned char* scr, int lane) {
    const int n4 = lane & 15, kg = lane >> 4;
    f32x4 v[4][4];
#pragma unroll
    for (int i = 0; i < 4; ++i)
#pragma unroll
        for (int kk = 0; kk < 4; ++kk) v[i][kk] = __builtin_nontemporal_load((const GAS f32x4*)(W + (size_t)(k0 + 4 * (kg + 4 * i) + kk) * ldw + n0 + 4 * n4));
#pragma unroll
    for (int i = 0; i < 4; ++i)
#pragma unroll
        for (int j = 0; j < 4; ++j) {
            u32x2 w; w.x = cvt_pk_bf16(v[i][0][j], v[i][1][j]); w.y = cvt_pk_bf16(v[i][2][j], v[i][3][j]);
            *(LAS u32x2*)(scr + ((4 * n4 + j) * 17 + (kg + 4 * i)) * 8) = w;
        }
    LDS_WAIT(); asm volatile("" ::: "memory");
#pragma unroll
    for (int q = 0; q < 16; ++q) {
        const int n = (lane >> 4) + 4 * q;
        const u32x2 w = *(const LAS u32x2*)(scr + (n * 17 + (lane & 15)) * 8);
        __builtin_nontemporal_store(w, (GAS u32x2*)(WT + (size_t)(drow0 + n) * ldt + k0 + 4 * (lane & 15)));
    }
    LDS_WAIT(); asm volatile("" ::: "memory");
}
__device__ __forceinline__ void tr_item8(const float* __restrict__ W, int ldw, unsigned char* __restrict__ WT, int ldt, int k0, int n0, int drow0, LAS unsigned char* scr, int lane, float scale) {
    const int n4 = lane & 15, kg = lane >> 4;
#pragma unroll
    for (int hf = 0; hf < 2; ++hf) {
        f32x4 v[4][4];
#pragma unroll
        for (int i = 0; i < 4; ++i)
#pragma unroll
            for (int kk = 0; kk < 4; ++kk) v[i][kk] = __builtin_nontemporal_load((const GAS f32x4*)(W + (size_t)(k0 + 64 * hf + 4 * (kg + 4 * i) + kk) * ldw + n0 + 4 * n4));
#pragma unroll
        for (int i = 0; i < 4; ++i)
#pragma unroll
            for (int j = 0; j < 4; ++j)
                *(LAS unsigned*)(scr + (4 * n4 + j) * 136 + 64 * hf + 4 * (kg + 4 * i)) = cvt_pk4_fp8(v[i][0][j] * scale, v[i][1][j] * scale, v[i][2][j] * scale, v[i][3][j] * scale);
    }
    LDS_WAIT(); asm volatile("" ::: "memory");
#pragma unroll
    for (int q = 0; q < 16; ++q) {
        const int n = (lane >> 4) + 4 * q;
        const u32x2 w = *(const LAS u32x2*)(scr + n * 136 + 8 * (lane & 15));
        __builtin_nontemporal_store(w, (GAS u32x2*)(WT + (size_t)(drow0 + n) * ldt + k0 + 8 * (lane & 15)));
    }
    LDS_WAIT(); asm volatile("" ::: "memory");
}
__device__ __forceinline__ void tr_item6(const float* __restrict__ W, int ldw, unsigned char* __restrict__ WT, int k0, int n0, int drow0, LAS unsigned char* scr, int lane) {
    const int n4 = lane & 15, kg = lane >> 4;
    v6u32 rr[4]; unsigned ee[4];
#pragma unroll
    for (int hf = 0; hf < 2; ++hf) {
        f32x4 v[4][4];
#pragma unroll
        for (int i = 0; i < 4; ++i)
#pragma unroll
            for (int kk = 0; kk < 4; ++kk) v[i][kk] = __builtin_nontemporal_load((const GAS f32x4*)(W + (size_t)(k0 + 64 * hf + 4 * (kg + 4 * i) + kk) * ldw + n0 + 4 * n4));
#pragma unroll
        for (int i = 0; i < 4; ++i)
#pragma unroll
            for (int j = 0; j < 4; ++j) {
                u32x2 w; w.x = cvt_pk_bf16(v[i][0][j], v[i][1][j]); w.y = cvt_pk_bf16(v[i][2][j], v[i][3][j]);
                *(LAS u32x2*)(scr + ((4 * n4 + j) * 17 + (kg + 4 * i)) * 8) = w;
            }
        LDS_WAIT(); asm volatile("" ::: "memory");
#pragma unroll
        for (int ch = 0; ch < 2; ++ch) {
            v16u32 x;
#pragma unroll
            for (int i = 0; i < 8; ++i) { const u32x2 w = *(const LAS u32x2*)(scr + (lane * 17 + 8 * ch + i) * 8); x[2 * i] = w.x; x[2 * i + 1] = w.y; }
            float m = 0.f;
#pragma unroll
            for (int i = 0; i < 16; ++i) m = fmaxf(fmaxf(m, fabsf(__uint_as_float(x[i] << 16))), fabsf(__uint_as_float(x[i] & 0xffff0000u)));
            int E = (int)(__float_as_uint(m * 1.0666667f) >> 23) - 2; E = E < 1 ? 1 : E;
            rr[2 * hf + ch] = __builtin_amdgcn_cvt_scalef32_pk32_fp6_bf16(__builtin_bit_cast(v32bf16, x), __uint_as_float((unsigned)E << 23)); ee[2 * hf + ch] = (unsigned)E;
        }
        LDS_WAIT(); asm volatile("" ::: "memory");
    }
#pragma unroll
    for (int q = 0; q < 4; ++q) {
        LAS unsigned char* o = scr + lane * 136 + 16 * q;
        *(LAS u32x2*)o = (u32x2){rr[q][0], rr[q][1]}; *(LAS u32x2*)(o + 8) = (u32x2){rr[q][2], rr[q][3]};
        *(LAS u32x2*)(o + 64) = (u32x2){rr[q][4], rr[q][5]}; *(LAS u32x2*)(o + 72) = (u32x2){ee[q], 0u};
    }
    LDS_WAIT(); asm volatile("" ::: "memory");
#pragma unroll
    for (int q = 0; q < 16; ++q) {
        const int n = (lane >> 4) + 4 * q;
        const u32x2 w = *(const LAS u32x2*)(scr + n * 136 + 8 * (lane & 15));
        __builtin_nontemporal_store(w, (GAS u32x2*)(WT + (size_t)(drow0 + n) * 1024 + k0 + 8 * (lane & 15)));
    }
    LDS_WAIT(); asm volatile("" ::: "memory");
}
__device__ __forceinline__ int glu_row(int n, int F) { const int hf = n >= F ? 1 : 0, m = n - hf * F; return (m >> 7) * 256 + hf * 128 + (m & 127); }

constexpr int CONV_SPLIT = 1;
constexpr int CONV_SCAN_SHARE = 36864;
__device__ __forceinline__ void convert_weights(KArgs a, LAS unsigned char* scr, int lane, int w, int nw, bool small, int l0, int l1, int it_lo, int it_hi) {
    unsigned char* ws = a->ws;
    constexpr int IT_POOL = 8 * 8, IT_GLU = 8 * 32, IT_QKV = 8 * 24, IT_WO = 8 * 16, IT_W1 = 8 * 32, IT_W2 = 8 * 16;
    const int n_small = small ? IT_POOL + IT_GLU + IT_QKV + IT_WO : 0;
    const int n_w1 = (l1 - l0) * 32 * IT_W1, n_w2 = (l1 - l0) * 32 * IT_W2;
    const int it_end = min(it_hi, n_small + n_w1 + n_w2);
    for (int it = it_lo + w; it < it_end; it += nw) {
        int r = it;
        if (r < n_small) {
            if (r < IT_POOL) { const int mat = r >> 3, q = r & 7, kb = q >> 2, nb = q & 3;
                tr_item8(a->in[I_POOLW] + (size_t)mat * 65536, 256, ws + WS_POOLW + (size_t)mat * 65536, 256, kb * 128, nb * 64, nb * 64, scr, lane, W8_SCALE); continue; }
            r -= IT_POOL;
            if (r < IT_GLU) { const int kb = r >> 5, nb = r & 31;
                tr_item8(a->in[I_GLUW], 2048, ws + WS_GLUW, 1024, kb * 128, nb * 64, glu_row(nb * 64, 1024), scr, lane, W8_SCALE); continue; }
            r -= IT_GLU;
            if (r < IT_QKV) { const int kb = r / 24, nb = r % 24;
                tr_item8(a->in[I_WQKV], 1536, ws + WS_WQKV, 1024, kb * 128, nb * 64, nb * 64, scr, lane, W8_SCALE); continue; }
            r -= IT_QKV;
            { const int kb = r >> 4, nb = r & 15;
                tr_item8(a->in[I_WO], 1024, ws + WS_WO, 1024, kb * 128, nb * 64, nb * 64, scr, lane, W8_SCALE); continue; }
        }
        r -= n_small;
        if (r < n_w1) { const int mat = l0 * 32 + (r >> 8), q = r & 255, kb = q >> 5, nb = q & 31;
            if constexpr (MOE1_FMT == 2) tr_item6(a->in[I_W1] + (size_t)mat * 1024 * 2048, 2048, ws + WS_W1T + (size_t)mat * 2048 * 1024, kb * 128, nb * 64, glu_row(nb * 64, 1024), scr, lane);
            else tr_item8(a->in[I_W1] + (size_t)mat * 1024 * 2048, 2048, ws + WS_W1T + (size_t)mat * 2048 * 1024, 1024, kb * 128, nb * 64, glu_row(nb * 64, 1024), scr, lane, W8_SCALE);
            continue; }
        r -= n_w1;
        { const int mat = l0 * 32 + (r >> 7), q = r & 127, kb = q >> 4, nb = q & 15;
            tr_item8(a->in[I_W2] + (size_t)mat * 1024 * 1024, 1024, ws + WS_W2T + (size_t)mat * 1024 * 1024, 1024, kb * 128, nb * 64, nb * 64, scr, lane, W8_SCALE); }
    }
}

__device__ __forceinline__ void prologue(KArgs a, LAS unsigned char* lds, int tid, int lane, int wave) {
    const int G = gridDim.x, bx = blockIdx.x;
    unsigned char* ws = a->ws;
    __syncthreads();
    {
        LAS float* sv = (LAS float*)lds;
        LAS float* red = (LAS float*)(lds + 9 * 1024 * 4);
        bool staged = false;
        for (int it = bx; it < 4 * 48; it += G) {
            if (!staged) {
                for (int i = tid; i < 9 * 1024; i += NTHR) { const int r = i >> 10, k = i & 1023; const float c = r < 8 ? a->in[I_C][r * 1024 + k] : a->in[I_CCTX][k]; sv[i] = c * sigmoidf_(c); }
                staged = true;
            }
            __syncthreads();
            const int layer = it / 48, col0 = (it % 48) * 128;
            const float* W = a->in[I_ADAW] + (size_t)layer * 1024 * NMOD + col0 + 2 * lane;
            f32x2 acc[9];
#pragma unroll
            for (int r = 0; r < 9; ++r) acc[r] = (f32x2){0.f, 0.f};
            const int kb = wave * 128;
#pragma unroll 8
            for (int k = 0; k < 128; ++k) {
                const f32x2 w = __builtin_nontemporal_load((const GAS f32x2*)(W + (size_t)(kb + k) * NMOD));
#pragma unroll
                for (int r = 0; r < 9; ++r) { const float s = sv[r * 1024 + kb + k]; acc[r].x += s * w.x; acc[r].y += s * w.y; }
            }
#pragma unroll
            for (int r = 0; r < 9; ++r) { red[(wave * 9 + r) * 128 + 2 * lane] = acc[r].x; red[(wave * 9 + r) * 128 + 2 * lane + 1] = acc[r].y; }
            __syncthreads();
            float* mods = (float*)(ws + WS_MODS);
            for (int i = tid; i < 9 * 128; i += NTHR) {
                const int r = i >> 7, cc = i & 127; float s = 0.f;
#pragma unroll
                for (int w = 0; w < 8; ++w) s += red[(w * 9 + r) * 128 + cc];
                mods[((size_t)layer * 9 + r) * NMOD + col0 + cc] = s + a->in[I_ADAB][layer * NMOD + col0 + cc];
            }
        }
        __syncthreads();
    }
    const int gt = bx * NTHR + tid, NGT = G * NTHR;
    for (int i = gt; i < 64 * 32; i += NGT) {
        const int pos = i >> 5, f = i & 31; const float inv = powf(10000.f, -(float)f / 32.f); const float ang = (float)pos * inv;
        ((f32x2*)(ws + WS_ROPE))[i] = (f32x2){cosf(ang), sinf(ang)};
    }
    for (int i = gt; i < 4 * 32 * 512; i += NGT) {
        const int layer = i >> 14, e = (i >> 9) & 31, c = (i & 511) * 2;
        ((unsigned*)(ws + WS_RT))[i] = cvt_pk_bf16(a->in[I_RW][((size_t)layer * 1024 + c) * 32 + e], a->in[I_RW][((size_t)layer * 1024 + c + 1) * 32 + e]);
    }
    for (int i = gt; i < 2 * 64 * 64; i += NGT) {
        const int d = i >> 12, g = (i >> 6) & 63;
        const float lr = a->in[I_LAMRE][i], li = a->in[I_LAMIM][i], dt = expf(a->in[I_LOGDT][d * 64 + g]);
        const float zr = lr * dt, zi = li * dt, mag = expf(zr);
        ((f32x2*)(ws + WS_S5LAM))[i] = (f32x2){mag * cosf(zi), mag * sinf(zi)};
    }
    for (int i = gt; i < 2 * 64 * 4 * 64; i += NGT) {
        const int l = i & 63, nt_ = (i >> 6) & 3, g = (i >> 8) & 63, d = i >> 14;
        const int p = (nt_ >> 1) * 32 + (l & 31), im = nt_ & 1, dg = d * 64 + g;
        const float lr = a->in[I_LAMRE][dg * 64 + p], li = a->in[I_LAMIM][dg * 64 + p], dt = expf(a->in[I_LOGDT][dg]);
        const float zr = lr * dt, zi = li * dt, mag = expf(zr), ar = mag * cosf(zi), ai = mag * sinf(zi), den = lr * lr + li * li;
        const float cr = ((ar - 1.f) * lr + ai * li) / den, ci = (ai * lr - (ar - 1.f) * li) / den;
        float o[8];
#pragma unroll
        for (int j = 0; j < 8; ++j) { const int h = 8 * (l >> 5) + j; const float br = a->in[I_BRE][((size_t)dg * 64 + p) * 16 + h], bi = a->in[I_BIM][((size_t)dg * 64 + p) * 16 + h];
            o[j] = im ? (cr * bi + ci * br) : (cr * br - ci * bi); }
        u32x4 w; w.x = cvt_pk_bf16(o[0], o[1]); w.y = cvt_pk_bf16(o[2], o[3]); w.z = cvt_pk_bf16(o[4], o[5]); w.w = cvt_pk_bf16(o[6], o[7]);
        ((u32x4*)(ws + WS_S5BF))[i] = w;
    }
    for (int i = gt; i < 2 * 64 * 4 * 64; i += NGT) {
        const int l = i & 63, ks = (i >> 6) & 3, g = (i >> 8) & 63, d = i >> 14, dg = d * 64 + g, hp = l & 15;
        float o[8];
#pragma unroll
        for (int j = 0; j < 8; ++j) { const int k = 32 * ks + 8 * (l >> 4) + j, p = k >> 1;
            o[j] = (k & 1) ? -a->in[I_CIM][((size_t)dg * 16 + hp) * 64 + p] : a->in[I_CRE][((size_t)dg * 16 + hp) * 64 + p]; }
        u32x4 w; w.x = cvt_pk_bf16(o[0], o[1]); w.y = cvt_pk_bf16(o[2], o[3]); w.z = cvt_pk_bf16(o[4], o[5]); w.w = cvt_pk_bf16(o[6], o[7]);
        ((u32x4*)(ws + WS_S5CF))[i] = w;
    }
    const int gw = bx * NWAVES + wave, NGW = G * NWAVES;
    convert_weights(a, lds + wave * 8704, lane, gw, NGW, true, 0, CONV_SPLIT, 0, 1 << 30);
}

template <bool BLOCKED> __device__ __forceinline__ int colof(int lane, int j) { return BLOCKED ? 16 * lane + 4 * j : 256 * j + 4 * lane; }

__device__ __forceinline__ const void* x_row_ptr(KArgs a, int layer, int row, int b, int s) {
    if (layer == 0) return s < CTXL ? a->in[I_CTX] + ((size_t)b * CTXL + s) * DM : a->in[I_X] + ((size_t)b * SEQ + (s - CTXL)) * DM;
    return (const bf16*)(a->ws + WS_XS) + (size_t)row * DM;
}
__device__ __forceinline__ f32x4 bf4_to_f32(u32x2 w) { return (f32x4){bf_lo(w.x), bf_hi(w.x), bf_lo(w.y), bf_hi(w.y)}; }
__device__ __forceinline__ u32x2 f32_to_bf4(f32x4 v) { u32x2 w; w.x = cvt_pk_bf16(v.x, v.y); w.y = cvt_pk_bf16(v.z, v.w); return w; }
template <bool BLOCKED>
__device__ __forceinline__ void row_loads(KArgs a, const void* xr, bool f32src, int row, int lane, bool combine, f32x4 (&v)[4], unsigned (&yw)[4][4]) {
    if (f32src) {
#pragma unroll
        for (int j = 0; j < 4; ++j) v[j] = *(const GAS f32x4*)((const float*)xr + colof<BLOCKED>(lane, j));
    } else {
#pragma unroll
        for (int j = 0; j < 4; ++j) v[j] = bf4_to_f32(*(const GAS u32x2*)((const bf16*)xr + colof<BLOCKED>(lane, j)));
    }
    if (combine) {
        const unsigned char* yb = a->ws + WS_YB + (size_t)row * 4 * DM;
#pragma unroll
        for (int j = 0; j < 4; ++j)
#pragma unroll
            for (int k = 0; k < 4; ++k) yw[j][k] = *(const GAS unsigned*)(yb + (size_t)k * DM + colof<BLOCKED>(lane, j));
    }
}
__device__ __forceinline__ f32x4 y8_sum(const unsigned (&w)[4]) {
    f32x4 s = (f32x4){0.f, 0.f, 0.f, 0.f};
#pragma unroll
    for (int k = 0; k < 4; ++k) { const f32x2 lo = __builtin_amdgcn_cvt_pk_f32_fp8(w[k], false), hi = __builtin_amdgcn_cvt_pk_f32_fp8(w[k], true); s.x += lo.x; s.y += lo.y; s.z += hi.x; s.w += hi.y; }
    return s * (1.0f / Y8_SCALE);
}
template <bool BLOCKED>
__device__ __forceinline__ void row_combine(KArgs a, int row, int lane, const float* gate_prev, f32x4 (&v)[4], const unsigned (&yw)[4][4]) {
    bf16* xw = (bf16*)(a->ws + WS_XS) + (size_t)row * DM;
#pragma unroll
    for (int j = 0; j < 4; ++j) {
        const int c = colof<BLOCKED>(lane, j);
        const f32x4 s = y8_sum(yw[j]);
        const f32x4 g = *(const GAS f32x4*)(gate_prev + c);
        v[j] = v[j] + g * s;
        *(GAS u32x2*)(xw + c) = f32_to_bf4(v[j]);
    }
}
template <bool BLOCKED>
__device__ __forceinline__ void load_x_row(KArgs a, int row, int lane, bool combine, const float* gate_prev, f32x4 (&v)[4]) {
    unsigned yw[4][4];
    row_loads<BLOCKED>(a, (const bf16*)(a->ws + WS_XS) + (size_t)row * DM, false, row, lane, combine, v, yw);
    if (combine) row_combine<BLOCKED>(a, row, lane, gate_prev, v, yw);
}
template <bool BLOCKED>
__device__ __forceinline__ void norm_mod(f32x4 (&v)[4], int lane, const float* g, const float* shift, const float* scale) {
    float ss = 0.f;
#pragma unroll
    for (int j = 0; j < 4; ++j) ss += (v[j].x * v[j].x + v[j].y * v[j].y) + (v[j].z * v[j].z + v[j].w * v[j].w);
    const float inv = rsqrtf(wave_sum(ss) * (1.f / DM) + NORM_EPS);
#pragma unroll
    for (int j = 0; j < 4; ++j) {
        const int c = colof<BLOCKED>(lane, j);
        const f32x4 gg = *(const GAS f32x4*)(g + c), sh = *(const GAS f32x4*)(shift + c), sc = *(const GAS f32x4*)(scale + c);
        v[j] = (v[j] * inv) * gg * (sc + 1.f) + sh;
    }
}

template <bool BLOCKED>
__device__ __forceinline__ void norm1_finish(KArgs a, int layer, int row, int b, int s, int lane, bool combine, f32x4 (&v)[4], const unsigned (&yw)[4][4]) {
    const int mrow = s < CTXL ? 8 : b;
    const float* md = mods_ptr(a, layer, mrow);
    if (combine) row_combine<BLOCKED>(a, row, lane, mods_ptr(a, layer - 1, mrow) + 5 * DM, v, yw);
    norm_mod<BLOCKED>(v, lane, a->in[I_N1G] + layer * DM, md, md + DM);
    if constexpr (!BLOCKED) {
        if (layer % 3 == 2) {
            unsigned char* o8 = a->ws + WS_B1 + (size_t)row * DM;
#pragma unroll
            for (int j = 0; j < 4; ++j) *(GAS unsigned*)(o8 + 256 * j + 4 * lane) = cvt_pk4_fp8(v[j].x, v[j].y, v[j].z, v[j].w);
        } else {
            bf16* o = (bf16*)(a->ws + WS_B1) + (size_t)row * DM;
#pragma unroll
            for (int j = 0; j < 4; ++j) { u32x2 w; w.x = cvt_pk_bf16(v[j].x, v[j].y); w.y = cvt_pk_bf16(v[j].z, v[j].w); *(GAS u32x2*)(o + 256 * j + 4 * lane) = w; }
        }
    } else {
        bf16* o = (bf16*)(a->ws + WS_B1) + (((size_t)b * 64 + lane) * SEG + s) * 16;
        u32x4 w0, w1;
        w0.x = cvt_pk_bf16(v[0].x, v[0].y); w0.y = cvt_pk_bf16(v[0].z, v[0].w); w0.z = cvt_pk_bf16(v[1].x, v[1].y); w0.w = cvt_pk_bf16(v[1].z, v[1].w);
        w1.x = cvt_pk_bf16(v[2].x, v[2].y); w1.y = cvt_pk_bf16(v[2].z, v[2].w); w1.z = cvt_pk_bf16(v[3].x, v[3].y); w1.w = cvt_pk_bf16(v[3].z, v[3].w);
        *(GAS u32x4*)o = w0; *(GAS u32x4*)(o + 8) = w1;
    }
}
template <bool BLOCKED>
__device__ __forceinline__ void phase_norm1(KArgs a, int layer, int lane, int wave) {
    const int gw = blockIdx.x * NWAVES + wave, NGW = gridDim.x * NWAVES;
    const bool combine = layer > 0, last = layer == MK_LAYERS - 1;
    for (int rowA = gw; rowA < NR; rowA += 2 * NGW) {
        const int rowB = rowA + NGW;
        const int bA = rowA / SEG, sA = rowA - bA * SEG, bB = rowB / SEG, sB = rowB - bB * SEG;
        const bool doA = !(last && sA < CTXL), doB = rowB < NR && !(last && sB < CTXL);
        f32x4 vA[4], vB[4]; unsigned yA[4][4], yB[4][4];
        if (doA) row_loads<BLOCKED>(a, x_row_ptr(a, layer, rowA, bA, sA), layer == 0, rowA, lane, combine, vA, yA);
        if (doB) row_loads<BLOCKED>(a, x_row_ptr(a, layer, rowB, bB, sB), layer == 0, rowB, lane, combine, vB, yB);
        if (doA) norm1_finish<BLOCKED>(a, layer, rowA, bA, sA, lane, combine, vA, yA);
        if (doB) norm1_finish<BLOCKED>(a, layer, rowB, bB, sB, lane, combine, vB, yB);
    }
}

__device__ __forceinline__ void phase_pooldiff(KArgs a, LAS unsigned char* lds, int layer, int tid, int lane, int wave) {
    const bool last = layer == MK_LAYERS - 1;
    const bf16* H = (const bf16*)(a->ws + WS_B1); bf16* Dd = (bf16*)(a->ws + WS_B2);
    constexpr int NCH = NR / 32;
    const int nch = last ? NB * 128 : NCH;
    for (int c = blockIdx.x; c < nch; c += gridDim.x) {
        const int b = last ? (c >> 7) : c / 136, cc = last ? 8 + (c & 127) : c - b * 136, s0 = cc * 32;
        const int seg_lo = cc < 8 ? 0 : CTXL, seg_hi = cc < 8 ? CTXL : SEG;
        const int st_lo = max(s0 - 8, seg_lo), st_hi = min(s0 + 40, seg_hi);
        __syncthreads();
        for (int p = tid; p < (st_hi - st_lo) * 128; p += NTHR) {
            const int r = p >> 7, q = p & 127;
            *(LAS u32x4*)(lds + (size_t)(st_lo + r - (s0 - 8)) * 2048 + q * 16) = *(const GAS u32x4*)(H + ((size_t)b * SEG + st_lo + r) * DM + q * 8);
        }
        __syncthreads();
#pragma unroll 1
        for (int rr = 0; rr < 4; ++rr) {
            const int s = s0 + wave * 4 + rr;
#pragma unroll
            for (int j = 0; j < 4; ++j) {
                const int half = 1 << j;
                const int lo = max(s - half, seg_lo), hi = min(s + half, seg_hi);
                f32x4 sum = (f32x4){0.f, 0.f, 0.f, 0.f};
                for (int t = lo; t < hi; ++t) { const u32x2 w = *(const LAS u32x2*)(lds + (size_t)(t - (s0 - 8)) * 2048 + (256 * j + 4 * lane) * 2); sum.x += bf_lo(w.x); sum.y += bf_hi(w.x); sum.z += bf_lo(w.y); sum.w += bf_hi(w.y); }
                const u32x2 w = *(const LAS u32x2*)(lds + (size_t)(s - (s0 - 8)) * 2048 + (256 * j + 4 * lane) * 2);
                const float ic = 1.f / (float)(hi - lo);
                *(GAS unsigned*)((unsigned char*)Dd + ((size_t)b * SEG + s) * DM + 256 * j + 4 * lane) = cvt_pk4_fp8(sum.x * ic - bf_lo(w.x), sum.y * ic - bf_hi(w.x), sum.z * ic - bf_lo(w.y), sum.w * ic - bf_hi(w.y));
            }
        }
    }
    __syncthreads();
}

__device__ __forceinline__ void phase_norm1_pooldiff(KArgs a, LAS unsigned char* lds, int layer, int tid, int lane, int wave) {
    const bool last = layer == MK_LAYERS - 1, combine = layer > 0;
    bf16* Dd = (bf16*)(a->ws + WS_B2);
    constexpr int NCH = NR / 32;
    const int nch = last ? NB * 128 : NCH;
    for (int c = blockIdx.x; c < nch; c += gridDim.x) {
        const int b = last ? (c >> 7) : c / 136, cc = last ? 8 + (c & 127) : c - b * 136, s0 = cc * 32;
        const int seg_lo = cc < 8 ? 0 : CTXL, seg_hi = cc < 8 ? CTXL : SEG, mrow = cc < 8 ? 8 : b;
        const int st_lo = max(s0 - 8, seg_lo), st_hi = min(s0 + 40, seg_hi);
        const float* md = mods_ptr(a, layer, mrow);
        __syncthreads();
#pragma unroll 1
        for (int i = 0; i < 6; i += 3) {
            int sR[3], rowR[3]; bool doR[3];
            f32x4 vR[3][4]; unsigned yR[3][4][4];
#pragma unroll
            for (int q = 0; q < 3; ++q) { sR[q] = s0 - 8 + wave + 8 * (i + q); doR[q] = sR[q] >= st_lo && sR[q] < st_hi; rowR[q] = b * SEG + sR[q]; }
#pragma unroll
            for (int q = 0; q < 3; ++q) if (doR[q]) row_loads<false>(a, x_row_ptr(a, layer, rowR[q], b, sR[q]), layer == 0, rowR[q], lane, combine, vR[q], yR[q]);
#pragma unroll
            for (int q = 0; q < 3; ++q) {
                if (!doR[q]) continue;
                f32x4 (&v)[4] = vR[q]; const unsigned (&yw)[4][4] = yR[q]; const int s = sR[q], row = rowR[q];
                if (combine) {
                    const float* gate_prev = mods_ptr(a, layer - 1, mrow) + 5 * DM;
                    const bool own = s >= s0 && s < s0 + 32;
                    bf16* xw = (bf16*)(a->ws + WS_B1) + (size_t)row * DM;
#pragma unroll
                    for (int j = 0; j < 4; ++j) { const int cidx = 256 * j + 4 * lane; v[j] = v[j] + *(const GAS f32x4*)(gate_prev + cidx) * y8_sum(yw[j]); if (own) *(GAS u32x2*)(xw + cidx) = f32_to_bf4(v[j]); }
                }
                norm_mod<false>(v, lane, a->in[I_N1G] + layer * DM, md, md + DM);
#pragma unroll
                for (int j = 0; j < 4; ++j) *(LAS u32x2*)(lds + (size_t)(s - (s0 - 8)) * 2048 + (256 * j + 4 * lane) * 2) = f32_to_bf4(v[j]);
            }
        }
        LDS_WAIT(); __syncthreads();
#pragma unroll 1
        for (int rr = 0; rr < 4; ++rr) {
            const int s = s0 + wave * 4 + rr;
#pragma unroll
            for (int j = 0; j < 4; ++j) {
                const int half = 1 << j;
                const int lo = max(s - half, seg_lo), hi = min(s + half, seg_hi);
                f32x4 sum = (f32x4){0.f, 0.f, 0.f, 0.f};
                for (int t = lo; t < hi; ++t) { const u32x2 w = *(const LAS u32x2*)(lds + (size_t)(t - (s0 - 8)) * 2048 + (256 * j + 4 * lane) * 2); sum.x += bf_lo(w.x); sum.y += bf_hi(w.x); sum.z += bf_lo(w.y); sum.w += bf_hi(w.y); }
                const u32x2 w = *(const LAS u32x2*)(lds + (size_t)(s - (s0 - 8)) * 2048 + (256 * j + 4 * lane) * 2);
                const float ic = 1.f / (float)(hi - lo);
                *(GAS unsigned*)((unsigned char*)Dd + ((size_t)b * SEG + s) * DM + 256 * j + 4 * lane) = cvt_pk4_fp8(sum.x * ic - bf_lo(w.x), sum.y * ic - bf_hi(w.x), sum.z * ic - bf_lo(w.y), sum.w * ic - bf_hi(w.y));
            }
        }
    }
    __syncthreads();
}

__device__ __forceinline__ void phase_s5_readout(KArgs a, int layer, int lane, int wave) {
    const int gw = blockIdx.x * NWAVES + wave, NGW = gridDim.x * NWAVES;
    const float* g1 = a->in[I_N1G] + layer * DM; const float* dsk = a->in[I_SSMD];
    const bf16* YG = (const bf16*)(a->ws + WS_YG);
    for (int row = gw; row < NR; row += NGW) {
        const int b = row / SEG, s = row - b * SEG, mrow = s < CTXL ? 8 : b;
        const float* md = mods_ptr(a, layer, mrow);
        f32x4 v[4];
        load_x_row<true>(a, row, lane, false, nullptr, v);
        norm_mod<true>(v, lane, g1, md, md + DM);
        const unsigned yoff = (unsigned)(b * 64 * SEG + s) * 16u + (unsigned)lane * (unsigned)(SEG * 16);
        const bf16* y0 = YG + yoff;
        const bf16* y1 = YG + yoff + (unsigned)(NB * 64 * SEG * 16);
        u32x4 ya[2], yb[2];
        ya[0] = *(const GAS u32x4*)y0; ya[1] = *(const GAS u32x4*)(y0 + 8); yb[0] = *(const GAS u32x4*)y1; yb[1] = *(const GAS u32x4*)(y1 + 8);
        unsigned pk[4];
#pragma unroll
        for (int j = 0; j < 4; ++j) {
            const unsigned a0 = ya[j >> 1][(j & 1) * 2], a1 = ya[j >> 1][(j & 1) * 2 + 1], b0 = yb[j >> 1][(j & 1) * 2], b1 = yb[j >> 1][(j & 1) * 2 + 1];
            const f32x4 ysum = (f32x4){bf_lo(a0) + bf_lo(b0), bf_hi(a0) + bf_hi(b0), bf_lo(a1) + bf_lo(b1), bf_hi(a1) + bf_hi(b1)};
            const f32x4 dd = *(const GAS f32x4*)(dsk + 16 * lane + 4 * j);
            f32x4 y = ysum + dd * v[j];
            float o[4];
#pragma unroll
            for (int i = 0; i < 4; ++i) { const float t = y[i]; o[i] = t * __builtin_amdgcn_rcpf(1.0f + __builtin_amdgcn_exp2f(-2.3022082f * (t + 0.044715f * t * t * t))); }
            pk[j] = cvt_pk4_fp8(o[0], o[1], o[2], o[3]);
        }
        *(GAS u32x4*)(a->ws + WS_B2 + (size_t)row * DM + 16 * lane) = (u32x4){pk[0], pk[1], pk[2], pk[3]};
    }
}

__device__ __forceinline__ void qk_head(bf16* p, unsigned char* p8, const float* g, const f32x2* rope, int t, bool latent, int q8) {
    const int ax = q8 >> 2, f0 = (q8 & 3) * 8, d1 = ax * 64 + f0;
    const u32x4 w1 = *(const GAS u32x4*)(p + d1), w2 = *(const GAS u32x4*)(p + d1 + 32);
    float x1[8], x2[8];
#pragma unroll
    for (int j = 0; j < 4; ++j) { x1[2 * j] = bf_lo(w1[j]); x1[2 * j + 1] = bf_hi(w1[j]); x2[2 * j] = bf_lo(w2[j]); x2[2 * j + 1] = bf_hi(w2[j]); }
    float ss = 0.f;
#pragma unroll
    for (int j = 0; j < 8; ++j) ss += x1[j] * x1[j] + x2[j] * x2[j];
    ss += __shfl_xor(ss, 1); ss += __shfl_xor(ss, 2); ss += __shfl_xor(ss, 4);
    const float inv = rsqrtf(ss * (1.f / 128.f) + NORM_EPS);
    const int pos = ax == 0 ? (t >> 6) : (t & 63);
    float y1[8], y2[8];
#pragma unroll
    for (int j = 0; j < 4; ++j) {
        const f32x2 ga = *(const GAS f32x2*)(g + d1 + 2 * j), gb = *(const GAS f32x2*)(g + d1 + 32 + 2 * j);
        float a0 = x1[2 * j] * inv * ga.x, a1 = x1[2 * j + 1] * inv * ga.y, b0 = x2[2 * j] * inv * gb.x, b1 = x2[2 * j + 1] * inv * gb.y;
        if (latent) {
            const f32x4 cs = *(const GAS f32x4*)(rope + pos * 32 + f0 + 2 * j);
            const float r0 = a0 * cs.x - b0 * cs.y, s0 = b0 * cs.x + a0 * cs.y, r1 = a1 * cs.z - b1 * cs.w, s1 = b1 * cs.z + a1 * cs.w;
            a0 = r0; b0 = s0; a1 = r1; b1 = s1;
        }
        y1[2 * j] = a0; y1[2 * j + 1] = a1; y2[2 * j] = b0; y2[2 * j + 1] = b1;
    }
    const int off = 64 * (q8 & 1) + 32 * ax + 8 * ((q8 & 3) >> 1);
    *(GAS u32x2*)(p8 + off) = (u32x2){cvt_pk4_fp8(y1[0], y1[1], y1[2], y1[3]), cvt_pk4_fp8(y1[4], y1[5], y1[6], y1[7])};
    *(GAS u32x2*)(p8 + off + 16) = (u32x2){cvt_pk4_fp8(y2[0], y2[1], y2[2], y2[3]), cvt_pk4_fp8(y2[4], y2[5], y2[6], y2[7])};
}
constexpr int V8T_TILE = 128 * 64;
__device__ __forceinline__ void phase_qkpost(KArgs a, LAS unsigned char* lds, int tid, int lane, int wave) {
    const int gw = blockIdx.x * NWAVES + wave, NGW = gridDim.x * NWAVES;
    const f32x2* rope = (const f32x2*)(a->ws + WS_ROPE);
    for (int row4 = gw * 4; row4 < NR; row4 += NGW * 4) {
        const int row = row4 + (lane >> 4), l16 = lane & 15;
        int s = (row4 - (row4 / SEG) * SEG) + (lane >> 4); if (s >= SEG) s -= SEG;
        const bool latent = s >= CTXL; const int t = s - CTXL;
        qk_head((bf16*)(a->ws + WS_KB) + (size_t)row * 256 + (l16 >> 3) * 128, a->ws + WS_B3 + (size_t)row * 256 + (l16 >> 3) * 128, a->in[I_KG], rope, t, latent, l16 & 7);
    }
    const bf16* Vb = (const bf16*)(a->ws + WS_VB); unsigned char* VT = a->ws + WS_YG;
    for (int item = blockIdx.x; item < NB * 2 * 68; item += gridDim.x) {
        const int b = item / 136, rem = item - b * 136, kvh = rem / 68, j = rem - kvh * 68;
        __syncthreads();
#pragma unroll
        for (int i = 0; i < 2; ++i) { const int p = tid + i * NTHR, key = p >> 4, piece = p & 15;
            *(LAS u32x4*)(lds + key * 272 + piece * 16) = *(const GAS u32x4*)(Vb + ((size_t)b * SEG + j * 64 + key) * 256 + kvh * 128 + piece * 8); }
        LDS_WAIT(); __syncthreads();
        const int d = tid >> 2, c = tid & 3, hh = c >> 1, kb = c & 1;
        float v[16];
#pragma unroll
        for (int t = 0; t < 16; ++t) { const int key = 32 * kb + (t & 3) + 8 * (t >> 2) + 4 * hh; v[t] = __uint_as_float((unsigned)*(const LAS unsigned short*)(lds + key * 272 + d * 2) << 16); }
        *(GAS u32x4*)(VT + (size_t)item * V8T_TILE + d * 64 + ((c ^ ((d >> 2) & 3)) << 4)) = (u32x4){cvt_pk4_fp8(v[0], v[1], v[2], v[3]), cvt_pk4_fp8(v[4], v[5], v[6], v[7]), cvt_pk4_fp8(v[8], v[9], v[10], v[11]), cvt_pk4_fp8(v[12], v[13], v[14], v[15])};
    }
    __syncthreads();
}

__device__ __forceinline__ void phase_final(KArgs a, int lane, int wave) {
    const int gw = blockIdx.x * NWAVES + wave, NGW = gridDim.x * NWAVES;
    for (int row = gw; row < NR; row += NGW) {
        const int b = row / SEG, s = row - b * SEG;
        if (s < CTXL) continue;
        f32x4 v[4]; unsigned yw[4][4];
        row_loads<false>(a, (const bf16*)(a->ws + WS_XS) + (size_t)row * DM, false, row, lane, true, v, yw);
        const float* gate = mods_ptr(a, MK_LAYERS - 1, b) + 5 * DM;
        float* o = a->out + ((size_t)b * SEQ + (s - CTXL)) * DM;
#pragma unroll
        for (int j = 0; j < 4; ++j) { const int c = 256 * j + 4 * lane; *(GAS f32x4*)(o + c) = v[j] + *(const GAS f32x4*)(gate + c) * y8_sum(yw[j]); }
    }
}

__device__ __forceinline__ int s5_token(int d, int j) { return d == 0 ? j : (j < CTXL ? (CTXL - 1 - j) : (SEG + CTXL - 1 - j)); }
__device__ __forceinline__ void phase_s5_scan(KArgs a, LAS unsigned char* lds, int lane, int wave) {
    if (wave >= 4) {
        convert_weights(a, lds + 4 * 8704 + (wave - 4) * 8704, lane, blockIdx.x * 4 + (wave - 4), gridDim.x * 4, false, CONV_SPLIT, MK_LAYERS, 0, CONV_SCAN_SHARE);
        return;
    }
    const int G = gridDim.x;
    __builtin_amdgcn_s_setprio(3);
    LAS unsigned* Hs = (LAS unsigned*)(lds + wave * 8704);
    const int hi = lane >> 5, c = lane & 31;
    const int rho = lane & 31, posA = 16 * ((rho >> 2) & 1) + (rho & 3) + 4 * (rho >> 3);
    for (int sid = blockIdx.x * 4 + wave; sid < NB * 64 * 2; sid += G * 4) {
        const int d = sid & 1, g = (sid >> 1) & 63, b = sid >> 7, dg = d * 64 + g;
        const bf16* U = (const bf16*)(a->ws + WS_B1) + ((size_t)b * 64 + g) * SEG * 16;
        unsigned* Y = (unsigned*)(a->ws + WS_YG) + ((size_t)(d * NB + b) * 64 + g) * SEG * 8;
        bf16x8 bfr[4], cfr[4];
#pragma unroll
        for (int n = 0; n < 4; ++n) { bfr[n] = *(const GAS bf16x8*)(a->ws + WS_S5BF + ((size_t)(dg * 4 + n) * 64 + lane) * 16); cfr[n] = *(const GAS bf16x8*)(a->ws + WS_S5CF + ((size_t)(dg * 4 + n) * 64 + lane) * 16); }
        const f32x2 lam0 = ((const f32x2*)(a->ws + WS_S5LAM))[dg * 64 + c], lam1 = ((const f32x2*)(a->ws + WS_S5LAM))[dg * 64 + 32 + c];
        float car[2][2] = {{0.f, 0.f}, {0.f, 0.f}};
        float pwr[2][8], pwi[2][8];
#pragma unroll
        for (int pp = 0; pp < 2; ++pp) { const float ar = pp ? lam1.x : lam0.x, ai = pp ? lam1.y : lam0.y; float pr = ar, pi = ai;
#pragma unroll
            for (int r = 0; r < 8; ++r) { pwr[pp][r] = pr; pwi[pp][r] = pi; const float tr = ar * pr - ai * pi, ti = ar * pi + ai * pr; pr = tr; pi = ti; } }
        bf16x8 uf[4];
#pragma unroll
        for (int q = 0; q < 4; ++q) uf[q] = *(const GAS bf16x8*)(U + (size_t)s5_token(d, 32 * q + posA) * 16 + 8 * hi);
        for (int jb = 0; jb < SEG; jb += 128) {
#pragma unroll
          for (int q = 0; q < 4; ++q) {
            const int j0 = jb + 32 * q;
            const bf16x8 ufr = uf[q];
            if (j0 + 128 < SEG) uf[q] = *(const GAS bf16x8*)(U + (size_t)s5_token(d, j0 + 128 + posA) * 16 + 8 * hi);
            f32x16 x[4];
#pragma unroll
            for (int n = 0; n < 4; ++n) { x[n] = f32x16{}; x[n] = __builtin_amdgcn_mfma_f32_32x32x16_bf16(ufr, bfr[n], x[n], 0, 0, 0); }
#pragma unroll
            for (int pp = 0; pp < 2; ++pp) {
                const float ar = pp ? lam1.x : lam0.x, ai = pp ? lam1.y : lam0.y;
                float sr = hi == 0 ? car[pp][0] : 0.f, si = hi == 0 ? car[pp][1] : 0.f;
#pragma unroll
                for (int r = 0; r < 16; ++r) {
                    const float nr = fmaf(ar, sr, fmaf(-ai, si, x[2 * pp][r])), ni = fmaf(ar, si, fmaf(ai, sr, x[2 * pp + 1][r]));
                    sr = nr; si = ni; x[2 * pp][r] = sr; x[2 * pp + 1][r] = si;
                }
                float wr_ = __shfl(sr, c), wi_ = __shfl(si, c);
                if (hi == 0) { wr_ = 0.f; wi_ = 0.f; }
#pragma unroll
                for (int r = 0; r < 16; ++r) {
                    if (r == 8) { const float tr = pwr[pp][7] * wr_ - pwi[pp][7] * wi_, ti = pwr[pp][7] * wi_ + pwi[pp][7] * wr_; wr_ = tr; wi_ = ti; }
                    x[2 * pp][r] = fmaf(pwr[pp][r & 7], wr_, fmaf(-pwi[pp][r & 7], wi_, x[2 * pp][r])); x[2 * pp + 1][r] = fmaf(pwr[pp][r & 7], wi_, fmaf(pwi[pp][r & 7], wr_, x[2 * pp + 1][r]));
                }
                car[pp][0] = __shfl(x[2 * pp][15], c + 32); car[pp][1] = __shfl(x[2 * pp + 1][15], c + 32);
#pragma unroll
                for (int r = 0; r < 16; ++r) Hs[(16 * hi + r) * 68 + c + 32 * pp] = cvt_pk_bf16(x[2 * pp][r], x[2 * pp + 1][r]);
            }
            LDS_WAIT(); asm volatile("" ::: "memory");
#pragma unroll
            for (int mt = 0; mt < 2; ++mt) {
                f32x4 y = (f32x4){0.f, 0.f, 0.f, 0.f};
#pragma unroll
                for (int ks = 0; ks < 4; ++ks) {
                    const bf16x8 af = *(const LAS bf16x8*)(Hs + (16 * mt + (lane & 15)) * 68 + 16 * ks + 4 * (lane >> 4));
                    y = __builtin_amdgcn_mfma_f32_16x16x32_bf16(af, cfr[ks], y, 0, 0, 0);
                }
#pragma unroll
                for (int i = 0; i < 4; ++i) { const int pos = 16 * mt + 4 * (lane >> 4) + i; const float nb_ = __shfl_xor(y[i], 1);
                    if ((lane & 1) == 0) Y[(size_t)s5_token(d, j0 + pos) * 8 + ((lane & 15) >> 1)] = cvt_pk_bf16(y[i], nb_); }
            }
            LDS_WAIT(); asm volatile("" ::: "memory");
          }
        }
    }
    __builtin_amdgcn_s_setprio(0);
    convert_weights(a, lds + wave * 8704, lane, blockIdx.x * 4 + wave, gridDim.x * 4, false, CONV_SPLIT, MK_LAYERS, CONV_SCAN_SHARE, 1 << 30);
}

constexpr int RW_STRIDE = 2064;
__device__ __forceinline__ void phase_router(KArgs a, LAS unsigned char* lds, int layer, int tid, int lane, int wave) {
    const int G = gridDim.x, bx = blockIdx.x;
    const bool last = layer >= MK_LAYERS - 2;
    LAS unsigned char* Wl = lds;
    LAS int* ent_e = (LAS int*)(lds + RSCR_OFF); LAS float* ent_g = (LAS float*)(lds + RSCR_OFF + RPB_MAX * 16);
    LAS int* lcount = (LAS int*)(lds + RSCR_OFF + RPB_MAX * 32); LAS int* lbase = lcount + 32; LAS int* lfill = lcount + 64;
    { const u32x4* src = (const u32x4*)(a->ws + WS_RT) + (size_t)layer * 4096;
      for (int p = tid; p < 4096; p += NTHR) *(LAS u32x4*)(Wl + (p >> 7) * RW_STRIDE + (p & 127) * 16) = src[p]; }
    if (tid < 32) { lcount[tid] = 0; lfill[tid] = 0; }
    __syncthreads();
    const bool lat_deal = last && G == NB * 32;
    const int rpb = lat_deal ? 128 : (NR + G - 1) / G, row0 = lat_deal ? (bx >> 5) * SEG + CTXL + (bx & 31) * 128 : bx * rpb, row1 = lat_deal ? row0 + 128 : min(NR, row0 + rpb), nrows = row1 - row0;
    const float* g2 = a->in[I_N2G] + layer * DM; const float* rb = a->in[I_RB] + layer * 32;
    LAS unsigned char* Hl = lds + 32 * RW_STRIDE;
    const int s_row0 = row0 - (row0 / SEG) * SEG;
    const int hi = lane >> 5, tk = lane & 31;
    u32x2 xw[4][4];
#define RT_LOAD(g_) do { _Pragma("unroll") for (int q_ = 0; q_ < 4; ++q_) { const int lr_ = 32 * (g_) + 8 * q_ + wave; if (lr_ < nrows) { \
        const bf16* xr_ = (const bf16*)(a->ws + WS_XS) + (size_t)(row0 + lr_) * DM; _Pragma("unroll") for (int j_ = 0; j_ < 4; ++j_) xw[q_][j_] = *(const GAS u32x2*)(xr_ + 256 * j_ + 4 * lane); } } } while (0)
    RT_LOAD(0);
    const int ngroups = (nrows + 31) >> 5;
    for (int g = 0; g < ngroups; ++g) {
#pragma unroll
        for (int q = 0; q < 4; ++q) {
            const int lr = 32 * g + 8 * q + wave;
            if (lr < nrows) {
                int sl = s_row0 + lr; int bb = row0 / SEG; if (sl >= SEG) { sl -= SEG; bb += 1; }
                if (!(last && sl < CTXL)) {
                    const float* md = mods_ptr(a, layer, sl < CTXL ? 8 : bb);
                    f32x4 v[4];
#pragma unroll
                    for (int j = 0; j < 4; ++j) v[j] = bf4_to_f32(xw[q][j]);
                    norm_mod<false>(v, lane, g2, md + 3 * DM, md + 4 * DM);
                    unsigned char* o8 = a->ws + WS_B3F + (size_t)(row0 + lr) * DM;
#pragma unroll
                    for (int j = 0; j < 4; ++j) { *(LAS u32x2*)(Hl + (8 * q + wave) * RW_STRIDE + (256 * j + 4 * lane) * 2) = f32_to_bf4(v[j]);
                        if constexpr (MOE1_FMT != 2) *(GAS unsigned*)(o8 + 256 * j + 4 * lane) = cvt_pk4_fp8(v[j].x, v[j].y, v[j].z, v[j].w); }
                }
            }
        }
        if (g + 1 < ngroups) RT_LOAD(g + 1);
        LDS_WAIT(); __syncthreads();
        if constexpr (MOE1_FMT == 2) {
#pragma unroll
            for (int ps = 0; ps < 2; ++ps) {
                const int lr32 = 4 * wave + 2 * ps + (lane >> 5), lr = 32 * g + lr32, c = lane & 31;
                if (lr < nrows) {
                    const LAS unsigned char* hp = Hl + lr32 * RW_STRIDE + c * 64;
                    const u32x4 w0 = *(const LAS u32x4*)hp, w1 = *(const LAS u32x4*)(hp + 16), w2 = *(const LAS u32x4*)(hp + 32), w3 = *(const LAS u32x4*)(hp + 48);
                    const v16u32 x = {w0.x, w0.y, w0.z, w0.w, w1.x, w1.y, w1.z, w1.w, w2.x, w2.y, w2.z, w2.w, w3.x, w3.y, w3.z, w3.w};
                    fp6_chunk_store(x, a->ws + WS_B3F + (size_t)(row0 + lr) * DM, c);
                }
            }
        }
        const int wa = g & 7, wb = (g + 1) & 7;
        LAS float* part = (LAS float*)(lds + RPART_OFF);
        f32x16 acc = f32x16{};
        if (wave == wa || wave == wb) {
            const LAS unsigned char* hp = Hl + tk * RW_STRIDE + 16 * hi + (wave == wa ? 0 : 1024);
            const LAS unsigned char* wp = Wl + tk * RW_STRIDE + 16 * hi + (wave == wa ? 0 : 1024);
            f32x16 acc1 = f32x16{};
#pragma unroll 4
            for (int s0 = 0; s0 < 32; s0 += 2) {
                const bf16x8 af0 = *(const LAS bf16x8*)(wp + 32 * s0), bf0 = *(const LAS bf16x8*)(hp + 32 * s0), af1 = *(const LAS bf16x8*)(wp + 32 * s0 + 32), bf1 = *(const LAS bf16x8*)(hp + 32 * s0 + 32);
                acc = __builtin_amdgcn_mfma_f32_32x32x16_bf16(af0, bf0, acc, 0, 0, 0); acc1 = __builtin_amdgcn_mfma_f32_32x32x16_bf16(af1, bf1, acc1, 0, 0, 0); }
            acc = acc + acc1;
            if (wave == wb) {
#pragma unroll
                for (int r = 0; r < 16; ++r) part[r * 64 + lane] = acc[r];
            }
        }
        LDS_WAIT(); __syncthreads();
        if (wave == wa) {
            const int lrow = 32 * g + tk; const bool inrange = lrow < nrows;
            bool valid = inrange; { int sl_ = s_row0 + lrow; if (sl_ >= SEG) sl_ -= SEG; if (last && sl_ < CTXL) valid = false; }
#pragma unroll
            for (int r = 0; r < 16; ++r) acc[r] += part[r * 64 + lane];
            float NEG = -3.0e38f; asm volatile("" : "+v"(NEG));
            float v[16];
#pragma unroll
            for (int r = 0; r < 16; ++r) v[r] = acc[r] + rb[(r & 3) + 8 * (r >> 2) + 4 * hi];
            float cv[8]; int ce[8];
#pragma unroll
            for (int k = 0; k < 4; ++k) {
                float best = NEG; int bi = 0;
#pragma unroll
                for (int r = 0; r < 16; ++r) if (v[r] > best) { best = v[r]; bi = r; }
#pragma unroll
                for (int r = 0; r < 16; ++r) if (r == bi) v[r] = NEG;
                cv[k] = best; ce[k] = (bi & 3) + 8 * (bi >> 2) + 4 * hi;
            }
#pragma unroll
            for (int k = 0; k < 4; ++k) { cv[4 + k] = __shfl_xor(cv[k], 32); ce[4 + k] = __shfl_xor(ce[k], 32); }
            float sv[4]; int se[4];
#pragma unroll
            for (int k = 0; k < 4; ++k) {
                float best = NEG; int be = 64, bi = 0;
#pragma unroll
                for (int q = 0; q < 8; ++q) if (cv[q] > best || (cv[q] == best && ce[q] < be)) { best = cv[q]; be = ce[q]; bi = q; }
#pragma unroll
                for (int q = 0; q < 8; ++q) if (q == bi) cv[q] = NEG;
                sv[k] = best; se[k] = be;
            }
            if (hi == 0 && inrange) {
                const float e1 = __expf(sv[1] - sv[0]), e2 = __expf(sv[2] - sv[0]), e3 = __expf(sv[3] - sv[0]);
                const float isum = 1.f / (1.f + e1 + e2 + e3);
                const int inv = valid ? 0 : -1;
                ent_e[lrow * 4 + 0] = se[0] | inv; ent_g[lrow * 4 + 0] = isum;
                ent_e[lrow * 4 + 1] = se[1] | inv; ent_g[lrow * 4 + 1] = e1 * isum;
                ent_e[lrow * 4 + 2] = se[2] | inv; ent_g[lrow * 4 + 2] = e2 * isum;
                ent_e[lrow * 4 + 3] = se[3] | inv; ent_g[lrow * 4 + 3] = e3 * isum;
                if (valid) {
#pragma unroll
                    for (int k = 0; k < 4; ++k) atomicAdd((int*)&lcount[se[k]], 1);
                }
            }
        }
    }
#undef RT_LOAD
    __syncthreads();
    unsigned* cnt = (unsigned*)(a->ws + WS_CTL) + CW_CNT + layer * 32;
    if (tid < 32) lbase[tid] = (int)__hip_atomic_fetch_add(cnt + tid, (unsigned)lcount[tid], __ATOMIC_RELAXED, __HIP_MEMORY_SCOPE_AGENT);
    __syncthreads();
    int* list = (int*)(a->ws + WS_LIST); float* gate = (float*)(a->ws + WS_GATE);
    for (int i = tid; i < (row1 - row0) * 4; i += NTHR) {
        const int e = ent_e[i];
        if (e >= 0) { const int pos = lbase[e] + atomicAdd((int*)&lfill[e], 1); const int ent = (row0 + (i >> 2)) * 4 + (i & 3); list[(size_t)e * NR + pos] = ent; gate[(size_t)e * NR + pos] = ent_g[i]; }
    }
    __syncthreads();
}

typedef f32x4 AccT[2][2][4][2];
struct EpiResid {
    static constexpr int PERM = 2;
    bf16* xs; const float* mods_layer; const float* pscale;
    const float* in_x; const float* in_ctx;
    const bf16* src_bf;
    __device__ __forceinline__ void operator()(const AccT& acc, const pg8::Unit& u, int wr, int wc, int fr, int fq, const LAS int* tab) const {
        const int tile = u.pm, bb = tile / 17, tt = tile - bb * 17, mrow = tt == 0 ? 8 : bb;
        const float* gate = mods_layer + (size_t)mrow * NMOD + 2 * DM;
        const float* srcf = in_x ? (tt == 0 ? in_ctx + (size_t)bb * CTXL * DM : in_x + ((size_t)bb * SEQ + (tt - 1) * 256) * DM) : nullptr;
        bf16* dst = xs + (size_t)tile * 256 * DM; const bf16* srcb = (src_bf ? src_bf : xs) + (size_t)tile * 256 * DM;
        const int col0 = u.pn * 256 + wc * 64 + fq * 16;
        f32x4 gv[2][2];
#pragma unroll
        for (int bj = 0; bj < 2; ++bj)
#pragma unroll
            for (int n = 0; n < 2; ++n) { gv[bj][n] = *(const GAS f32x4*)(gate + col0 + 8 * bj + 4 * n); if (pscale) gv[bj][n] = gv[bj][n] * *(const GAS f32x4*)(pscale + col0 + 8 * bj + 4 * n); }
#pragma unroll
        for (int ai = 0; ai < 2; ++ai)
#pragma unroll
            for (int m = 0; m < 4; ++m) {
                const size_t o = (size_t)(ai * 128 + wr * 64 + m * 16 + fr) * DM + col0;
                f32x4 x[2][2];
                if (srcf) {
#pragma unroll
                    for (int bj = 0; bj < 2; ++bj)
#pragma unroll
                        for (int n = 0; n < 2; ++n) x[bj][n] = *(const GAS f32x4*)(srcf + o + 8 * bj + 4 * n);
                } else {
#pragma unroll
                    for (int bj = 0; bj < 2; ++bj) { const u32x4 w = *(const GAS u32x4*)(srcb + o + 8 * bj); x[bj][0] = bf4_to_f32((u32x2){w.x, w.y}); x[bj][1] = bf4_to_f32((u32x2){w.z, w.w}); }
                }
#pragma unroll
                for (int bj = 0; bj < 2; ++bj) { const u32x2 lo = f32_to_bf4(x[bj][0] + gv[bj][0] * acc[ai][bj][m][0]), hi2 = f32_to_bf4(x[bj][1] + gv[bj][1] * acc[ai][bj][m][1]);
                    *(GAS u32x4*)(dst + o + 8 * bj) = (u32x4){lo.x, lo.y, hi2.x, hi2.y}; }
            }
    }
};
struct EpiGlu {
    static constexpr int PERM = 1;
    bf16* xs; const float* mods_layer; const float* bias;
    __device__ __forceinline__ void operator()(const AccT& acc, const pg8::Unit& u, int wr, int wc, int fr, int fq, const LAS int* tab) const {
        const int tile = u.pm, mrow = (tile % 17 == 0) ? 8 : tile / 17;
        const float* gate = mods_layer + (size_t)mrow * NMOD + 2 * DM;
        const int col0 = u.pn * 128 + wc * 32 + 8 * fq;
        f32x4 gv[2], bv[2], bg[2];
#pragma unroll
        for (int n = 0; n < 2; ++n) { gv[n] = *(const GAS f32x4*)(gate + col0 + 4 * n); bv[n] = *(const GAS f32x4*)(bias + col0 + 4 * n); bg[n] = *(const GAS f32x4*)(bias + DM + col0 + 4 * n); }
#pragma unroll
        for (int ai = 0; ai < 2; ++ai)
#pragma unroll
            for (int m = 0; m < 4; ++m) {
                bf16* p = xs + (size_t)(tile * 256 + ai * 128 + wr * 64 + m * 16 + fr) * DM + col0;
                const u32x4 w = *(const GAS u32x4*)p;
                f32x4 x[2] = {bf4_to_f32((u32x2){w.x, w.y}), bf4_to_f32((u32x2){w.z, w.w})};
                u32x2 ow[2];
#pragma unroll
                for (int n = 0; n < 2; ++n) {
                    const f32x4 val = acc[ai][0][m][n] + bv[n], gt = acc[ai][1][m][n] + bg[n];
                    f32x4 o; o.x = val.x * sigmoidf_(gt.x); o.y = val.y * sigmoidf_(gt.y); o.z = val.z * sigmoidf_(gt.z); o.w = val.w * sigmoidf_(gt.w);
                    ow[n] = f32_to_bf4(x[n] + gv[n] * o);
                }
                *(GAS u32x4*)p = (u32x4){ow[0].x, ow[0].y, ow[1].x, ow[1].y};
            }
    }
};
struct EpiQkv {
    static constexpr int PERM = 2;
    bf16* q; bf16* k; bf16* v;
    __device__ __forceinline__ void operator()(const AccT& acc, const pg8::Unit& u, int wr, int wc, int fr, int fq, const LAS int* tab) const {
        bf16* base = u.pn < 4 ? q + u.pn * 256 : (u.pn == 4 ? k : v); const int ldc = u.pn < 4 ? 1024 : 256;
#pragma unroll
        for (int ai = 0; ai < 2; ++ai)
#pragma unroll
            for (int m = 0; m < 4; ++m) { bf16* rowp = base + (size_t)(u.pm * 256 + ai * 128 + wr * 64 + m * 16 + fr) * ldc + wc * 64 + 16 * fq;
#pragma unroll
                for (int bj = 0; bj < 2; ++bj) { const f32x4 v0 = acc[ai][bj][m][0], v1 = acc[ai][bj][m][1];
                    u32x4 w; w.x = cvt_pk_bf16(v0[0], v0[1]); w.y = cvt_pk_bf16(v0[2], v0[3]); w.z = cvt_pk_bf16(v1[0], v1[1]); w.w = cvt_pk_bf16(v1[2], v1[3]);
                    *(GAS u32x4*)(rowp + bj * 8) = w; } }
    }
};
struct EpiMoe1 {
    static constexpr int PERM = 1;
    unsigned char* act;
    __device__ __forceinline__ void operator()(const AccT& acc, const pg8::Unit& u, int wr, int wc, int fr, int fq, const LAS int* tab) const {
        const int cl = wc * 32 + 8 * fq, col0 = u.pn * 128 + cl;
        const LAS float* bt = (const LAS float*)(tab + 512);
        float c7 = 7.0f, ck = -2.4554669595930156f; asm volatile("" : "+v"(c7), "+v"(ck));
        f32x4 bg[2], bl[2];
#pragma unroll
        for (int n = 0; n < 2; ++n) { bg[n] = *(const LAS f32x4*)(bt + cl + 4 * n); bl[n] = *(const LAS f32x4*)(bt + 128 + cl + 4 * n); }
#pragma unroll
        for (int ai = 0; ai < 2; ++ai)
#pragma unroll
            for (int m = 0; m < 4; ++m) {
                float o[8];
#pragma unroll
                for (int n = 0; n < 2; ++n)
#pragma unroll
                    for (int jp = 0; jp < 2; ++jp) {
                        f32x2 g = (f32x2){acc[ai][0][m][n][2 * jp], acc[ai][0][m][n][2 * jp + 1]} + (f32x2){bg[n][2 * jp], bg[n][2 * jp + 1]};
                        f32x2 l = (f32x2){acc[ai][1][m][n][2 * jp], acc[ai][1][m][n][2 * jp + 1]} + (f32x2){bl[n][2 * jp], bl[n][2 * jp + 1]};
                        g.x = fminf(g.x, c7); g.y = fminf(g.y, c7);
                        l.x = __builtin_amdgcn_fmed3f(l.x, -c7, c7); l.y = __builtin_amdgcn_fmed3f(l.y, -c7, c7);
                        f32x2 t = g * ck;
                        t.x = __builtin_amdgcn_exp2f(t.x); t.y = __builtin_amdgcn_exp2f(t.y);
                        t = t + 1.0f;
                        t.x = __builtin_amdgcn_rcpf(t.x); t.y = __builtin_amdgcn_rcpf(t.y);
                        const f32x2 r = (g * t) * (l + 1.0f);
                        o[4 * n + 2 * jp] = r.x; o[4 * n + 2 * jp + 1] = r.y;
                    }
                u32x2 w; w.x = cvt_pk4_fp8(o[0], o[1], o[2], o[3]); w.y = cvt_pk4_fp8(o[4], o[5], o[6], o[7]);
                *(GAS u32x2*)(act + (size_t)(u.pm * 256 + ai * 128 + wr * 64 + m * 16 + fr) * DFF + col0) = w;
            }
    }
};
struct EpiNull {
    static constexpr int PERM = 1;
    float* sink;
    __device__ __forceinline__ void operator()(const AccT& acc, const pg8::Unit& u, int wr, int wc, int fr, int fq, const LAS int* tab) const {
        f32x4 s = (f32x4){0.f, 0.f, 0.f, 0.f};
#pragma unroll
        for (int ai = 0; ai < 2; ++ai)
#pragma unroll
            for (int bj = 0; bj < 2; ++bj)
#pragma unroll
                for (int m = 0; m < 4; ++m)
#pragma unroll
                    for (int n = 0; n < 2; ++n) s = s + acc[ai][bj][m][n];
        sink[(size_t)(u.pm * 256 + wr * 64 + fr) * 64 + wc * 16 + fq * 4 + (u.pn & 3)] = (s.x + s.y) + (s.z + s.w);
    }
};
struct EpiMoe2 {
    static constexpr int PERM = 2;
    unsigned char* yb;
    __device__ __forceinline__ void operator()(const AccT& acc, const pg8::Unit& u, int wr, int wc, int fr, int fq, const LAS int* tab) const {
        const int cl = wc * 64 + 16 * fq, col0 = u.pn * 256 + cl;
        const LAS float* bt = (const LAS float*)(tab + 512); const LAS float* gt = (const LAS float*)(tab + 256);
        f32x4 bv[2][2];
#pragma unroll
        for (int bj = 0; bj < 2; ++bj)
#pragma unroll
            for (int n = 0; n < 2; ++n) bv[bj][n] = *(const LAS f32x4*)(bt + cl + 8 * bj + 4 * n);
#pragma unroll
        for (int ai = 0; ai < 2; ++ai)
#pragma unroll
            for (int m = 0; m < 4; ++m) {
                const int rl = ai * 128 + wr * 64 + m * 16 + fr;
                const int ent = (u.rb * 256 + rl < u.cnt) ? tab[rl] : NR * 4; const float g = gt[rl] * Y8_SCALE;
                u32x4 w;
#pragma unroll
                for (int bj = 0; bj < 2; ++bj) { const f32x4 v0 = (acc[ai][bj][m][0] + bv[bj][0]) * g, v1 = (acc[ai][bj][m][1] + bv[bj][1]) * g;
                    w[2 * bj] = cvt_pk4_fp8(v0[0], v0[1], v0[2], v0[3]); w[2 * bj + 1] = cvt_pk4_fp8(v1[0], v1[1], v1[2], v1[3]); }
                *(GAS u32x4*)(yb + (size_t)ent * DM + col0) = w;
            }
    }
};

constexpr int PH_PER_LAYER = 8, PH_FINAL = 1 + MK_LAYERS * PH_PER_LAYER, N_PHASES = PH_FINAL + 1;

__global__ void __launch_bounds__(NTHR, 2) mega_fwd(Args args_byval) {
    KArgs args = (KArgs)__builtin_amdgcn_kernarg_segment_ptr();
    extern __shared__ __attribute__((aligned(16))) unsigned char lds_raw[];
    LAS unsigned char* lds = (LAS unsigned char*)lds_raw;
    int tid = threadIdx.x, lane = tid & 63, wave = __builtin_amdgcn_readfirstlane(tid >> 6);
    const int G = gridDim.x, bx = blockIdx.x;
    volatile LAS unsigned* MISC = (volatile LAS unsigned*)(lds + MISC_OFF);
    if (tid < 16) MISC[tid] = 0u;
    __syncthreads();
    unsigned* ctl = (unsigned*)(args->ws + WS_CTL);
    XcdBarrier bar; bar.bar = ctl + CW_BAR; bar.x = 0; bar.st = nullptr;
    if (!MK_SPLIT) bar = xcd_barrier_post(ctl + CW_BAR, MISC);
    const int lo = args->ph_lo, hi = args->ph_hi;
#define IN(k) (lo <= (k) && (k) < hi)
#define SEAM(k) do { if (!MK_SPLIT && (k) + 1 < hi) xcd_barrier(bar); } while (0)
    LAS int* rowtab = (LAS int*)(lds + ROWTAB_OFF);

    if (IN(0)) { if (EN(0)) for (int rep = 0; rep < NREP(0); ++rep) prologue(args, lds, tid, lane, wave); }
    if (!MK_SPLIT) xcd_barrier_census(bar);
    if (IN(0)) SEAM(0);

    for (int layer = 0; layer < MK_LAYERS; ++layer) {
        const int kind = layer % 3, base = 1 + layer * PH_PER_LAYER;
        asm volatile("" : "+s"(args));
        tid = threadIdx.x; asm volatile("" : "+v"(tid)); lane = tid & 63; wave = __builtin_amdgcn_readfirstlane(tid >> 6);
        const float* mods_layer = (const float*)(args->ws + WS_MODS) + (size_t)layer * 9 * NMOD;
        bf16* xs = (bf16*)(args->ws + WS_XS);
        if (IN(base + 0)) {
            if (EN(1)) { if (kind == 1) phase_norm1<true>(args, layer, lane, wave); else if (kind == 2) phase_norm1<false>(args, layer, lane, wave); }
            if (kind != 0) SEAM(base + 0);
        }
        if (IN(base + 1)) {
            if (kind == 0) { if (EN(2)) phase_norm1_pooldiff(args, lds, layer, tid, lane, wave); }
            else if (kind == 1) { if (EN(3)) for (int rep = 0; rep < NREP(3); ++rep) phase_s5_scan(args, lds, lane, wave); }
            else if (EN(4)) for (int rep = 0; rep < NREP(4); ++rep) {
                pg8::StaticSchedG S{{(const char*)(args->ws + WS_B1), (const char*)(args->ws + WS_WQKV), (size_t)256 * DM, (size_t)256 * DM, NTILE, 6, NTILE * 6, G, bx, 0, 0}};
                EpiQkv E{(bf16*)(args->ws + WS_B2), (bf16*)(args->ws + WS_KB), (bf16*)(args->ws + WS_VB)};
                pg8::gemm_phase<EpiQkv, pg8::StaticSchedG, true, true>(tid, lds, rowtab, DM / 2, DM / 2, DM / 2, S, E);
            }
            SEAM(base + 1);
        }
        if (IN(base + 2)) {
            if (kind == 0) { if (EN(5)) for (int rep = 0; rep < NREP(5); ++rep) {
                const int j = layer / 3;
                pg8::StaticSchedG S{{(const char*)(args->ws + WS_B2), (const char*)(args->ws + WS_POOLW) + (size_t)j * 4 * 65536, (size_t)256 * DM, (size_t)256 * 256, NTILE, 4, NTILE * 4, G, bx, (size_t)256, 0}};
                EpiResid E{rep + 1 < NREP(5) ? (bf16*)(args->ws + WS_YG) : xs, mods_layer, args->in[I_POOLS] + j * DM, layer == 0 ? args->in[I_X] : nullptr, args->in[I_CTX], layer == 0 ? nullptr : (const bf16*)(args->ws + WS_B1)};
                pg8::gemm_phase<EpiResid, pg8::StaticSchedG, true, true>(tid, lds, rowtab, DM / 2, 128, 128, S, E);
            } } else if (kind == 1) { if (EN(6)) for (int rep = 0; rep < NREP(6); ++rep) phase_s5_readout(args, layer, lane, wave); }
            else { if (EN(7)) phase_qkpost(args, lds, tid, lane, wave); }
            SEAM(base + 2);
        }
        if (IN(base + 3) && kind != 0) {
            if (kind == 1) { if (EN(8)) for (int rep = 0; rep < NREP(8); ++rep) {
                pg8::StaticSchedG S{{(const char*)(args->ws + WS_B2), (const char*)(args->ws + WS_GLUW), (size_t)256 * DM, (size_t)256 * DM, NTILE, 8, NTILE * 8, G, bx, 0, 0}};
                EpiGlu E{rep + 1 < NREP(8) ? (bf16*)(args->ws + WS_YG) : xs, mods_layer, args->in[I_GLUB]};
                pg8::gemm_phase<EpiGlu, pg8::StaticSchedG, true, true>(tid, lds, rowtab, DM / 2, DM / 2, DM / 2, S, E);
            } } else if (EN(9)) for (int rep = 0; rep < NREP(9); ++rep) {
                const bf16* Q = (const bf16*)(args->ws + WS_B2); const unsigned char* Kb = args->ws + WS_B3  ; const unsigned char* Vt = args->ws + WS_YG  ; unsigned char* O = args->ws + WS_B1;
                const int vcu = (G % 8 == 0) ? (bx % 8) * (G / 8) + bx / 8 : bx;
                float gqm = fmaxf(fabsf(args->in[I_QG][lane]), fabsf(args->in[I_QG][lane + 64])), gkm = fmaxf(fabsf(args->in[I_KG][lane]), fabsf(args->in[I_KG][lane + 64]));
#pragma unroll
                for (int o_ = 1; o_ < 64; o_ <<= 1) { gqm = fmaxf(gqm, __shfl_xor(gqm, o_)); gkm = fmaxf(gkm, __shfl_xor(gkm, o_)); }
                const float mnC = __uint_as_float(__builtin_amdgcn_readfirstlane(__float_as_uint(-(128.0f * 1.02f) * gqm * gkm * (att::SCALE * 1.4426950408889634f))));
                for (int u = vcu; u < 1024; u += G) {
                    const int grp = u >> 6, b = grp >> 1, kvh = grp & 1, h = kvh * 4 + ((u & 63) >> 4), qb = u & 15;
                    const size_t qrow = (size_t)b * SEG + CTXL + qb * 256, krow = (size_t)b * SEG;
                    att::attn_dense_body(tid, Q + qrow * DM + h * 128, Kb + krow * 256 + kvh * 128, Vt + (size_t)(b * 2 + kvh) * 68 * att::V8T_TILE_, O + qrow * DM + h * 128, SEG, (char*)lds_raw, args->in[I_QG], (const f32x2*)(args->ws + WS_ROPE), qb * 256, mnC);
                }
                if constexpr (MK_LAYERS > 4) if (MK_LAYERS - layer > 2) for (int u = vcu; u < 64; u += G) {
                    const int b = u >> 3, h = u & 7, kvh = h >> 2;
                    const size_t qrow = (size_t)b * SEG;
                    att::attn_dense_body(tid, Q + qrow * DM + h * 128, Kb + qrow * 256 + kvh * 128, Vt + (size_t)(b * 2 + kvh) * 68 * att::V8T_TILE_, O + qrow * DM + h * 128, CTXL, (char*)lds_raw, args->in[I_QG], (const f32x2*)(args->ws + WS_ROPE), -1, mnC);
                }
            }
            SEAM(base + 3);
        }
        if (IN(base + 4) && kind == 2) { if (EN(10)) for (int rep = 0; rep < NREP(10); ++rep) {
            pg8::StaticSchedG S{{(const char*)(args->ws + WS_B1), (const char*)(args->ws + WS_WO), (size_t)256 * DM, (size_t)256 * DM, 128, 4, 128 * 4, G, bx, 0, 1}};
            EpiResid E{rep + 1 < NREP(10) ? (bf16*)(args->ws + WS_YG) : xs, mods_layer, nullptr, nullptr, nullptr, nullptr};
            pg8::gemm_phase<EpiResid, pg8::StaticSchedG, true, true>(tid, lds, rowtab, DM / 2, DM / 2, DM / 2, S, E); }
            SEAM(base + 4);
        }
        if (IN(base + 5)) { if (EN(11)) phase_router(args, lds, layer, tid, lane, wave); SEAM(base + 5); }
        if (IN(base + 6) || IN(base + 7)) {
            const unsigned* cnt = (const unsigned*)(args->ws + WS_CTL) + CW_CNT + layer * 32;
            const int cntl = (int)__hip_atomic_load(cnt + (lane & 31), __ATOMIC_RELAXED, __HIP_MEMORY_SCOPE_AGENT);
            const int nrb = (cntl + 255) >> 8;
            int incl = nrb;
#pragma unroll
            for (int o = 1; o < 32; o <<= 1) { const int t = __shfl_up(incl, o, 32); if ((lane & 31) >= o) incl += t; }
            const int pbl = incl - nrb, TB = __builtin_amdgcn_readlane(incl, 31);
            if (IN(base + 6)) { if (EN(12)) for (int rep = 0; rep < NREP(12); ++rep) {
                pg8::MoeSched<1> S{(const char*)(args->ws + WS_B3F), (const char*)(args->ws + WS_W1T) + (size_t)layer * 32 * 2048 * 1024, 0, (size_t)256 * DM, (size_t)2048 * 1024,
                                (const int*)(args->ws + WS_LIST), (const float*)(args->ws + WS_GATE), args->in[I_B1] + (size_t)layer * 32 * 2048, 8, TB * 8, G, bx, pbl, cntl};
                EpiMoe1 E{args->ws + WS_ACT};
                pg8::gemm_phase<EpiMoe1, pg8::MoeSched<1>, true, MOE1_FMT>(tid, lds, rowtab, DM / 2, DM / 2, DM / 2, S, E); }
                if (MK_PROBE_NULL) {
                    pg8::MoeSched<1> S{(const char*)(args->ws + WS_B3F), (const char*)(args->ws + WS_W1T) + (size_t)layer * 32 * 2048 * 1024, 0, (size_t)256 * DM, (size_t)2048 * 1024,
                                    (const int*)(args->ws + WS_LIST), (const float*)(args->ws + WS_GATE), args->in[I_B1] + (size_t)layer * 32 * 2048, 8, TB * 8, G, bx, pbl, cntl};
                    EpiNull E{(float*)(args->ws + WS_YG)};
                    pg8::gemm_phase<EpiNull, pg8::MoeSched<1>, true, MOE1_FMT>(tid, lds, rowtab, DM / 2, DM / 2, DM / 2, S, E);
                }
                SEAM(base + 6);
            }
            if (IN(base + 7)) { if (EN(13)) for (int rep = 0; rep < NREP(13); ++rep) {
                pg8::MoeSched<2> S{(const char*)(args->ws + WS_ACT), (const char*)(args->ws + WS_W2T) + (size_t)layer * 32 * 1024 * 1024, (size_t)256 * DFF, (size_t)256 * DFF, (size_t)1024 * 1024,
                                (const int*)(args->ws + WS_LIST), (const float*)(args->ws + WS_GATE), args->in[I_B2] + (size_t)layer * 32 * DM, 4, TB * 4, G, bx, pbl, cntl};
                EpiMoe2 E{args->ws + WS_YB};
                pg8::gemm_phase<EpiMoe2, pg8::MoeSched<2>, true, true>(tid, lds, rowtab, DFF / 2, DFF / 2, DFF / 2, S, E); }
                SEAM(base + 7);
            }
        }
    }
    if (IN(PH_FINAL)) { if (EN(14)) phase_final(args, lane, wave); }
#undef IN
#undef SEAM
}

extern "C" void kernel_launch(void* const* d_in, const int* in_sizes, int n_in, void* d_out, int out_size, void* d_ws, size_t ws_size, hipStream_t stream) {
    static int grid = 0;
    if (grid == 0) {
        if (n_in != N_IN || out_size != NB * SEQ * DM || ws_size < WS_END) { fprintf(stderr, "kernel_launch: shape/workspace mismatch: n_in %d out %d ws %zu (need %zu)\n", n_in, out_size, ws_size, (size_t)WS_END); grid = -1; return; }
        int dev = 0, cus = 0, per_cu = 0;
        if (hipGetDevice(&dev) != hipSuccess || hipDeviceGetAttribute(&cus, hipDeviceAttributeMultiprocessorCount, dev) != hipSuccess) { grid = -1; return; }
        if (hipFuncSetAttribute((const void*)mega_fwd, hipFuncAttributeMaxDynamicSharedMemorySize, LDS_BYTES) != hipSuccess) { fprintf(stderr, "kernel_launch: hipFuncSetAttribute failed\n"); grid = -1; return; }
        if (hipOccupancyMaxActiveBlocksPerMultiprocessor(&per_cu, (const void*)mega_fwd, NTHR, LDS_BYTES) != hipSuccess || per_cu < 1) { fprintf(stderr, "kernel_launch: occupancy query reports %d blocks per CU\n", per_cu); }
        (void)hipGetLastError();
        grid = cus;
        if (grid > 256) grid = 256;
    }
    if (grid < 0) return;
    (void)hipMemsetAsync((char*)d_ws + WS_CTL, 0, 65536, stream);
    Args a{};
    for (int i = 0; i < N_IN; ++i) a.in[i] = (const float*)d_in[i];
    a.out = (float*)d_out; a.ws = (unsigned char*)d_ws;
#if MK_SPLIT
    for (int p = 0; p < N_PHASES; ++p) { a.ph_lo = p; a.ph_hi = p + 1; hipLaunchKernelGGL(mega_fwd, dim3(grid), dim3(NTHR), LDS_BYTES, stream, a); }
#else
    a.ph_lo = 0; a.ph_hi = N_PHASES;
    hipLaunchKernelGGL(mega_fwd, dim3(grid), dim3(NTHR), LDS_BYTES, stream, a);
#endif
    const hipError_t le = hipPeekAtLastError();
    if (le != hipSuccess) fprintf(stderr, "kernel_launch: launch failed: %s\n", hipGetErrorName(le));
}
```

```cpp
#include <hip/hip_runtime.h>
#include <cstdio>
#include <cstdint>

#ifndef MK_SPLIT
#define MK_SPLIT 0
#endif
#ifndef MK_LAYERS
#define MK_LAYERS 4
#endif
#ifndef MK_EN
#define MK_EN 0xFFFFF
#endif
#define EN(n) ((MK_EN >> (n)) & 1)
#ifndef MK_REP
#define MK_REP 0
#endif
#ifndef MK_PROBE_NULL
#define MK_PROBE_NULL 0
#endif
#define NREP(n) (1 + ((MK_REP >> (n)) & 1))

#define GAS __attribute__((address_space(1)))
#define LAS __attribute__((address_space(3)))
typedef unsigned short bf16;
typedef float f32x4 __attribute__((ext_vector_type(4)));
typedef float f32x2 __attribute__((ext_vector_type(2)));
typedef float f32x16 __attribute__((ext_vector_type(16)));
typedef float f32x8 __attribute__((ext_vector_type(8)));
typedef short bf16x8 __attribute__((ext_vector_type(8)));
typedef short s16x4 __attribute__((ext_vector_type(4)));
typedef unsigned u32x4 __attribute__((ext_vector_type(4)));
typedef unsigned u32x2 __attribute__((ext_vector_type(2)));
typedef int v8i __attribute__((ext_vector_type(8)));
typedef int v4i __attribute__((ext_vector_type(4)));
constexpr float W8_SCALE = 32.0f;
constexpr float Y8_SCALE = 8.0f;

constexpr int DM = 1024, NB = 8, SEQ = 4096, CTXL = 256, SEG = SEQ + CTXL  , NR = NB * SEG  , NTILE = NR / 256  ;
constexpr int NE = 32, TOPK = 4, DFF = 1024, NMOD = 6 * DM;
constexpr int CAPROWS = NR * TOPK + NE * 256;
constexpr float NORM_EPS = 1e-6f;
constexpr int NWAVES = 8, NTHR = 512;

enum { I_X = 0, I_C, I_CTX, I_CCTX, I_ADAW, I_ADAB, I_N1G, I_N2G, I_POOLW, I_POOLS, I_LAMRE, I_LAMIM, I_LOGDT, I_BRE, I_BIM, I_CRE, I_CIM, I_SSMD, I_GLUW, I_GLUB,
       I_WQKV, I_QG, I_KG, I_WO, I_RW, I_RB, I_W1, I_B1, I_W2, I_B2, N_IN };

constexpr size_t al256(size_t x) { return (x + 255) & ~(size_t)255; }
constexpr size_t WS_CTL = 0, CTL_BYTES = 1u << 20;
constexpr size_t WS_MODS = WS_CTL + CTL_BYTES;
constexpr size_t WS_ROPE = al256(WS_MODS + (size_t)4 * 9 * NMOD * 4);
constexpr size_t WS_S5LAM = al256(WS_ROPE + 64 * 32 * 8);
constexpr size_t WS_S5BF = al256(WS_S5LAM + 2 * 64 * 64 * 8);
constexpr size_t WS_S5CF = al256(WS_S5BF + (size_t)2 * 64 * 4 * 64 * 16);
constexpr size_t WS_RT = al256(WS_S5CF + (size_t)2 * 64 * 4 * 64 * 16);
constexpr size_t WS_POOLW = al256(WS_RT + (size_t)4 * 32 * 1024 * 4);
constexpr size_t WS_GLUW = al256(WS_POOLW + (size_t)2 * 4 * 256 * 256 * 2);
constexpr size_t WS_WQKV = al256(WS_GLUW + (size_t)2048 * 1024 * 2);
constexpr size_t WS_WO = al256(WS_WQKV + (size_t)1536 * 1024 * 2);
constexpr size_t WS_GATE = al256(WS_WO + (size_t)1024 * 1024 * 2);
constexpr size_t WS_LIST = al256(WS_GATE + (size_t)32 * NR * 4);
constexpr size_t WS_XS = al256(WS_LIST + (size_t)32 * NR * 4);
constexpr size_t WS_B1 = al256(WS_XS + (size_t)NR * DM * 4);
constexpr size_t WS_B2 = al256(WS_B1 + (size_t)NR * DM * 2);
constexpr size_t WS_B3 = al256(WS_B2 + (size_t)NR * DM * 2);
constexpr size_t WS_KB = al256(WS_B3 + (size_t)NR * DM * 2);
constexpr size_t WS_VB = al256(WS_KB + (size_t)NR * 256 * 2);
constexpr size_t WS_YG = al256(WS_VB + (size_t)NR * 256 * 2);
constexpr size_t WS_ACT = al256(WS_YG + (size_t)2 * NR * DM * 4);
constexpr size_t WS_YB = al256(WS_ACT + (size_t)CAPROWS * DFF * 2);
constexpr size_t WS_B3F = al256(WS_YB + (size_t)(NR * 4 + 1) * DM * 2);
constexpr size_t WS_W1T = al256(WS_B3F + (size_t)NR * DM);
constexpr size_t WS_W2T = al256(WS_W1T + (size_t)4 * 32 * 2048 * 1024);
constexpr size_t WS_END = al256(WS_W2T + (size_t)4 * 32 * 1024 * 1024);

constexpr int CW_CNT = 64;
constexpr int CW_BAR = 4096;

constexpr int RING_BYTES = 131072;
constexpr int ROWTAB_OFF = RING_BYTES;
constexpr int RSCR_OFF = 132096;
constexpr int LDS_BYTES = 147456;
constexpr int MISC_OFF = LDS_BYTES - 64;
constexpr int RPB_MAX = 280;
constexpr int RPART_OFF = RSCR_OFF + RPB_MAX * 4 * 8 + 3 * 32 * 4 + 64;
static_assert(RPART_OFF + 16 * 64 * 4 <= MISC_OFF, "LDS map");

__device__ __forceinline__ unsigned cvt_pk_bf16(float lo, float hi) { unsigned r; asm volatile("v_cvt_pk_bf16_f32 %0, %1, %2" : "=v"(r) : "v"(lo), "v"(hi)); return r; }
__device__ __forceinline__ unsigned cvt_pk4_fp8(float a, float b, float c, float d) { unsigned w = 0; w = __builtin_amdgcn_cvt_pk_fp8_f32(a, b, w, false); w = __builtin_amdgcn_cvt_pk_fp8_f32(c, d, w, true); return w; }
__device__ __forceinline__ float bf_lo(unsigned w) { return __uint_as_float(w << 16); }
__device__ __forceinline__ float bf_hi(unsigned w) { return __uint_as_float(w & 0xffff0000u); }
__device__ __forceinline__ float wave_sum(float v) {
#pragma unroll
    for (int o = 1; o < 64; o <<= 1) v += __shfl_xor(v, o);
    return v;
}
__device__ __forceinline__ float sigmoidf_(float x) { return 1.0f / (1.0f + __expf(-x)); }
#define LDS_WAIT() asm volatile("s_waitcnt lgkmcnt(0)" ::: "memory")
#define VM_WAIT() asm volatile("s_waitcnt vmcnt(0)" ::: "memory")

#define XB_TMO      128
#define XB_XCNT(j)  (256  + 64 * (j))
#define XB_XSUB(j)  (1280 + 64 * (j))
#define XB_XGEN(j)  (2304 + 64 * (j))
#define XB_TOP      3328
#define XB_TOPGEN   3392
#define XCD_BAR_WORDS 3456
#define XB_SPIN_CAP (1u << 18)
__device__ __forceinline__ unsigned xb_ld(unsigned* p)              { return __hip_atomic_load(p, __ATOMIC_RELAXED, __HIP_MEMORY_SCOPE_AGENT); }
__device__ __forceinline__ unsigned xb_add(unsigned* p, unsigned v) { return __hip_atomic_fetch_add(p, v, __ATOMIC_RELAXED, __HIP_MEMORY_SCOPE_AGENT); }
__device__ __forceinline__ unsigned xb_xcc_id() { return (unsigned)__builtin_amdgcn_s_getreg((3 << 11) | 20) & 0xFu; }
#define XB_SPIN(cond, bar) do { unsigned _sp = 0; while (cond) { __builtin_amdgcn_s_sleep(1); \
    if ((++_sp & 255u) == 0u) { if (xb_ld(&(bar)[XB_TMO])) break; if (_sp > XB_SPIN_CAP) { atomicAdd(&(bar)[XB_TMO], 1u); break; } } } } while (0)
struct XcdBarrier { unsigned* bar; unsigned x; volatile LAS unsigned* st; };
__device__ __forceinline__ XcdBarrier xcd_barrier_post(unsigned* bar, volatile LAS unsigned* st) {
    XcdBarrier b; b.bar = bar; b.x = xb_xcc_id(); b.st = st;
    if (threadIdx.x == 0) (void)xb_add(&bar[XB_XCNT(b.x)], 1u);
    return b;
}
__device__ __forceinline__ void xcd_barrier_complete(unsigned* bar, unsigned x, unsigned& nloc, unsigned& nx) {
    const unsigned G = gridDim.x * gridDim.y * gridDim.z;
    unsigned sum, cnt, mine, sp = 0u;
    for (;;) {
        sum = 0u; cnt = 0u; mine = 0u;
#pragma unroll
        for (unsigned j = 0; j < 16; ++j) { const unsigned c = xb_ld(&bar[XB_XCNT(j)]); sum += c; cnt += (c > 0u) ? 1u : 0u; mine = (j == x) ? c : mine; }
        if (sum == G) break;
        __builtin_amdgcn_s_sleep(1);
        if ((++sp & 255u) == 0u) { if (xb_ld(&bar[XB_TMO])) break; if (sp > XB_SPIN_CAP) { atomicAdd(&bar[XB_TMO], 1u); break; } }
    }
    nloc = mine > 0u ? mine : 1u; nx = cnt > 0u ? cnt : 1u;
}
__device__ __forceinline__ void xcd_barrier_census(const XcdBarrier& b) {
    if (threadIdx.x == 0) { unsigned nloc, nx; xcd_barrier_complete(b.bar, b.x, nloc, nx); b.st[0] = nloc; b.st[1] = nx; }
}
__device__ __forceinline__ void xcd_barrier(const XcdBarrier& b) {
    asm volatile("s_waitcnt vmcnt(0)" ::: "memory");
    __syncthreads();
    if (threadIdx.x == 0) {
        unsigned* bar = b.bar; asm volatile("" : "+s"(bar));
        __builtin_amdgcn_s_waitcnt(0);
        unsigned nloc = b.st[0], nx = b.st[1];
        const unsigned old = xb_add(&bar[XB_XSUB(b.x)], 1u);
        const unsigned gen = old / nloc;
        if (old + 1u == (gen + 1u) * nloc) {
            __builtin_amdgcn_fence(__ATOMIC_RELEASE, "agent");
            asm volatile("s_waitcnt vmcnt(0)" ::: "memory");
            const unsigned og = xb_add(&bar[XB_TOP], 1u);
            const unsigned tg = og / nx;
            if (og + 1u == (tg + 1u) * nx) xb_add(&bar[XB_TOPGEN], 1u);
            else XB_SPIN(xb_ld(&bar[XB_TOPGEN]) == tg, bar);
            __builtin_amdgcn_fence(__ATOMIC_ACQUIRE, "agent");
            xb_add(&bar[XB_XGEN(b.x)], 1u);
            asm volatile("s_waitcnt vmcnt(0)" ::: "memory");
        } else {
            XB_SPIN(xb_ld(&bar[XB_XGEN(b.x)]) == gen, bar);
            __builtin_amdgcn_fence(__ATOMIC_ACQUIRE, "agent");
            asm volatile("s_waitcnt vmcnt(0)" ::: "memory");
        }
    }
    __syncthreads();
}

namespace pg8 {
constexpr int BM = 256, BK = 64, HALF = 128, HTB = HALF * BK * 2, STAGE_BYTES = 8 * HTB, NXCD = 8;
__device__ __forceinline__ int lds_byte(int r, int c) { const int st = (r >> 4) * 2 + (c >> 5), rr = r & 15, cc = c & 31, ob = rr * 64 + cc * 2; return st * 1024 + (ob ^ (((ob >> 9) & 1) << 5)); }
__device__ __forceinline__ void stage_rc(int b, int& R, int& C) { const int st = b / 1024, sb = b % 1024, swz = sb ^ (((sb >> 9) & 1) << 5); R = (st >> 1) * 16 + swz / 64; C = (st & 1) * 32 + (swz % 64) / 2; }
__device__ __forceinline__ int perm32(int rho) { const int n = rho >> 4, i = rho & 15; return 8 * (i >> 2) + 4 * n + (i & 3); }

struct Unit { int pm, pn, e, rb, cnt; };

__device__ __forceinline__ int xcd_remap(int L, int nwg) { const int q = nwg / NXCD, r = nwg % NXCD, xcd = L % NXCD, off = L / NXCD; return (xcd < r ? xcd * (q + 1) : r * (q + 1) + (xcd - r) * q) + off; }

template <class Epi, class Sched, bool GATHER, int FP8 = 0>
__device__ __forceinline__ void gemm_phase(const int tid, LAS unsigned char* lds, LAS int* rowtab, const int lda, const int ldb, const int K, const Sched& S, const Epi& E) {
    const int wid = __builtin_amdgcn_readfirstlane(tid >> 6), lane = tid & 63, wr = wid >> 2, wc = wid & 3, fr = lane & 15, fq = lane >> 4;
    int nt = K / BK;
    if (K <= 2 * BK) asm volatile("" : "+s"(nt));
    int Rr[2], Cc[2];
    constexpr int PM = (int)Epi::PERM;
    unsigned voffB[2][2];
#pragma unroll
    for (int i = 0; i < 2; ++i) { stage_rc(tid * 16 + i * 8192, Rr[i], Cc[i]);
        if constexpr (PM == 2) { const int p = perm32(Rr[i] & 31);
#pragma unroll
            for (int bj = 0; bj < 2; ++bj) voffB[bj][i] = (unsigned)((64 * (Rr[i] >> 5) + 16 * (p >> 3) + 8 * bj + (p & 7)) * ldb + Cc[i]) * 2u; }
        else { const int Rb = PM ? ((Rr[i] & ~31) + perm32(Rr[i] & 31)) : Rr[i]; voffB[0][i] = voffB[1][i] = (unsigned)(Rb * ldb + Cc[i]) * 2u; } }
    const size_t kstep = (size_t)(BK * 2);
    const size_t hstepA = GATHER ? 0 : (size_t)HALF * lda * 2, hstepB = PM == 2 ? 0 : (size_t)HALF * ldb * 2;
    const unsigned ldsw = (unsigned)wid * 1024u;
    const int aoff = lds_byte(wr * 64 + fr, fq * 8), boff = lds_byte(wc * 32 + fr, fq * 8);
#define PG8_SA(b, h) (((b) * 2 + (h)) * HTB)
#define PG8_SB(b, h) ((4 + (b) * 2 + (h)) * HTB)
#define PG8_STAGE(bufoff, gbase, voff) do { _Pragma("unroll") for (int _i = 0; _i < 2; ++_i) \
        __builtin_amdgcn_global_load_lds((const unsigned*)((const char*)(gbase) + (voff)[_i]), (LAS unsigned*)(lds + (bufoff) + ldsw + _i * 8192), 16, 0, 0); } while (0)
#define PG8_LDA(dst, b, h) do { _Pragma("unroll") for (int m = 0; m < 4; ++m) _Pragma("unroll") for (int k = 0; k < 2; ++k) dst[m][k] = *(const LAS bf16x8*)(lds + PG8_SA(b, h) + aoff + m * 2048 + k * 1024); } while (0)
#define PG8_LDB(dst, b, h) do { _Pragma("unroll") for (int n = 0; n < 2; ++n) _Pragma("unroll") for (int k = 0; k < 2; ++k) dst[n][k] = *(const LAS bf16x8*)(lds + PG8_SB(b, h) + boff + n * 2048 + k * 1024); } while (0)
#define PG8_MMA(ai, bj, At, Bt) do { __builtin_amdgcn_s_setprio(1); _Pragma("unroll") for (int m = 0; m < 4; ++m) _Pragma("unroll") for (int n = 0; n < 2; ++n) { \
        if constexpr (FP8) { const v8i bv_ = __builtin_shufflevector(__builtin_bit_cast(v4i, Bt[n][0]), __builtin_bit_cast(v4i, Bt[n][1]), 0, 1, 2, 3, 4, 5, 6, 7); \
                             const v8i av_ = __builtin_shufflevector(__builtin_bit_cast(v4i, At[m][0]), __builtin_bit_cast(v4i, At[m][1]), 0, 1, 2, 3, 4, 5, 6, 7); \
                             if constexpr (FP8 == 2) acc[ai][bj][m][n] = __builtin_amdgcn_mfma_scale_f32_16x16x128_f8f6f4(bv_, av_, acc[ai][bj][m][n], 2, 2, 0, bv_[6], 0, av_[6]); \
                             else acc[ai][bj][m][n] = __builtin_amdgcn_mfma_scale_f32_16x16x128_f8f6f4(bv_, av_, acc[ai][bj][m][n], 0, 0, 0, scale_w, 0, scale_x); } \
        else { _Pragma("unroll") for (int k = 0; k < 2; ++k) acc[ai][bj][m][n] = __builtin_amdgcn_mfma_f32_16x16x32_bf16(Bt[n][k], At[m][k], acc[ai][bj][m][n], 0, 0, 0); } } \
        __builtin_amdgcn_s_setprio(0); } while (0)
#define PG8_WAIT_V(n) asm volatile("s_waitcnt vmcnt(" #n ")" ::: "memory")
#define PG8_WAIT_L(n) asm volatile("s_waitcnt lgkmcnt(" #n ")" ::: "memory")
#define PG8_BAR __builtin_amdgcn_s_barrier()
#define PG8_SCHED __builtin_amdgcn_sched_barrier(0)
    Unit cur, nxt; int ui = 0;
    if (!S.next(0, cur)) return;
    int scale_w = 0x7A7A7A7A, scale_x = 0x7F7F7F7F; asm volatile("" : "+v"(scale_w), "+v"(scale_x));
    unsigned vA[2][2];
    constexpr int NTAB = Sched::NTAB;
    if constexpr (NTAB > 0) {
        if (tid < 256) {
#pragma unroll
            for (int sl = 0; sl < 3; ++sl) if (NTAB & (1 << sl)) rowtab[sl * 256 + tid] = (int)*S.tab_src(cur, sl, tid);
        }
        LDS_WAIT(); __syncthreads();
    }
    if constexpr (GATHER) {
#pragma unroll
        for (int h = 0; h < 2; ++h)
#pragma unroll
            for (int i = 0; i < 2; ++i) vA[h][i] = (unsigned)(S.a_rowidx(cur, rowtab, h * 128 + Rr[i]) * lda + Cc[i]) * 2u;
    } else {
#pragma unroll
        for (int h = 0; h < 2; ++h)
#pragma unroll
            for (int i = 0; i < 2; ++i) vA[h][i] = (unsigned)(Rr[i] * lda + Cc[i]) * 2u;
    }
    bf16x8 At[4][2], B0[2][2], B1[2][2];
    const char* cA = S.a_base(cur); const char* cB = S.b_base(cur);
    PG8_STAGE(PG8_SB(0, 0), cB, voffB[0]); PG8_STAGE(PG8_SB(0, 1), cB + hstepB, voffB[1]); PG8_STAGE(PG8_SA(0, 0), cA, vA[0]); PG8_STAGE(PG8_SA(0, 1), cA + hstepA, vA[1]);
    if (wr == 1) PG8_BAR;
    PG8_WAIT_V(2); PG8_BAR;
    PG8_STAGE(PG8_SB(1, 0), cB + kstep, voffB[0]); PG8_STAGE(PG8_SA(1, 0), cA + kstep, vA[0]); PG8_STAGE(PG8_SB(1, 1), cB + hstepB + kstep, voffB[1]);
    PG8_WAIT_V(6); PG8_BAR;
    for (;;) {
        f32x4 acc[2][2][4][2];
#pragma unroll
        for (int a = 0; a < 2; ++a)
#pragma unroll
            for (int b = 0; b < 2; ++b)
#pragma unroll
                for (int m = 0; m < 4; ++m)
#pragma unroll
                    for (int n = 0; n < 2; ++n) acc[a][b][m][n] = (f32x4){0.f, 0.f, 0.f, 0.f};
        const bool has_next = S.next(ui + 1, nxt);
        const char* nA = has_next ? S.a_base(nxt) : cA; const char* nB = has_next ? S.b_base(nxt) : cB;
        if constexpr (NTAB > 0) {
            if (has_next && tid < 256) {
#pragma unroll
                for (int sl = 0; sl < 3; ++sl) if (NTAB & (1 << sl))
                    __builtin_amdgcn_global_load_lds(S.tab_src(nxt, sl, tid), (LAS unsigned*)((LAS unsigned char*)rowtab + (((ui + 1) % 3) * 3072) + sl * 1024 + wid * 256), 4, 0, 0);
            }
        }
#pragma nounroll
        for (int t = 0; t < nt; t += 2) {
            const bool last = (t == nt - 2);
            if constexpr (PM == 2) asm volatile("" : "+v"(voffB[1][0]), "+v"(voffB[1][1])); else { voffB[1][0] = voffB[0][0]; voffB[1][1] = voffB[0][1]; }
            asm volatile("" : "+v"(vA[0][0]), "+v"(vA[0][1]), "+v"(vA[1][0]), "+v"(vA[1][1]), "+v"(voffB[0][0]), "+v"(voffB[0][1]));
            const char* a1 = cA + (size_t)(t + 1) * kstep;
            const char* a2 = last ? nA : cA + (size_t)(t + 2) * kstep; const char* b2 = last ? nB : cB + (size_t)(t + 2) * kstep;
            const char* a3 = a2 + kstep; const char* b3 = b2 + kstep;
            PG8_LDB(B0, 0, 0); PG8_LDB(B1, 0, 1); PG8_SCHED; PG8_LDA(At, 0, 0); PG8_STAGE(PG8_SA(1, 1), a1 + hstepA, vA[1]);
            if constexpr (GATHER) {
                if (last && has_next) {
                    LAS int* rt = rowtab + ((ui + 1) % 3) * 768;
#pragma unroll
                    for (int h = 0; h < 2; ++h)
#pragma unroll
                        for (int i = 0; i < 2; ++i) vA[h][i] = (unsigned)(S.a_rowidx(nxt, rt, h * 128 + Rr[i]) * lda + Cc[i]) * 2u;
                }
            }
            PG8_WAIT_V(8); PG8_WAIT_L(0); PG8_BAR; PG8_MMA(0, 0, At, B0); PG8_MMA(0, 1, At, B1); PG8_BAR; PG8_SCHED;
            PG8_LDA(At, 0, 1); PG8_STAGE(PG8_SB(0, 0), b2, voffB[0]); PG8_STAGE(PG8_SB(0, 1), b2 + hstepB, voffB[1]); PG8_STAGE(PG8_SA(0, 0), a2, vA[0]);
            PG8_WAIT_V(8); PG8_WAIT_L(0); PG8_BAR; PG8_MMA(1, 0, At, B0); PG8_MMA(1, 1, At, B1); PG8_BAR; PG8_SCHED;
            PG8_LDB(B0, 1, 0); PG8_LDB(B1, 1, 1); PG8_SCHED; PG8_LDA(At, 1, 0); PG8_STAGE(PG8_SA(0, 1), a2 + hstepA, vA[1]);
            PG8_WAIT_V(8); PG8_WAIT_L(0); PG8_BAR; PG8_MMA(0, 0, At, B0); PG8_MMA(0, 1, At, B1); PG8_BAR; PG8_SCHED;
            PG8_LDA(At, 1, 1); PG8_STAGE(PG8_SB(1, 0), b3, voffB[0]); PG8_STAGE(PG8_SB(1, 1), b3 + hstepB, voffB[1]); PG8_STAGE(PG8_SA(1, 0), a3, vA[0]);
            PG8_WAIT_V(8); PG8_WAIT_L(0); PG8_BAR; PG8_MMA(1, 0, At, B0); PG8_MMA(1, 1, At, B1); PG8_BAR; PG8_SCHED;
        }
        if (wr == 0) PG8_BAR;
        { int fr_ = fr, fq_ = fq; asm volatile("" : "+v"(fr_), "+v"(fq_));
          E(acc, cur, wr, wc, fr_, fq_, rowtab + (ui % 3) * 768); }
        if (!has_next) break;
        cur = nxt; cA = nA; cB = nB; ++ui;
        if (wr == 1) PG8_BAR;
    }
    PG8_WAIT_V(0);
    PG8_BAR;
#undef PG8_SA
#undef PG8_SB
#undef PG8_STAGE
#undef PG8_LDA
#undef PG8_LDB
#undef PG8_MMA
#undef PG8_WAIT_V
#undef PG8_WAIT_L
#undef PG8_BAR
#undef PG8_SCHED
}

struct StaticSched {
    const char* A; const char* B; size_t atile, btile; int nM, nN, nwg, G, c;
    size_t acol; int skipctx;
    __device__ __forceinline__ bool next(int i, Unit& u) const {
        const int L = i * G + c; if (L >= nwg) return false;
        const int wgid = xcd_remap(L, nwg);
        constexpr int WGM = 8;
        const int nig = WGM * nN, gid = wgid / nig, fm = gid * WGM, gsz = (nM - fm) < WGM ? (nM - fm) : WGM;
        const int pm0 = fm + ((wgid % nig) % gsz); u.pm = pm0 + skipctx * ((pm0 >> 4) + 1); u.pn = (wgid % nig) / gsz; u.e = 0; u.rb = 0; u.cnt = 0; return true;
    }
    __device__ __forceinline__ const char* a_base(const Unit& u) const { return A + (size_t)u.pm * atile + (size_t)u.pn * acol; }
    __device__ __forceinline__ const char* b_base(const Unit& u) const { return B + (size_t)u.pn * btile; }
    static constexpr int NTAB = 0;
    __device__ __forceinline__ const unsigned* tab_src(const Unit&, int, int) const { return nullptr; }
    __device__ __forceinline__ int a_rowidx(const Unit&, const LAS int*, int) const { return 0; }
};
struct StaticSchedG : StaticSched {
    __device__ __forceinline__ const char* a_base(const Unit& u) const { return A + (size_t)u.pn * acol; }
    __device__ __forceinline__ int a_rowidx(const Unit& u, const LAS int*, int rl) const { return u.pm * 256 + rl; }
};

template <int KIND>
struct MoeSched {
    static constexpr int NTAB = KIND == 1 ? 0x5 : 0x7;
    const char* A; const char* B; size_t atile, btile, bexp; const int* list; const float* glist; const float* bias; int NPN, U, G, c; int pbl, cntl;
    __device__ __forceinline__ bool next(int i, Unit& u) const {
        const int L = i * G + c; if (L >= U) return false;
        const int idx = xcd_remap(L, U);
        const int rbg = idx / NPN; u.pn = idx % NPN; u.pm = rbg;
        const unsigned long long m = __ballot(pbl <= rbg);
        const int e = __builtin_popcount((unsigned)(m & 0xffffffffull)) - 1;
        u.e = e; u.rb = rbg - __builtin_amdgcn_readlane(pbl, e); u.cnt = __builtin_amdgcn_readlane(cntl, e); return true;
    }
    __device__ __forceinline__ const char* a_base(const Unit& u) const { return A; }
    __device__ __forceinline__ int a_rowidx(const Unit& u, const LAS int* tab, int rl) const { return KIND == 1 ? (tab[rl] >> 2) : u.pm * 256 + rl; }
    __device__ __forceinline__ const char* b_base(const Unit& u) const { return B + (size_t)u.e * bexp + (size_t)u.pn * btile; }
    __device__ __forceinline__ const unsigned* tab_src(const Unit& u, int sl, int t) const {
        if (sl == 2) { const int col = KIND == 1 ? ((t >> 7) * DFF + u.pn * 128 + (t & 127)) : (u.pn * 256 + t); return (const unsigned*)(bias + (size_t)u.e * (KIND == 1 ? 2 * DFF : DM) + col); }
        int idx = u.rb * 256 + t; idx = idx < u.cnt ? idx : u.cnt - 1;
        return (sl == 0 ? (const unsigned*)list : (const unsigned*)glist) + (size_t)u.e * NR + idx;
    }
};
}

namespace att {
constexpr int D = 128, NW = 8, QBLK = 32, KVBLK = 64;
constexpr float SCALE = 0.088388347648318440f;
constexpr float THR = 8.f;
constexpr int LDQ = 1024, LDK = 256, LDO = 1024;
constexpr int V8T_TILE_ = 128 * 64;
#ifndef ATT_NS
#define ATT_NS 6
#endif
constexpr int NS = ATT_NS, SLOT = 16384;
#ifndef ATT_SDEPTH
#define ATT_SDEPTH 1
#endif
constexpr int SDEPTH = ATT_SDEPTH;
constexpr size_t SHM_V = KVBLK * D * 2, SHM_K = KVBLK * D * 2, SHM_ATTN = 2 * SHM_V + 2 * SHM_K + NW * 64 * 4;
#define KSWZ(row, colB) ((row) * 256 + ((colB) ^ (((row) & 7) << 4)))
#define SBAR() __builtin_amdgcn_sched_barrier(0)
__device__ __forceinline__ int crow(int r, int hi) { return (r & 3) + 8 * (r >> 2) + 4 * hi; }
__device__ __forceinline__ unsigned cvtpk(float lo, float hi) { unsigned r; asm volatile("v_cvt_pk_bf16_f32 %0, %1, %2" : "=v"(r) : "v"(lo), "v"(hi)); return r; }
__device__ __forceinline__ bf16x8 ld8(const bf16* p) { return *reinterpret_cast<const bf16x8*>(p); }
__device__ __forceinline__ void partialSM(f32x16& p0, f32x16& p1, float& m_reg, float& mn, float& alpha) {
  constexpr float C = SCALE * 1.4426950408889634f;
  float pmax = p0[0]; for (int r = 1; r < 16; ++r) pmax = fmaxf(pmax, p0[r]); for (int r = 0; r < 16; ++r) pmax = fmaxf(pmax, p1[r]);
  { auto rr = __builtin_amdgcn_permlane32_swap(__float_as_uint(pmax), __float_as_uint(pmax), false, false);
    pmax = fmaxf(__uint_as_float(rr[0]), __uint_as_float(rr[1])); }
  if (__builtin_expect(__all(pmax - m_reg <= THR / SCALE), 1)) { mn = m_reg; alpha = 1.f; }
  else { mn = fmaxf(m_reg, pmax); alpha = __builtin_amdgcn_exp2f((m_reg - mn) * C); m_reg = mn; }
  float mnC = -mn * C;
  for (int r = 0; r < 16; ++r) p0[r] = fmaf(p0[r], C, mnC); for (int r = 0; r < 16; ++r) p1[r] = fmaf(p1[r], C, mnC);
  for (int r = 0; r < 16; ++r) p0[r] = __builtin_amdgcn_exp2f(p0[r]);
}
__device__ __forceinline__ void partialSMb(f32x16& p0, f32x16& p1) {
  for (int r = 0; r < 16; ++r) p0[r] = __builtin_amdgcn_exp2f(p0[r]);
}
__device__ __forceinline__ void finishSMb(f32x16& p0, f32x16& p1, float& l_part, bf16x8& pa0, bf16x8& pa1, bf16x8& pa2, bf16x8& pa3) {
  for (int r = 0; r < 16; ++r) p1[r] = __builtin_amdgcn_exp2f(p1[r]);
  float ps = 0; for (int r = 0; r < 16; ++r) ps += p0[r]; for (int r = 0; r < 16; ++r) ps += p1[r];
  l_part += ps;
#define PK4(P, BASE, OUT) do { unsigned a0 = cvtpk(P[BASE + 0], P[BASE + 1]), a1 = cvtpk(P[BASE + 2], P[BASE + 3]);   \
    unsigned b0 = cvtpk(P[BASE + 4], P[BASE + 5]), b1 = cvtpk(P[BASE + 6], P[BASE + 7]);                              \
    auto r0 = __builtin_amdgcn_permlane32_swap(a0, b0, false, false); auto r1 = __builtin_amdgcn_permlane32_swap(a1, b1, false, false); \
    u32x4 w = {r0[0], r1[0], r0[1], r1[1]}; OUT = *reinterpret_cast<bf16x8*>(&w); } while (0)
  PK4(p0, 0, pa0); PK4(p0, 8, pa1); PK4(p1, 0, pa2); PK4(p1, 8, pa3);
#undef PK4
}
typedef short v2s16 __attribute__((ext_vector_type(2)));
__device__ __forceinline__ int cvt_pk4_fp8_sc(float a, float b, float c, float d, float sc) {
  v2s16 w = {0, 0};
  w = __builtin_amdgcn_cvt_scalef32_pk_fp8_f32(w, a, b, sc, false);
  w = __builtin_amdgcn_cvt_scalef32_pk_fp8_f32(w, c, d, sc, true);
  return __builtin_bit_cast(int, w);
}
__device__ __forceinline__ void exp32(f32x16& p0, f32x16& p1) {
  for (int r = 0; r < 16; ++r) p0[r] = __builtin_amdgcn_exp2f(p0[r]);
  for (int r = 0; r < 16; ++r) p1[r] = __builtin_amdgcn_exp2f(p1[r]);
}
__device__ __forceinline__ void finishSM8(const f32x16& p0, const f32x16& p1, float& l_part, v8i& pf, int& E) {
  float ps = 0; for (int r = 0; r < 16; ++r) ps += p0[r]; for (int r = 0; r < 16; ++r) ps += p1[r];
  l_part += ps;
  float pm = fmaxf(p0[0], p1[0]);
  for (int r = 1; r < 16; ++r) pm = fmaxf(fmaxf(pm, p0[r]), p1[r]);
  int e = (int)(__float_as_uint(pm) >> 23) - 7; e = e < 1 ? 1 : e;
  E = e;
  const float sc = __uint_as_float((unsigned)e << 23);
  pf = (v8i){cvt_pk4_fp8_sc(p0[0], p0[1], p0[2], p0[3], sc), cvt_pk4_fp8_sc(p0[4], p0[5], p0[6], p0[7], sc), cvt_pk4_fp8_sc(p0[8], p0[9], p0[10], p0[11], sc), cvt_pk4_fp8_sc(p0[12], p0[13], p0[14], p0[15], sc),
             cvt_pk4_fp8_sc(p1[0], p1[1], p1[2], p1[3], sc), cvt_pk4_fp8_sc(p1[4], p1[5], p1[6], p1[7], sc), cvt_pk4_fp8_sc(p1[8], p1[9], p1[10], p1[11], sc), cvt_pk4_fp8_sc(p1[12], p1[13], p1[14], p1[15], sc)};
}
__device__ __forceinline__ void pv8(f32x16* o, const char* Vs, v8i pf, int E, int r32, int hi) {
  int s1 = 0x7F7F7F7F; asm volatile("" : "+v"(s1));
  const int f = (r32 >> 2) & 3;
  const char* vrow = Vs + r32 * 64;
#pragma unroll
  for (int d0 = 0; d0 < 4; ++d0) {
    const v4i v0 = *reinterpret_cast<const v4i*>(vrow + d0 * 2048 + (((2 * hi) ^ f) << 4)), v1 = *reinterpret_cast<const v4i*>(vrow + d0 * 2048 + (((2 * hi + 1) ^ f) << 4));
    o[d0] = __builtin_amdgcn_mfma_scale_f32_32x32x64_f8f6f4(pf, __builtin_shufflevector(v0, v1, 0, 1, 2, 3, 4, 5, 6, 7), o[d0], 0, 0, 0, E, 0, s1);
  }
}
__device__ __forceinline__ void finishSM(f32x16& p0, f32x16& p1, float alpha, float& l_reg, bf16x8& pa0, bf16x8& pa1, bf16x8& pa2, bf16x8& pa3) {
  for (int r = 0; r < 16; ++r) p1[r] = __builtin_amdgcn_exp2f(p1[r]);
  float ps = 0; for (int r = 0; r < 16; ++r) ps += p0[r]; for (int r = 0; r < 16; ++r) ps += p1[r];
  { auto rr = __builtin_amdgcn_permlane32_swap(__float_as_uint(ps), __float_as_uint(ps), false, false);
    ps = __uint_as_float(rr[0]) + __uint_as_float(rr[1]); }
  l_reg = l_reg * alpha + ps;
#define PK4(P, BASE, OUT) do { unsigned a0 = cvtpk(P[BASE + 0], P[BASE + 1]), a1 = cvtpk(P[BASE + 2], P[BASE + 3]);   \
    unsigned b0 = cvtpk(P[BASE + 4], P[BASE + 5]), b1 = cvtpk(P[BASE + 6], P[BASE + 7]);                              \
    auto r0 = __builtin_amdgcn_permlane32_swap(a0, b0, false, false); auto r1 = __builtin_amdgcn_permlane32_swap(a1, b1, false, false); \
    u32x4 w = {r0[0], r1[0], r0[1], r1[1]}; OUT = *reinterpret_cast<bf16x8*>(&w); } while (0)
  PK4(p0, 0, pa0); PK4(p0, 8, pa1); PK4(p1, 0, pa2); PK4(p1, 8, pa3);
#undef PK4
}
__device__ __forceinline__ void qkt(f32x16& p0, f32x16& p1, const char* Ks, const v8i* qf, int r32, int hi) {
  int sc = 0x7F7F7F7F; asm volatile("" : "+v"(sc));
  p0 = f32x16{}; p1 = f32x16{};
#pragma unroll
  for (int st = 0; st < 2; ++st) {
    const int ua = 4 * hi + 2 * st, f0 = (r32 >> 1) & 7;
    const v4i a0 = *reinterpret_cast<const v4i*>(Ks + r32 * 128 + ((ua ^ f0) << 4)), a1 = *reinterpret_cast<const v4i*>(Ks + r32 * 128 + (((ua + 1) ^ f0) << 4));
    const v4i b0 = *reinterpret_cast<const v4i*>(Ks + (32 + r32) * 128 + ((ua ^ f0) << 4)), b1 = *reinterpret_cast<const v4i*>(Ks + (32 + r32) * 128 + (((ua + 1) ^ f0) << 4));
    p0 = __builtin_amdgcn_mfma_scale_f32_32x32x64_f8f6f4(__builtin_shufflevector(a0, a1, 0, 1, 2, 3, 4, 5, 6, 7), qf[st], p0, 0, 0, 0, sc, 0, sc);
    p1 = __builtin_amdgcn_mfma_scale_f32_32x32x64_f8f6f4(__builtin_shufflevector(b0, b1, 0, 1, 2, 3, 4, 5, 6, 7), qf[st], p1, 0, 0, 0, sc, 0, sc);
  }
}
__device__ __forceinline__ int v_st(int k, int c) { const int kk = (k & ~0xC) | ((k & 4) << 1) | ((k & 8) >> 1); return ((kk >> 3) * 4 + (c >> 5)) * 512 + ((kk & 7) * 32 + (c & 31)) * 2; }
__device__ __forceinline__ int v_rd_base(int lane) { return ((lane & 3) << 3) | (((lane >> 2) & 3) << 6) | (((lane >> 4) & 1) << 5) | (((lane >> 5) & 1) << 8); }
constexpr int v_rd_off(int d0, int ks, int half) { return d0 * 512 + ks * 4096 + half * 2048; }
template <int OFF> __device__ __forceinline__ s16x4 tr_read(int vb) {
  s16x4 r; asm volatile("ds_read_b64_tr_b16 %0, %1 offset:%2" : "=&v"(r) : "v"(vb), "i"(OFF) : "memory"); return r;
}
template <int D0> __device__ __forceinline__ void pv_one(f32x16& od, int vb, bf16x8 pa0, bf16x8 pa1, bf16x8 pa2, bf16x8 pa3) {
  const s16x4 l0 = tr_read<v_rd_off(D0, 0, 0)>(vb), h0 = tr_read<v_rd_off(D0, 0, 1)>(vb), l1 = tr_read<v_rd_off(D0, 1, 0)>(vb), h1 = tr_read<v_rd_off(D0, 1, 1)>(vb);
  const s16x4 l2 = tr_read<v_rd_off(D0, 2, 0)>(vb), h2 = tr_read<v_rd_off(D0, 2, 1)>(vb), l3 = tr_read<v_rd_off(D0, 3, 0)>(vb), h3 = tr_read<v_rd_off(D0, 3, 1)>(vb);
  asm volatile("s_waitcnt lgkmcnt(0)" ::: "memory"); SBAR();
#define PK(L, H) (bf16x8){L[0], L[1], L[2], L[3], H[0], H[1], H[2], H[3]}
  od = __builtin_amdgcn_mfma_f32_32x32x16_bf16(pa0, PK(l0, h0), od, 0, 0, 0);
  od = __builtin_amdgcn_mfma_f32_32x32x16_bf16(pa1, PK(l1, h1), od, 0, 0, 0);
  od = __builtin_amdgcn_mfma_f32_32x32x16_bf16(pa2, PK(l2, h2), od, 0, 0, 0);
  od = __builtin_amdgcn_mfma_f32_32x32x16_bf16(pa3, PK(l3, h3), od, 0, 0, 0);
#undef PK
}
__device__ __forceinline__ void pv_d0(f32x16* o, int vb, bf16x8 pa0, bf16x8 pa1, bf16x8 pa2, bf16x8 pa3) {
  pv_one<0>(o[0], vb, pa0, pa1, pa2, pa3); pv_one<1>(o[1], vb, pa0, pa1, pa2, pa3); pv_one<2>(o[2], vb, pa0, pa1, pa2, pa3); pv_one<3>(o[3], vb, pa0, pa1, pa2, pa3);
}
#define MFMA8(A, B, C, SA, SB) __builtin_amdgcn_mfma_scale_f32_32x32x64_f8f6f4(A, B, C, 0, 0, 0, SA, 0, SB)
#define CAT8(x, y) __builtin_shufflevector(x, y, 0, 1, 2, 3, 4, 5, 6, 7)
template <bool QK, bool PV>
__device__ __forceinline__ void att_step(f32x16& c0, f32x16& c1, const f32x16& q0, const f32x16& q1, f32x16* o, const v8i* qf, const char* Ks, const char* Vs, int r32, int hi, float& l_part) {
  int one = 0x7F7F7F7F; asm volatile("" : "+v"(one));
  const int f0 = (r32 >> 1) & 7, f = (r32 >> 2) & 3;
  const char* kr = Ks + r32 * 128; const char* vr = Vs + r32 * 64;
  v4i ka[4], kb[4];
  if (QK) {
#pragma unroll
    for (int u = 0; u < 4; ++u) { ka[u] = *reinterpret_cast<const v4i*>(kr + (((4 * hi + u) ^ f0) << 4)); kb[u] = *reinterpret_cast<const v4i*>(kr + 4096 + (((4 * hi + u) ^ f0) << 4)); }
  }
  SBAR();
  float ps = 0.f, pm = 0.f; v8i pf; int E = 0; float scf = 0.f;
  if (QK) { c0 = MFMA8(CAT8(ka[0], ka[1]), qf[0], f32x16{}, one, one); SBAR(); }
  if (PV) {
#pragma unroll
    for (int r = 0; r < 16; ++r) ps += q0[r];
    pm = fmaxf(q0[0], q0[1]);
#pragma unroll
    for (int r = 2; r < 16; r += 2) pm = fmaxf(fmaxf(pm, q0[r]), q0[r + 1]);
    SBAR();
  }
  if (QK) { c1 = MFMA8(CAT8(kb[0], kb[1]), qf[0], f32x16{}, one, one); SBAR(); }
  if (PV) {
#pragma unroll
    for (int r = 0; r < 16; ++r) ps += q1[r];
#pragma unroll
    for (int r = 0; r < 16; r += 2) pm = fmaxf(fmaxf(pm, q1[r]), q1[r + 1]);
    l_part += ps;
    int e = (int)(__float_as_uint(pm) >> 23) - 7; e = e < 1 ? 1 : e;
    E = e; scf = __uint_as_float((unsigned)e << 23);
    SBAR();
  }
  if (QK) { c0 = MFMA8(CAT8(ka[2], ka[3]), qf[1], c0, one, one); SBAR(); }
  v4i va[4], vb[4];
  if (PV) {
#pragma unroll
    for (int d0 = 0; d0 < 4; ++d0) { va[d0] = *reinterpret_cast<const v4i*>(vr + d0 * 2048 + (((2 * hi) ^ f) << 4)); vb[d0] = *reinterpret_cast<const v4i*>(vr + d0 * 2048 + (((2 * hi + 1) ^ f) << 4)); }
    pf[0] = cvt_pk4_fp8_sc(q0[0], q0[1], q0[2], q0[3], scf); pf[1] = cvt_pk4_fp8_sc(q0[4], q0[5], q0[6], q0[7], scf);
    pf[2] = cvt_pk4_fp8_sc(q0[8], q0[9], q0[10], q0[11], scf); pf[3] = cvt_pk4_fp8_sc(q0[12], q0[13], q0[14], q0[15], scf);
    SBAR();
  }
  if (QK) { c1 = MFMA8(CAT8(kb[2], kb[3]), qf[1], c1, one, one); SBAR(); }
  if (PV) {
    pf[4] = cvt_pk4_fp8_sc(q1[0], q1[1], q1[2], q1[3], scf); pf[5] = cvt_pk4_fp8_sc(q1[4], q1[5], q1[6], q1[7], scf);
    pf[6] = cvt_pk4_fp8_sc(q1[8], q1[9], q1[10], q1[11], scf); pf[7] = cvt_pk4_fp8_sc(q1[12], q1[13], q1[14], q1[15], scf);
    SBAR();
    o[0] = MFMA8(pf, CAT8(va[0], vb[0]), o[0], E, one); SBAR();
  }
  if (QK) {
#pragma unroll
    for (int r = 0; r < 8; ++r) c0[r] = __builtin_amdgcn_exp2f(c0[r]);
    SBAR();
  }
  if (PV) { o[1] = MFMA8(pf, CAT8(va[1], vb[1]), o[1], E, one); SBAR(); }
  if (QK) {
#pragma unroll
    for (int r = 8; r < 16; ++r) c0[r] = __builtin_amdgcn_exp2f(c0[r]);
    SBAR();
  }
  if (PV) { o[2] = MFMA8(pf, CAT8(va[2], vb[2]), o[2], E, one); SBAR(); }
  if (QK) {
#pragma unroll
    for (int r = 0; r < 8; ++r) c1[r] = __builtin_amdgcn_exp2f(c1[r]);
    SBAR();
  }
  if (PV) { o[3] = MFMA8(pf, CAT8(va[3], vb[3]), o[3], E, one); SBAR(); }
  if (QK) {
#pragma unroll
    for (int r = 8; r < 16; ++r) c1[r] = __builtin_amdgcn_exp2f(c1[r]);
    SBAR();
  }
}
constexpr size_t SHM_RING = (size_t)NS * SLOT, SHM_ATTN3 = SHM_RING + NW * 64 * 4;
__device__ __forceinline__ void attn_dense_body(const int tid, const bf16* __restrict__ Qb, const unsigned char* __restrict__ Kh, const unsigned char* __restrict__ Vh, unsigned char* __restrict__ Ob, int seq, char* lds,
                                                const float* __restrict__ q_g, const f32x2* __restrict__ rope, int t0, float mnC) {
  const int wid = __builtin_amdgcn_readfirstlane(tid >> 6), lane = tid & 63, r32 = lane & 31, hi = lane >> 5;
  float* ws = (float*)(lds + SHM_RING) + wid * 64; float* li_l = ws; float* al_l = ws + 32;
  float l_reg = 0; bf16x8 qr[8]; v8i qf[2];
  const bf16* Qw = Qb + (long)(wid * QBLK + r32) * LDQ + hi * 8;
#pragma unroll
  for (int d0 = 0; d0 < 8; ++d0) qr[d0] = ld8(Qw + d0 * 16);
  unsigned koff, voff;
  { int l_ = lane; asm volatile("" : "+v"(l_)); const int pk_ = wid * 64 + l_, key_ = pk_ >> 3;
    koff = (unsigned)(key_ * 256 + (((pk_ & 7) ^ ((key_ >> 1) & 7)) << 4)); voff = (unsigned)(wid * 1024 + l_ * 16); }
#define DMA_TILE(tile, slot) do { const int tl_ = (tile); \
    __builtin_amdgcn_global_load_lds((const unsigned*)(Kh + (size_t)tl_ * (64 * 256) + koff), (LAS unsigned*)(uintptr_t)(unsigned)((uintptr_t)lds + (slot) * SLOT + wid * 1024), 16, 0, 0); \
    __builtin_amdgcn_global_load_lds((const unsigned*)(Vh + (size_t)tl_ * 8192 + voff), (LAS unsigned*)(uintptr_t)(unsigned)((uintptr_t)lds + (slot) * SLOT + 8192 + wid * 1024), 16, 0, 0); } while (0)
#pragma unroll
  for (int i = 0; i < NS - 2; ++i) DMA_TILE(i, i);
  {
    float ss = 0.f;
#pragma unroll
    for (int d0 = 0; d0 < 8; ++d0)
#pragma unroll
      for (int j = 0; j < 8; ++j) { const float xv = __uint_as_float((unsigned)(unsigned short)qr[d0][j] << 16); ss += xv * xv; }
    ss += __shfl_xor(ss, 32);
    const float inv = rsqrtf(ss * (1.f / 128.f) + 1e-6f) * (SCALE * 1.4426950408889634f);
    const int t = t0 + wid * QBLK + r32;
#pragma unroll
    for (int ax = 0; ax < 2; ++ax) {
      float x[4][8];
#pragma unroll
      for (int dd = 0; dd < 4; ++dd) {
        const int d0 = ax * 4 + dd;
        const f32x4 g0 = *(const f32x4*)(q_g + d0 * 16 + hi * 8), g1 = *(const f32x4*)(q_g + d0 * 16 + hi * 8 + 4);
#pragma unroll
        for (int j = 0; j < 4; ++j) { x[dd][j] = __uint_as_float((unsigned)(unsigned short)qr[d0][j] << 16) * inv * g0[j]; x[dd][4 + j] = __uint_as_float((unsigned)(unsigned short)qr[d0][4 + j] << 16) * inv * g1[j]; }
      }
      if (t0 >= 0) {
        const int pos = ax == 0 ? (t >> 6) : (t & 63);
#pragma unroll
        for (int dd = 0; dd < 2; ++dd)
#pragma unroll
          for (int j = 0; j < 8; j += 2) {
            const f32x4 cs = *(const f32x4*)(rope + pos * 32 + dd * 16 + hi * 8 + j);
            const float a0 = x[dd][j], b0 = x[dd + 2][j], a1 = x[dd][j + 1], b1 = x[dd + 2][j + 1];
            x[dd][j] = a0 * cs.x - b0 * cs.y; x[dd + 2][j] = b0 * cs.x + a0 * cs.y; x[dd][j + 1] = a1 * cs.z - b1 * cs.w; x[dd + 2][j + 1] = b1 * cs.z + a1 * cs.w;
          }
      }
      qf[ax] = (v8i){(int)cvt_pk4_fp8(x[0][0], x[0][1], x[0][2], x[0][3]), (int)cvt_pk4_fp8(x[0][4], x[0][5], x[0][6], x[0][7]), (int)cvt_pk4_fp8(x[1][0], x[1][1], x[1][2], x[1][3]), (int)cvt_pk4_fp8(x[1][4], x[1][5], x[1][6], x[1][7]),
                     (int)cvt_pk4_fp8(x[2][0], x[2][1], x[2][2], x[2][3]), (int)cvt_pk4_fp8(x[2][4], x[2][5], x[2][6], x[2][7]), (int)cvt_pk4_fp8(x[3][0], x[3][1], x[3][2], x[3][3]), (int)cvt_pk4_fp8(x[3][4], x[3][5], x[3][6], x[3][7])};
    }
  }
  f32x16 pA0, pA1, pB0, pB1; const int NT = seq / KVBLK;
  int sc = 0, sp = NS - 1, sd = NS - 2;
#define STEP_HEAD(t_) do { asm volatile("s_waitcnt vmcnt(%0)\n\ts_barrier" :: "n"(2 * (NS - 3)) : "memory"); \
    { int tn_ = (t_) + NS - 2; tn_ = tn_ < NT ? tn_ : NT - 1; DMA_TILE(tn_, sd); } SBAR(); } while (0)
#define STEP_TAIL() do { sd = sp; sp = sc; sc = sc == NS - 1 ? 0 : sc + 1; } while (0)
#define PIN2(a, b) asm volatile("" : "+v"(a), "+v"(b))
#define STEP(PC0, PC1, PP0, PP1, t_) do { STEP_HEAD(t_); \
    att_step<true, true>(PC0, PC1, PP0, PP1, o, qf, lds + sc * SLOT, lds + sp * SLOT + 8192, r32, hi, l_reg); \
    PIN2(PC0, PC1); PIN2(o[0], o[1]); PIN2(o[2], o[3]); \
    STEP_TAIL(); } while (0)
  f32x16 o[4];
  STEP_HEAD(0);
  att_step<true, false>(pA0, pA1, pB0, pB1, o, qf, lds + sc * SLOT, lds, r32, hi, l_reg); PIN2(pA0, pA1);
  STEP_TAIL();
#pragma unroll
  for (int d = 0; d < 4; ++d) o[d] = f32x16{};
  for (int t = 1; t + 1 < NT; t += 2) {
    STEP(pB0, pB1, pA0, pA1, t);
    STEP(pA0, pA1, pB0, pB1, t + 1);
  }
  STEP(pB0, pB1, pA0, pA1, NT - 1);
  att_step<false, true>(pA0, pA1, pB0, pB1, o, qf, lds, lds + sp * SLOT + 8192, r32, hi, l_reg);
  asm volatile("s_waitcnt vmcnt(0)" ::: "memory");
  l_reg += __shfl_xor(l_reg, 32);
  if (hi == 0) li_l[r32] = l_reg; asm volatile("s_waitcnt lgkmcnt(0)" ::: "memory");
  float rli[16];
#pragma unroll
  for (int r = 0; r < 16; ++r) rli[r] = __builtin_amdgcn_rcpf(li_l[crow(r, hi)]);
  asm volatile("s_waitcnt lgkmcnt(0)\n\ts_barrier" ::: "memory");
  {
    int l2 = lane; asm volatile("" : "+v"(l2));
    char* stg = lds + 4 * SLOT + wid * 4096;
    char* sp_ = stg + (4 * (l2 >> 5)) * 128 + (l2 & 31);
#pragma unroll
    for (int r = 0; r < 16; r += 2) {
#pragma unroll
      for (int d0 = 0; d0 < 4; ++d0) {
        const int w = __builtin_amdgcn_cvt_pk_fp8_f32(o[d0][r] * rli[r], o[d0][r + 1] * rli[r + 1], 0, false);
        *(unsigned char*)(sp_ + crow(r, 0) * 128 + d0 * 32) = (unsigned char)w;
        *(unsigned char*)(sp_ + crow(r + 1, 0) * 128 + d0 * 32) = (unsigned char)(w >> 8);
      }
    }
    asm volatile("s_waitcnt lgkmcnt(0)" ::: "memory");
    unsigned char* Ow = Ob + (size_t)(wid * QBLK) * 1024;
#pragma unroll
    for (int i = 0; i < 4; ++i) {
      const int rowl = (l2 >> 3) + 8 * i;
      const u32x4 v = *reinterpret_cast<const u32x4*>(stg + rowl * 128 + (l2 & 7) * 16);
      *reinterpret_cast<u32x4*>(Ow + (size_t)rowl * 1024 + (l2 & 7) * 16) = v;
    }
    asm volatile("s_waitcnt lgkmcnt(0)" ::: "memory");
  }
#undef DMA_TILE
#undef STEP
#undef STEP_HEAD
#undef STEP_TAIL
#undef PIN2
}
}

struct Args { const float* in[N_IN]; float* out; unsigned char* ws; int ph_lo, ph_hi; };
typedef const Args __attribute__((address_space(4)))* KArgs;

__device__ __forceinline__ const float* mods_ptr(KArgs a, int layer, int mrow) { return (const float*)(a->ws + WS_MODS) + ((size_t)layer * 9 + mrow) * NMOD; }
__device__ __forceinline__ int mrow_of(int row) { const int b = row / SEG, s = row - b * SEG; return s < CTXL ? 8 : b; }


#ifndef MOE1_FMT
#define MOE1_FMT 2
#endif
typedef __bf16 v32bf16 __attribute__((ext_vector_type(32)));
typedef unsigned v6u32 __attribute__((ext_vector_type(6)));
typedef unsigned v16u32 __attribute__((ext_vector_type(16)));
__device__ __forceinline__ void fp6_chunk_store(const v16u32 x, unsigned char* rowp, int c) {
    float m = 0.f;
#pragma unroll
    for (int i = 0; i < 16; ++i) m = fmaxf(fmaxf(m, fabsf(__uint_as_float(x[i] << 16))), fabsf(__uint_as_float(x[i] & 0xffff0000u)));
    int E = (int)(__float_as_uint(m * 1.0666667f) >> 23) - 2; E = E < 1 ? 1 : E;
    const v6u32 r = __builtin_amdgcn_cvt_scalef32_pk32_fp6_bf16(__builtin_bit_cast(v32bf16, x), __uint_as_float((unsigned)E << 23));
    unsigned char* o = rowp + (c >> 2) * 128 + (c & 3) * 16;
    *(GAS u32x4*)o = (u32x4){r[0], r[1], r[2], r[3]};
    *(GAS u32x4*)(o + 64) = (u32x4){r[4], r[5], (unsigned)E, 0u};
}
__device__ __forceinline__ void tr_item(const float* __restrict__ W, int ldw, bf16* __restrict__ WT, int ldt, int k0, int n0, int drow0, LAS unsigned char* scr, int lane) {
    const int n4 = lane & 15, kg = lane >> 4;
    f32x4 v[4][4];
#pragma unroll
    for (int i = 0; i < 4; ++i)
#pragma unroll
        for (int kk = 0; kk < 4; ++kk) v[i][kk] = __builtin_nontemporal_load((const GAS f32x4*)(W + (size_t)(k0 + 4 * (kg + 4 * i) + kk) * ldw + n0 + 4 * n4));
#pragma unroll
    for (int i = 0; i < 4; ++i)
#pragma unroll
        for (int j = 0; j < 4; ++j) {
            u32x2 w; w.x = cvt_pk_bf16(v[i][0][j], v[i][1][j]); w.y = cvt_pk_bf16(v[i][2][j], v[i][3][j]);
            *(LAS u32x2*)(scr + ((4 * n4 + j) * 17 + (kg + 4 * i)) * 8) = w;
        }
    LDS_WAIT(); asm volatile("" ::: "memory");
#pragma unroll
    for (int q = 0; q < 16; ++q) {
        const int n = (lane >> 4) + 4 * q;
        const u32x2 w = *(const LAS u32x2*)(scr + (n * 17 + (lane & 15)) * 8);
        __builtin_nontemporal_store(w, (GAS u32x2*)(WT + (size_t)(drow0 + n) * ldt + k0 + 4 * (lane & 15)));
    }
    LDS_WAIT(); asm volatile("" ::: "memory");
}
__device__ __forceinline__ void tr_item8(const float* __restrict__ W, int ldw, unsigned char* __restrict__ WT, int ldt, int k0, int n0, int drow0, LAS unsigned char* scr, int lane, float scale) {
    const int n4 = lane & 15, kg = lane >> 4;
#pragma unroll
    for (int hf = 0; hf < 2; ++hf) {
        f32x4 v[4][4];
#pragma unroll
        for (int i = 0; i < 4; ++i)
#pragma unroll
            for (int kk = 0; kk < 4; ++kk) v[i][kk] = __builtin_nontemporal_load((const GAS f32x4*)(W + (size_t)(k0 + 64 * hf + 4 * (kg + 4 * i) + kk) * ldw + n0 + 4 * n4));
#pragma unroll
        for (int i = 0; i < 4; ++i)
#pragma unroll
            for (int j = 0; j < 4; ++j)
                *(LAS unsigned*)(scr + (4 * n4 + j) * 136 + 64 * hf + 4 * (kg + 4 * i)) = cvt_pk4_fp8(v[i][0][j] * scale, v[i][1][j] * scale, v[i][2][j] * scale, v[i][3][j] * scale);
    }
    LDS_WAIT(); asm volatile("" ::: "memory");
#pragma unroll
    for (int q = 0; q < 16; ++q) {
        const int n = (lane >> 4) + 4 * q;
        const u32x2 w = *(const LAS u32x2*)(scr + n * 136 + 8 * (lane & 15));
        __builtin_nontemporal_store(w, (GAS u32x2*)(WT + (size_t)(drow0 + n) * ldt + k0 + 8 * (lane & 15)));
    }
    LDS_WAIT(); asm volatile("" ::: "memory");
}
__device__ __forceinline__ void tr_item6(const float* __restrict__ W, int ldw, unsigned char* __restrict__ WT, int k0, int n0, int drow0, LAS unsigned char* scr, int lane) {
    const int n4 = lane & 15, kg = lane >> 4;
    v6u32 rr[4]; unsigned ee[4];
#pragma unroll
    for (int hf = 0; hf < 2; ++hf) {
        f32x4 v[4][4];
#pragma unroll
        for (int i = 0; i < 4; ++i)
#pragma unroll
            for (int kk = 0; kk < 4; ++kk) v[i][kk] = __builtin_nontemporal_load((const GAS f32x4*)(W + (size_t)(k0 + 64 * hf + 4 * (kg + 4 * i) + kk) * ldw + n0 + 4 * n4));
#pragma unroll
        for (int i = 0; i < 4; ++i)
#pragma unroll
            for (int j = 0; j < 4; ++j) {
                u32x2 w; w.x = cvt_pk_bf16(v[i][0][j], v[i][1][j]); w.y = cvt_pk_bf16(v[i][2][j], v[i][3][j]);
                *(LAS u32x2*)(scr + ((4 * n4 + j) * 17 + (kg + 4 * i)) * 8) = w;
            }
        LDS_WAIT(); asm volatile("" ::: "memory");
#pragma unroll
        for (int ch = 0; ch < 2; ++ch) {
            v16u32 x;
#pragma unroll
            for (int i = 0; i < 8; ++i) { const u32x2 w = *(const LAS u32x2*)(scr + (lane * 17 + 8 * ch + i) * 8); x[2 * i] = w.x; x[2 * i + 1] = w.y; }
            float m = 0.f;
#pragma unroll
            for (int i = 0; i < 16; ++i) m = fmaxf(fmaxf(m, fabsf(__uint_as_float(x[i] << 16))), fabsf(__uint_as_float(x[i] & 0xffff0000u)));
            int E = (int)(__float_as_uint(m * 1.0666667f) >> 23) - 2; E = E < 1 ? 1 : E;
            rr[2 * hf + ch] = __builtin_amdgcn_cvt_scalef32_pk32_fp6_bf16(__builtin_bit_cast(v32bf16, x), __uint_as_float((unsigned)E << 23)); ee[2 * hf + ch] = (unsigned)E;
        }
        LDS_WAIT(); asm volatile("" ::: "memory");
    }
#pragma unroll
    for (int q = 0; q < 4; ++q) {
        LAS unsigned char* o = scr + lane * 136 + 16 * q;
        *(LAS u32x2*)o = (u32x2){rr[q][0], rr[q][1]}; *(LAS u32x2*)(o + 8) = (u32x2){rr[q][2], rr[q][3]};
        *(LAS u32x2*)(o + 64) = (u32x2){rr[q][4], rr[q][5]}; *(LAS u32x2*)(o + 72) = (u32x2){ee[q], 0u};
    }
    LDS_WAIT(); asm volatile("" ::: "memory");
#pragma unroll
    for (int q = 0; q < 16; ++q) {
        const int n = (lane >> 4) + 4 * q;
        const u32x2 w = *(const LAS u32x2*)(scr + n * 136 + 8 * (lane & 15));
        __builtin_nontemporal_store(w, (GAS u32x2*)(WT + (size_t)(drow0 + n) * 1024 + k0 + 8 * (lane & 15)));
    }
    LDS_WAIT(); asm volatile("" ::: "memory");
}
__device__ __forceinline__ int glu_row(int n, int F) { const int hf = n >= F ? 1 : 0, m = n - hf * F; return (m >> 7) * 256 + hf * 128 + (m & 127); }

constexpr int CONV_SPLIT = 1;
constexpr int CONV_SCAN_SHARE = 36864;
__device__ __forceinline__ void convert_weights(KArgs a, LAS unsigned char* scr, int lane, int w, int nw, bool small, int l0, int l1, int it_lo, int it_hi) {
    unsigned char* ws = a->ws;
    constexpr int IT_POOL = 8 * 8, IT_GLU = 8 * 32, IT_QKV = 8 * 24, IT_WO = 8 * 16, IT_W1 = 8 * 32, IT_W2 = 8 * 16;
    const int n_small = small ? IT_POOL + IT_GLU + IT_QKV + IT_WO : 0;
    const int n_w1 = (l1 - l0) * 32 * IT_W1, n_w2 = (l1 - l0) * 32 * IT_W2;
    const int it_end = min(it_hi, n_small + n_w1 + n_w2);
    for (int it = it_lo + w; it < it_end; it += nw) {
        int r = it;
        if (r < n_small) {
            if (r < IT_POOL) { const int mat = r >> 3, q = r & 7, kb = q >> 2, nb = q & 3;
                tr_item8(a->in[I_POOLW] + (size_t)mat * 65536, 256, ws + WS_POOLW + (size_t)mat * 65536, 256, kb * 128, nb * 64, nb * 64, scr, lane, W8_SCALE); continue; }
            r -= IT_POOL;
            if (r < IT_GLU) { const int kb = r >> 5, nb = r & 31;
                tr_item8(a->in[I_GLUW], 2048, ws + WS_GLUW, 1024, kb * 128, nb * 64, glu_row(nb * 64, 1024), scr, lane, W8_SCALE); continue; }
            r -= IT_GLU;
            if (r < IT_QKV) { const int kb = r / 24, nb = r % 24;
                tr_item8(a->in[I_WQKV], 1536, ws + WS_WQKV, 1024, kb * 128, nb * 64, nb * 64, scr, lane, W8_SCALE); continue; }
            r -= IT_QKV;
            { const int kb = r >> 4, nb = r & 15;
                tr_item8(a->in[I_WO], 1024, ws + WS_WO, 1024, kb * 128, nb * 64, nb * 64, scr, lane, W8_SCALE); continue; }
        }
        r -= n_small;
        if (r < n_w1) { const int mat = l0 * 32 + (r >> 8), q = r & 255, kb = q >> 5, nb = q & 31;
            if constexpr (MOE1_FMT == 2) tr_item6(a->in[I_W1] + (size_t)mat * 1024 * 2048, 2048, ws + WS_W1T + (size_t)mat * 2048 * 1024, kb * 128, nb * 64, glu_row(nb * 64, 1024), scr, lane);
            else tr_item8(a->in[I_W1] + (size_t)mat * 1024 * 2048, 2048, ws + WS_W1T + (size_t)mat * 2048 * 1024, 1024, kb * 128, nb * 64, glu_row(nb * 64, 1024), scr, lane, W8_SCALE);
            continue; }
        r -= n_w1;
        { const int mat = l0 * 32 + (r >> 7), q = r & 127, kb = q >> 4, nb = q & 15;
            tr_item8(a->in[I_W2] + (size_t)mat * 1024 * 1024, 1024, ws + WS_W2T + (size_t)mat * 1024 * 1024, 1024, kb * 128, nb * 64, nb * 64, scr, lane, W8_SCALE); }
    }
}

__device__ __forceinline__ void prologue(KArgs a, LAS unsigned char* lds, int tid, int lane, int wave) {
    const int G = gridDim.x, bx = blockIdx.x;
    unsigned char* ws = a->ws;
    __syncthreads();
    {
        LAS float* sv = (LAS float*)lds;
        LAS float* red = (LAS float*)(lds + 9 * 1024 * 4);
        bool staged = false;
        for (int it = bx; it < 4 * 48; it += G) {
            if (!staged) {
                for (int i = tid; i < 9 * 1024; i += NTHR) { const int r = i >> 10, k = i & 1023; const float c = r < 8 ? a->in[I_C][r * 1024 + k] : a->in[I_CCTX][k]; sv[i] = c * sigmoidf_(c); }
                staged = true;
            }
            __syncthreads();
            const int layer = it / 48, col0 = (it % 48) * 128;
            const float* W = a->in[I_ADAW] + (size_t)layer * 1024 * NMOD + col0 + 2 * lane;
            f32x2 acc[9];
#pragma unroll
            for (int r = 0; r < 9; ++r) acc[r] = (f32x2){0.f, 0.f};
            const int kb = wave * 128;
#pragma unroll 8
            for (int k = 0; k < 128; ++k) {
                const f32x2 w = __builtin_nontemporal_load((const GAS f32x2*)(W + (size_t)(kb + k) * NMOD));
#pragma unroll
                for (int r = 0; r < 9; ++r) { const float s = sv[r * 1024 + kb + k]; acc[r].x += s * w.x; acc[r].y += s * w.y; }
            }
#pragma unroll
            for (int r = 0; r < 9; ++r) { red[(wave * 9 + r) * 128 + 2 * lane] = acc[r].x; red[(wave * 9 + r) * 128 + 2 * lane + 1] = acc[r].y; }
            __syncthreads();
            float* mods = (float*)(ws + WS_MODS);
            for (int i = tid; i < 9 * 128; i += NTHR) {
                const int r = i >> 7, cc = i & 127; float s = 0.f;
#pragma unroll
                for (int w = 0; w < 8; ++w) s += red[(w * 9 + r) * 128 + cc];
                mods[((size_t)layer * 9 + r) * NMOD + col0 + cc] = s + a->in[I_ADAB][layer * NMOD + col0 + cc];
            }
        }
        __syncthreads();
    }
    const int gt = bx * NTHR + tid, NGT = G * NTHR;
    for (int i = gt; i < 64 * 32; i += NGT) {
        const int pos = i >> 5, f = i & 31; const float inv = powf(10000.f, -(float)f / 32.f); const float ang = (float)pos * inv;
        ((f32x2*)(ws + WS_ROPE))[i] = (f32x2){cosf(ang), sinf(ang)};
    }
    for (int i = gt; i < 4 * 32 * 512; i += NGT) {
        const int layer = i >> 14, e = (i >> 9) & 31, c = (i & 511) * 2;
        ((unsigned*)(ws + WS_RT))[i] = cvt_pk_bf16(a->in[I_RW][((size_t)layer * 1024 + c) * 32 + e], a->in[I_RW][((size_t)layer * 1024 + c + 1) * 32 + e]);
    }
    for (int i = gt; i < 2 * 64 * 64; i += NGT) {
        const int d = i >> 12, g = (i >> 6) & 63;
        const float lr = a->in[I_LAMRE][i], li = a->in[I_LAMIM][i], dt = expf(a->in[I_LOGDT][d * 64 + g]);
        const float zr = lr * dt, zi = li * dt, mag = expf(zr);
        ((f32x2*)(ws + WS_S5LAM))[i] = (f32x2){mag * cosf(zi), mag * sinf(zi)};
    }
    for (int i = gt; i < 2 * 64 * 4 * 64; i += NGT) {
        const int l = i & 63, nt_ = (i >> 6) & 3, g = (i >> 8) & 63, d = i >> 14;
        const int p = (nt_ >> 1) * 32 + (l & 31), im = nt_ & 1, dg = d * 64 + g;
        const float lr = a->in[I_LAMRE][dg * 64 + p], li = a->in[I_LAMIM][dg * 64 + p], dt = expf(a->in[I_LOGDT][dg]);
        const float zr = lr * dt, zi = li * dt, mag = expf(zr), ar = mag * cosf(zi), ai = mag * sinf(zi), den = lr * lr + li * li;
        const float cr = ((ar - 1.f) * lr + ai * li) / den, ci = (ai * lr - (ar - 1.f) * li) / den;
        float o[8];
#pragma unroll
        for (int j = 0; j < 8; ++j) { const int h = 8 * (l >> 5) + j; const float br = a->in[I_BRE][((size_t)dg * 64 + p) * 16 + h], bi = a->in[I_BIM][((size_t)dg * 64 + p) * 16 + h];
            o[j] = im ? (cr * bi + ci * br) : (cr * br - ci * bi); }
        u32x4 w; w.x = cvt_pk_bf16(o[0], o[1]); w.y = cvt_pk_bf16(o[2], o[3]); w.z = cvt_pk_bf16(o[4], o[5]); w.w = cvt_pk_bf16(o[6], o[7]);
        ((u32x4*)(ws + WS_S5BF))[i] = w;
    }
    for (int i = gt; i < 2 * 64 * 4 * 64; i += NGT) {
        const int l = i & 63, ks = (i >> 6) & 3, g = (i >> 8) & 63, d = i >> 14, dg = d * 64 + g, hp = l & 15;
        float o[8];
#pragma unroll
        for (int j = 0; j < 8; ++j) { const int k = 32 * ks + 8 * (l >> 4) + j, p = k >> 1;
            o[j] = (k & 1) ? -a->in[I_CIM][((size_t)dg * 16 + hp) * 64 + p] : a->in[I_CRE][((size_t)dg * 16 + hp) * 64 + p]; }
        u32x4 w; w.x = cvt_pk_bf16(o[0], o[1]); w.y = cvt_pk_bf16(o[2], o[3]); w.z = cvt_pk_bf16(o[4], o[5]); w.w = cvt_pk_bf16(o[6], o[7]);
        ((u32x4*)(ws + WS_S5CF))[i] = w;
    }
    const int gw = bx * NWAVES + wave, NGW = G * NWAVES;
    convert_weights(a, lds + wave * 8704, lane, gw, NGW, true, 0, CONV_SPLIT, 0, 1 << 30);
}

template <bool BLOCKED> __device__ __forceinline__ int colof(int lane, int j) { return BLOCKED ? 16 * lane + 4 * j : 256 * j + 4 * lane; }

__device__ __forceinline__ const void* x_row_ptr(KArgs a, int layer, int row, int b, int s) {
    if (layer == 0) return s < CTXL ? a->in[I_CTX] + ((size_t)b * CTXL + s) * DM : a->in[I_X] + ((size_t)b * SEQ + (s - CTXL)) * DM;
    return (const bf16*)(a->ws + WS_XS) + (size_t)row * DM;
}
__device__ __forceinline__ f32x4 bf4_to_f32(u32x2 w) { return (f32x4){bf_lo(w.x), bf_hi(w.x), bf_lo(w.y), bf_hi(w.y)}; }
__device__ __forceinline__ u32x2 f32_to_bf4(f32x4 v) { u32x2 w; w.x = cvt_pk_bf16(v.x, v.y); w.y = cvt_pk_bf16(v.z, v.w); return w; }
template <bool BLOCKED>
__device__ __forceinline__ void row_loads(KArgs a, const void* xr, bool f32src, int row, int lane, bool combine, f32x4 (&v)[4], unsigned (&yw)[4][4]) {
    if (f32src) {
#pragma unroll
        for (int j = 0; j < 4; ++j) v[j] = *(const GAS f32x4*)((const float*)xr + colof<BLOCKED>(lane, j));
    } else {
#pragma unroll
        for (int j = 0; j < 4; ++j) v[j] = bf4_to_f32(*(const GAS u32x2*)((const bf16*)xr + colof<BLOCKED>(lane, j)));
    }
    if (combine) {
        const unsigned char* yb = a->ws + WS_YB + (size_t)row * 4 * DM;
#pragma unroll
        for (int j = 0; j < 4; ++j)
#pragma unroll
            for (int k = 0; k < 4; ++k) yw[j][k] = *(const GAS unsigned*)(yb + (size_t)k * DM + colof<BLOCKED>(lane, j));
    }
}
__device__ __forceinline__ f32x4 y8_sum(const unsigned (&w)[4]) {
    f32x4 s = (f32x4){0.f, 0.f, 0.f, 0.f};
#pragma unroll
    for (int k = 0; k < 4; ++k) { const f32x2 lo = __builtin_amdgcn_cvt_pk_f32_fp8(w[k], false), hi = __builtin_amdgcn_cvt_pk_f32_fp8(w[k], true); s.x += lo.x; s.y += lo.y; s.z += hi.x; s.w += hi.y; }
    return s * (1.0f / Y8_SCALE);
}
template <bool BLOCKED>
__device__ __forceinline__ void row_combine(KArgs a, int row, int lane, const float* gate_prev, f32x4 (&v)[4], const unsigned (&yw)[4][4]) {
    bf16* xw = (bf16*)(a->ws + WS_XS) + (size_t)row * DM;
#pragma unroll
    for (int j = 0; j < 4; ++j) {
        const int c = colof<BLOCKED>(lane, j);
        const f32x4 s = y8_sum(yw[j]);
        const f32x4 g = *(const GAS f32x4*)(gate_prev + c);
        v[j] = v[j] + g * s;
        *(GAS u32x2*)(xw + c) = f32_to_bf4(v[j]);
    }
}
template <bool BLOCKED>
__device__ __forceinline__ void load_x_row(KArgs a, int row, int lane, bool combine, const float* gate_prev, f32x4 (&v)[4]) {
    unsigned yw[4][4];
    row_loads<BLOCKED>(a, (const bf16*)(a->ws + WS_XS) + (size_t)row * DM, false, row, lane, combine, v, yw);
    if (combine) row_combine<BLOCKED>(a, row, lane, gate_prev, v, yw);
}
template <bool BLOCKED>
__device__ __forceinline__ void norm_mod(f32x4 (&v)[4], int lane, const float* g, const float* shift, const float* scale) {
    float ss = 0.f;
#pragma unroll
    for (int j = 0; j < 4; ++j) ss += (v[j].x * v[j].x + v[j].y * v[j].y) + (v[j].z * v[j].z + v[j].w * v[j].w);
    const float inv = rsqrtf(wave_sum(ss) * (1.f / DM) + NORM_EPS);
#pragma unroll
    for (int j = 0; j < 4; ++j) {
        const int c = colof<BLOCKED>(lane, j);
        const f32x4 gg = *(const GAS f32x4*)(g + c), sh = *(const GAS f32x4*)(shift + c), sc = *(const GAS f32x4*)(scale + c);
        v[j] = (v[j] * inv) * gg * (sc + 1.f) + sh;
    }
}

template <bool BLOCKED>
__device__ __forceinline__ void norm1_finish(KArgs a, int layer, int row, int b, int s, int lane, bool combine, f32x4 (&v)[4], const unsigned (&yw)[4][4]) {
    const int mrow = s < CTXL ? 8 : b;
    const float* md = mods_ptr(a, layer, mrow);
    if (combine) row_combine<BLOCKED>(a, row, lane, mods_ptr(a, layer - 1, mrow) + 5 * DM, v, yw);
    norm_mod<BLOCKED>(v, lane, a->in[I_N1G] + layer * DM, md, md + DM);
    if constexpr (!BLOCKED) {
        if (layer % 3 == 2) {
            unsigned char* o8 = a->ws + WS_B1 + (size_t)row * DM;
#pragma unroll
            for (int j = 0; j < 4; ++j) *(GAS unsigned*)(o8 + 256 * j + 4 * lane) = cvt_pk4_fp8(v[j].x, v[j].y, v[j].z, v[j].w);
        } else {
            bf16* o = (bf16*)(a->ws + WS_B1) + (size_t)row * DM;
#pragma unroll
            for (int j = 0; j < 4; ++j) { u32x2 w; w.x = cvt_pk_bf16(v[j].x, v[j].y); w.y = cvt_pk_bf16(v[j].z, v[j].w); *(GAS u32x2*)(o + 256 * j + 4 * lane) = w; }
        }
    } else {
        bf16* o = (bf16*)(a->ws + WS_B1) + (((size_t)b * 64 + lane) * SEG + s) * 16;
        u32x4 w0, w1;
        w0.x = cvt_pk_bf16(v[0].x, v[0].y); w0.y = cvt_pk_bf16(v[0].z, v[0].w); w0.z = cvt_pk_bf16(v[1].x, v[1].y); w0.w = cvt_pk_bf16(v[1].z, v[1].w);
        w1.x = cvt_pk_bf16(v[2].x, v[2].y); w1.y = cvt_pk_bf16(v[2].z, v[2].w); w1.z = cvt_pk_bf16(v[3].x, v[3].y); w1.w = cvt_pk_bf16(v[3].z, v[3].w);
        *(GAS u32x4*)o = w0; *(GAS u32x4*)(o + 8) = w1;
    }
}
template <bool BLOCKED>
__device__ __forceinline__ void phase_norm1(KArgs a, int layer, int lane, int wave) {
    const int gw = blockIdx.x * NWAVES + wave, NGW = gridDim.x * NWAVES;
    const bool combine = layer > 0, last = layer == MK_LAYERS - 1;
    for (int rowA = gw; rowA < NR; rowA += 2 * NGW) {
        const int rowB = rowA + NGW;
        const int bA = rowA / SEG, sA = rowA - bA * SEG, bB = rowB / SEG, sB = rowB - bB * SEG;
        const bool doA = !(last && sA < CTXL), doB = rowB < NR && !(last && sB < CTXL);
        f32x4 vA[4], vB[4]; unsigned yA[4][4], yB[4][4];
        if (doA) row_loads<BLOCKED>(a, x_row_ptr(a, layer, rowA, bA, sA), layer == 0, rowA, lane, combine, vA, yA);
        if (doB) row_loads<BLOCKED>(a, x_row_ptr(a, layer, rowB, bB, sB), layer == 0, rowB, lane, combine, vB, yB);
        if (doA) norm1_finish<BLOCKED>(a, layer, rowA, bA, sA, lane, combine, vA, yA);
        if (doB) norm1_finish<BLOCKED>(a, layer, rowB, bB, sB, lane, combine, vB, yB);
    }
}

__device__ __forceinline__ void phase_pooldiff(KArgs a, LAS unsigned char* lds, int layer, int tid, int lane, int wave) {
    const bool last = layer == MK_LAYERS - 1;
    const bf16* H = (const bf16*)(a->ws + WS_B1); bf16* Dd = (bf16*)(a->ws + WS_B2);
    constexpr int NCH = NR / 32;
    const int nch = last ? NB * 128 : NCH;
    for (int c = blockIdx.x; c < nch; c += gridDim.x) {
        const int b = last ? (c >> 7) : c / 136, cc = last ? 8 + (c & 127) : c - b * 136, s0 = cc * 32;
        const int seg_lo = cc < 8 ? 0 : CTXL, seg_hi = cc < 8 ? CTXL : SEG;
        const int st_lo = max(s0 - 8, seg_lo), st_hi = min(s0 + 40, seg_hi);
        __syncthreads();
        for (int p = tid; p < (st_hi - st_lo) * 128; p += NTHR) {
            const int r = p >> 7, q = p & 127;
            *(LAS u32x4*)(lds + (size_t)(st_lo + r - (s0 - 8)) * 2048 + q * 16) = *(const GAS u32x4*)(H + ((size_t)b * SEG + st_lo + r) * DM + q * 8);
        }
        __syncthreads();
#pragma unroll 1
        for (int rr = 0; rr < 4; ++rr) {
            const int s = s0 + wave * 4 + rr;
#pragma unroll
            for (int j = 0; j < 4; ++j) {
                const int half = 1 << j;
                const int lo = max(s - half, seg_lo), hi = min(s + half, seg_hi);
                f32x4 sum = (f32x4){0.f, 0.f, 0.f, 0.f};
                for (int t = lo; t < hi; ++t) { const u32x2 w = *(const LAS u32x2*)(lds + (size_t)(t - (s0 - 8)) * 2048 + (256 * j + 4 * lane) * 2); sum.x += bf_lo(w.x); sum.y += bf_hi(w.x); sum.z += bf_lo(w.y); sum.w += bf_hi(w.y); }
                const u32x2 w = *(const LAS u32x2*)(lds + (size_t)(s - (s0 - 8)) * 2048 + (256 * j + 4 * lane) * 2);
                const float ic = 1.f / (float)(hi - lo);
                *(GAS unsigned*)((unsigned char*)Dd + ((size_t)b * SEG + s) * DM + 256 * j + 4 * lane) = cvt_pk4_fp8(sum.x * ic - bf_lo(w.x), sum.y * ic - bf_hi(w.x), sum.z * ic - bf_lo(w.y), sum.w * ic - bf_hi(w.y));
            }
        }
    }
    __syncthreads();
}

__device__ __forceinline__ void phase_norm1_pooldiff(KArgs a, LAS unsigned char* lds, int layer, int tid, int lane, int wave) {
    const bool last = layer == MK_LAYERS - 1, combine = layer > 0;
    bf16* Dd = (bf16*)(a->ws + WS_B2);
    constexpr int NCH = NR / 32;
    const int nch = last ? NB * 128 : NCH;
    for (int c = blockIdx.x; c < nch; c += gridDim.x) {
        const int b = last ? (c >> 7) : c / 136, cc = last ? 8 + (c & 127) : c - b * 136, s0 = cc * 32;
        const int seg_lo = cc < 8 ? 0 : CTXL, seg_hi = cc < 8 ? CTXL : SEG, mrow = cc < 8 ? 8 : b;
        const int st_lo = max(s0 - 8, seg_lo), st_hi = min(s0 + 40, seg_hi);
        const float* md = mods_ptr(a, layer, mrow);
        __syncthreads();
#pragma unroll 1
        for (int i = 0; i < 6; i += 3) {
            int sR[3], rowR[3]; bool doR[3];
            f32x4 vR[3][4]; unsigned yR[3][4][4];
#pragma unroll
            for (int q = 0; q < 3; ++q) { sR[q] = s0 - 8 + wave + 8 * (i + q); doR[q] = sR[q] >= st_lo && sR[q] < st_hi; rowR[q] = b * SEG + sR[q]; }
#pragma unroll
            for (int q = 0; q < 3; ++q) if (doR[q]) row_loads<false>(a, x_row_ptr(a, layer, rowR[q], b, sR[q]), layer == 0, rowR[q], lane, combine, vR[q], yR[q]);
#pragma unroll
            for (int q = 0; q < 3; ++q) {
                if (!doR[q]) continue;
                f32x4 (&v)[4] = vR[q]; const unsigned (&yw)[4][4] = yR[q]; const int s = sR[q], row = rowR[q];
                if (combine) {
                    const float* gate_prev = mods_ptr(a, layer - 1, mrow) + 5 * DM;
                    const bool own = s >= s0 && s < s0 + 32;
                    bf16* xw = (bf16*)(a->ws + WS_B1) + (size_t)row * DM;
#pragma unroll
                    for (int j = 0; j < 4; ++j) { const int cidx = 256 * j + 4 * lane; v[j] = v[j] + *(const GAS f32x4*)(gate_prev + cidx) * y8_sum(yw[j]); if (own) *(GAS u32x2*)(xw + cidx) = f32_to_bf4(v[j]); }
                }
                norm_mod<false>(v, lane, a->in[I_N1G] + layer * DM, md, md + DM);
#pragma unroll
                for (int j = 0; j < 4; ++j) *(LAS u32x2*)(lds + (size_t)(s - (s0 - 8)) * 2048 + (256 * j + 4 * lane) * 2) = f32_to_bf4(v[j]);
            }
        }
        LDS_WAIT(); __syncthreads();
#pragma unroll 1
        for (int rr = 0; rr < 4; ++rr) {
            const int s = s0 + wave * 4 + rr;
#pragma unroll
            for (int j = 0; j < 4; ++j) {
                const int half = 1 << j;
                const int lo = max(s - half, seg_lo), hi = min(s + half, seg_hi);
                f32x4 sum = (f32x4){0.f, 0.f, 0.f, 0.f};
                for (int t = lo; t < hi; ++t) { const u32x2 w = *(const LAS u32x2*)(lds + (size_t)(t - (s0 - 8)) * 2048 + (256 * j + 4 * lane) * 2); sum.x += bf_lo(w.x); sum.y += bf_hi(w.x); sum.z += bf_lo(w.y); sum.w += bf_hi(w.y); }
                const u32x2 w = *(const LAS u32x2*)(lds + (size_t)(s - (s0 - 8)) * 2048 + (256 * j + 4 * lane) * 2);
                const float ic = 1.f / (float)(hi - lo);
                *(GAS unsigned*)((unsigned char*)Dd + ((size_t)b * SEG + s) * DM + 256 * j + 4 * lane) = cvt_pk4_fp8(sum.x * ic - bf_lo(w.x), sum.y * ic - bf_hi(w.x), sum.z * ic - bf_lo(w.y), sum.w * ic - bf_hi(w.y));
            }
        }
    }
    __syncthreads();
}

__device__ __forceinline__ void phase_s5_readout(KArgs a, int layer, int lane, int wave) {
    const int gw = blockIdx.x * NWAVES + wave, NGW = gridDim.x * NWAVES;
    const float* g1 = a->in[I_N1G] + layer * DM; const float* dsk = a->in[I_SSMD];
    const bf16* YG = (const bf16*)(a->ws + WS_YG);
    for (int row = gw; row < NR; row += NGW) {
        const int b = row / SEG, s = row - b * SEG, mrow = s < CTXL ? 8 : b;
        const float* md = mods_ptr(a, layer, mrow);
        f32x4 v[4];
        load_x_row<true>(a, row, lane, false, nullptr, v);
        norm_mod<true>(v, lane, g1, md, md + DM);
        const unsigned yoff = (unsigned)(b * 64 * SEG + s) * 16u + (unsigned)lane * (unsigned)(SEG * 16);
        const unsigned char* y0 = (const unsigned char*)YG + yoff;
        const unsigned char* y1 = y0 + (unsigned)(NB * 64 * SEG * 16);
        const u32x4 ya = *(const GAS u32x4*)y0, yb = *(const GAS u32x4*)y1;
        unsigned pk[4];
#pragma unroll
        for (int j = 0; j < 4; ++j) {
            const f32x2 al = __builtin_amdgcn_cvt_pk_f32_fp8(ya[j], false), ah = __builtin_amdgcn_cvt_pk_f32_fp8(ya[j], true), bl = __builtin_amdgcn_cvt_pk_f32_fp8(yb[j], false), bh = __builtin_amdgcn_cvt_pk_f32_fp8(yb[j], true);
            const f32x4 ysum = (f32x4){al.x + bl.x, al.y + bl.y, ah.x + bh.x, ah.y + bh.y} * (1.0f / 16.f);
            const f32x4 dd = *(const GAS f32x4*)(dsk + 16 * lane + 4 * j);
            f32x4 y = ysum + dd * v[j];
            float o[4];
#pragma unroll
            for (int i = 0; i < 4; ++i) { const float t = y[i]; o[i] = t * __builtin_amdgcn_rcpf(1.0f + __builtin_amdgcn_exp2f(-2.3022082f * (t + 0.044715f * t * t * t))); }
            pk[j] = cvt_pk4_fp8(o[0], o[1], o[2], o[3]);
        }
        *(GAS u32x4*)(a->ws + WS_B2 + (size_t)row * DM + 16 * lane) = (u32x4){pk[0], pk[1], pk[2], pk[3]};
    }
}

__device__ __forceinline__ void qk_head(bf16* p, unsigned char* p8, const float* g, const f32x2* rope, int t, bool latent, int q8) {
    const int ax = q8 >> 2, f0 = (q8 & 3) * 8, d1 = ax * 64 + f0;
    const u32x4 w1 = *(const GAS u32x4*)(p + d1), w2 = *(const GAS u32x4*)(p + d1 + 32);
    float x1[8], x2[8];
#pragma unroll
    for (int j = 0; j < 4; ++j) { x1[2 * j] = bf_lo(w1[j]); x1[2 * j + 1] = bf_hi(w1[j]); x2[2 * j] = bf_lo(w2[j]); x2[2 * j + 1] = bf_hi(w2[j]); }
    float ss = 0.f;
#pragma unroll
    for (int j = 0; j < 8; ++j) ss += x1[j] * x1[j] + x2[j] * x2[j];
    ss += __shfl_xor(ss, 1); ss += __shfl_xor(ss, 2); ss += __shfl_xor(ss, 4);
    const float inv = rsqrtf(ss * (1.f / 128.f) + NORM_EPS);
    const int pos = ax == 0 ? (t >> 6) : (t & 63);
    float y1[8], y2[8];
#pragma unroll
    for (int j = 0; j < 4; ++j) {
        const f32x2 ga = *(const GAS f32x2*)(g + d1 + 2 * j), gb = *(const GAS f32x2*)(g + d1 + 32 + 2 * j);
        float a0 = x1[2 * j] * inv * ga.x, a1 = x1[2 * j + 1] * inv * ga.y, b0 = x2[2 * j] * inv * gb.x, b1 = x2[2 * j + 1] * inv * gb.y;
        if (latent) {
            const f32x4 cs = *(const GAS f32x4*)(rope + pos * 32 + f0 + 2 * j);
            const float r0 = a0 * cs.x - b0 * cs.y, s0 = b0 * cs.x + a0 * cs.y, r1 = a1 * cs.z - b1 * cs.w, s1 = b1 * cs.z + a1 * cs.w;
            a0 = r0; b0 = s0; a1 = r1; b1 = s1;
        }
        y1[2 * j] = a0; y1[2 * j + 1] = a1; y2[2 * j] = b0; y2[2 * j + 1] = b1;
    }
    const int off = 64 * (q8 & 1) + 32 * ax + 8 * ((q8 & 3) >> 1);
    *(GAS u32x2*)(p8 + off) = (u32x2){cvt_pk4_fp8(y1[0], y1[1], y1[2], y1[3]), cvt_pk4_fp8(y1[4], y1[5], y1[6], y1[7])};
    *(GAS u32x2*)(p8 + off + 16) = (u32x2){cvt_pk4_fp8(y2[0], y2[1], y2[2], y2[3]), cvt_pk4_fp8(y2[4], y2[5], y2[6], y2[7])};
}
constexpr int V8T_TILE = 128 * 64;
__device__ __forceinline__ void phase_qkpost(KArgs a, LAS unsigned char* lds, int tid, int lane, int wave) {
    const int gw = blockIdx.x * NWAVES + wave, NGW = gridDim.x * NWAVES;
    const f32x2* rope = (const f32x2*)(a->ws + WS_ROPE);
    for (int row4 = gw * 4; row4 < NR; row4 += NGW * 4) {
        const int row = row4 + (lane >> 4), l16 = lane & 15;
        int s = (row4 - (row4 / SEG) * SEG) + (lane >> 4); if (s >= SEG) s -= SEG;
        const bool latent = s >= CTXL; const int t = s - CTXL;
        qk_head((bf16*)(a->ws + WS_KB) + (size_t)row * 256 + (l16 >> 3) * 128, a->ws + WS_B3 + (size_t)row * 256 + (l16 >> 3) * 128, a->in[I_KG], rope, t, latent, l16 & 7);
    }
    const bf16* Vb = (const bf16*)(a->ws + WS_VB); unsigned char* VT = a->ws + WS_YG;
    for (int item = blockIdx.x; item < NB * 2 * 68; item += gridDim.x) {
        const int b = item / 136, rem = item - b * 136, kvh = rem / 68, j = rem - kvh * 68;
        __syncthreads();
#pragma unroll
        for (int i = 0; i < 2; ++i) { const int p = tid + i * NTHR, key = p >> 4, piece = p & 15;
            *(LAS u32x4*)(lds + key * 272 + piece * 16) = *(const GAS u32x4*)(Vb + ((size_t)b * SEG + j * 64 + key) * 256 + kvh * 128 + piece * 8); }
        LDS_WAIT(); __syncthreads();
        const int d = tid >> 2, c = tid & 3, hh = c >> 1, kb = c & 1;
        float v[16];
#pragma unroll
        for (int t = 0; t < 16; ++t) { const int key = 32 * kb + (t & 3) + 8 * (t >> 2) + 4 * hh; v[t] = __uint_as_float((unsigned)*(const LAS unsigned short*)(lds + key * 272 + d * 2) << 16); }
        *(GAS u32x4*)(VT + (size_t)item * V8T_TILE + d * 64 + ((c ^ ((d >> 2) & 3)) << 4)) = (u32x4){cvt_pk4_fp8(v[0], v[1], v[2], v[3]), cvt_pk4_fp8(v[4], v[5], v[6], v[7]), cvt_pk4_fp8(v[8], v[9], v[10], v[11]), cvt_pk4_fp8(v[12], v[13], v[14], v[15])};
    }
    __syncthreads();
}

__device__ __forceinline__ void phase_final(KArgs a, int lane, int wave) {
    const int gw = blockIdx.x * NWAVES + wave, NGW = gridDim.x * NWAVES;
    for (int row = gw; row < NR; row += NGW) {
        const int b = row / SEG, s = row - b * SEG;
        if (s < CTXL) continue;
        f32x4 v[4]; unsigned yw[4][4];
        row_loads<false>(a, (const bf16*)(a->ws + WS_XS) + (size_t)row * DM, false, row, lane, true, v, yw);
        const float* gate = mods_ptr(a, MK_LAYERS - 1, b) + 5 * DM;
        float* o = a->out + ((size_t)b * SEQ + (s - CTXL)) * DM;
#pragma unroll
        for (int j = 0; j < 4; ++j) { const int c = 256 * j + 4 * lane; *(GAS f32x4*)(o + c) = v[j] + *(const GAS f32x4*)(gate + c) * y8_sum(yw[j]); }
    }
}

__device__ __forceinline__ int s5_token(int d, int j) { return d == 0 ? j : (j < CTXL ? (CTXL - 1 - j) : (SEG + CTXL - 1 - j)); }
__device__ __forceinline__ void phase_s5_scan(KArgs a, LAS unsigned char* lds, int lane, int wave) {
    if (wave >= 4) {
        convert_weights(a, lds + 4 * 8704 + (wave - 4) * 8704, lane, blockIdx.x * 4 + (wave - 4), gridDim.x * 4, false, CONV_SPLIT, MK_LAYERS, 0, CONV_SCAN_SHARE);
        return;
    }
    const int G = gridDim.x;
    __builtin_amdgcn_s_setprio(3);
    LAS unsigned* Hs = (LAS unsigned*)(lds + wave * 8704);
    const int hi = lane >> 5, c = lane & 31;
    const int rho = lane & 31, posA = 16 * ((rho >> 2) & 1) + (rho & 3) + 4 * (rho >> 3);
    for (int sid = blockIdx.x * 4 + wave; sid < NB * 64 * 2; sid += G * 4) {
        const int d = sid & 1, g = (sid >> 1) & 63, b = sid >> 7, dg = d * 64 + g;
        const bf16* U = (const bf16*)(a->ws + WS_B1) + ((size_t)b * 64 + g) * SEG * 16;
        unsigned* Y = (unsigned*)(a->ws + WS_YG) + ((size_t)(d * NB + b) * 64 + g) * SEG * 4;
        bf16x8 bfr[4], cfr[4];
#pragma unroll
        for (int n = 0; n < 4; ++n) { bfr[n] = *(const GAS bf16x8*)(a->ws + WS_S5BF + ((size_t)(dg * 4 + n) * 64 + lane) * 16); cfr[n] = *(const GAS bf16x8*)(a->ws + WS_S5CF + ((size_t)(dg * 4 + n) * 64 + lane) * 16); }
        const f32x2 lam0 = ((const f32x2*)(a->ws + WS_S5LAM))[dg * 64 + c], lam1 = ((const f32x2*)(a->ws + WS_S5LAM))[dg * 64 + 32 + c];
        float car[2][2] = {{0.f, 0.f}, {0.f, 0.f}};
        float pwr[2][8], pwi[2][8];
#pragma unroll
        for (int pp = 0; pp < 2; ++pp) { const float ar = pp ? lam1.x : lam0.x, ai = pp ? lam1.y : lam0.y; float pr = ar, pi = ai;
#pragma unroll
            for (int r = 0; r < 8; ++r) { pwr[pp][r] = pr; pwi[pp][r] = pi; const float tr = ar * pr - ai * pi, ti = ar * pi + ai * pr; pr = tr; pi = ti; } }
        bf16x8 uf[4];
#pragma unroll
        for (int q = 0; q < 4; ++q) uf[q] = *(const GAS bf16x8*)(U + (size_t)s5_token(d, 32 * q + posA) * 16 + 8 * hi);
        for (int jb = 0; jb < SEG; jb += 128) {
#pragma unroll
          for (int q = 0; q < 4; ++q) {
            const int j0 = jb + 32 * q;
            const bf16x8 ufr = uf[q];
            if (j0 + 128 < SEG) uf[q] = *(const GAS bf16x8*)(U + (size_t)s5_token(d, j0 + 128 + posA) * 16 + 8 * hi);
            f32x16 x[4];
#pragma unroll
            for (int n = 0; n < 4; ++n) { x[n] = f32x16{}; x[n] = __builtin_amdgcn_mfma_f32_32x32x16_bf16(ufr, bfr[n], x[n], 0, 0, 0); }
#pragma unroll
            for (int pp = 0; pp < 2; ++pp) {
                const float ar = pp ? lam1.x : lam0.x, ai = pp ? lam1.y : lam0.y;
                float sr = hi == 0 ? car[pp][0] : 0.f, si = hi == 0 ? car[pp][1] : 0.f;
#pragma unroll
                for (int r = 0; r < 16; ++r) {
                    const float nr = fmaf(ar, sr, fmaf(-ai, si, x[2 * pp][r])), ni = fmaf(ar, si, fmaf(ai, sr, x[2 * pp + 1][r]));
                    sr = nr; si = ni; x[2 * pp][r] = sr; x[2 * pp + 1][r] = si;
                }
                float wr_ = __shfl(sr, c), wi_ = __shfl(si, c);
                if (hi == 0) { wr_ = 0.f; wi_ = 0.f; }
#pragma unroll
                for (int r = 0; r < 16; ++r) {
                    if (r == 8) { const float tr = pwr[pp][7] * wr_ - pwi[pp][7] * wi_, ti = pwr[pp][7] * wi_ + pwi[pp][7] * wr_; wr_ = tr; wi_ = ti; }
                    x[2 * pp][r] = fmaf(pwr[pp][r & 7], wr_, fmaf(-pwi[pp][r & 7], wi_, x[2 * pp][r])); x[2 * pp + 1][r] = fmaf(pwr[pp][r & 7], wi_, fmaf(pwi[pp][r & 7], wr_, x[2 * pp + 1][r]));
                }
                car[pp][0] = __shfl(x[2 * pp][15], c + 32); car[pp][1] = __shfl(x[2 * pp + 1][15], c + 32);
#pragma unroll
                for (int r = 0; r < 16; ++r) Hs[(16 * hi + r) * 68 + c + 32 * pp] = cvt_pk_bf16(x[2 * pp][r], x[2 * pp + 1][r]);
            }
            LDS_WAIT(); asm volatile("" ::: "memory");
#pragma unroll
            for (int mt = 0; mt < 2; ++mt) {
                f32x4 y = (f32x4){0.f, 0.f, 0.f, 0.f};
#pragma unroll
                for (int ks = 0; ks < 4; ++ks) {
                    const bf16x8 af = *(const LAS bf16x8*)(Hs + (16 * mt + (lane & 15)) * 68 + 16 * ks + 4 * (lane >> 4));
                    y = __builtin_amdgcn_mfma_f32_16x16x32_bf16(af, cfr[ks], y, 0, 0, 0);
                }
#pragma unroll
                for (int i = 0; i < 4; ++i) { const int pos = 16 * mt + 4 * (lane >> 4) + i; const float nb_ = __shfl_xor(y[i], 1);
                    const int pk_ = __builtin_amdgcn_cvt_pk_fp8_f32(y[i] * 16.f, nb_ * 16.f, 0, false) & 0xffff; const int ot_ = __shfl_xor(pk_, 2);
                    if ((lane & 3) == 0) Y[(size_t)s5_token(d, j0 + pos) * 4 + ((lane & 15) >> 2)] = (unsigned)(pk_ | (ot_ << 16)); }
            }
            LDS_WAIT(); asm volatile("" ::: "memory");
          }
        }
    }
    __builtin_amdgcn_s_setprio(0);
    convert_weights(a, lds + wave * 8704, lane, blockIdx.x * 4 + wave, gridDim.x * 4, false, CONV_SPLIT, MK_LAYERS, CONV_SCAN_SHARE, 1 << 30);
}

constexpr int RW_STRIDE = 2064;
__device__ __forceinline__ void phase_router(KArgs a, LAS unsigned char* lds, int layer, int tid, int lane, int wave) {
    const int G = gridDim.x, bx = blockIdx.x;
    const bool last = layer >= MK_LAYERS - 2;
    LAS unsigned char* Wl = lds;
    LAS int* ent_e = (LAS int*)(lds + RSCR_OFF); LAS float* ent_g = (LAS float*)(lds + RSCR_OFF + RPB_MAX * 16);
    LAS int* lcount = (LAS int*)(lds + RSCR_OFF + RPB_MAX * 32); LAS int* lbase = lcount + 32; LAS int* lfill = lcount + 64;
    { const u32x4* src = (const u32x4*)(a->ws + WS_RT) + (size_t)layer * 4096;
      for (int p = tid; p < 4096; p += NTHR) *(LAS u32x4*)(Wl + (p >> 7) * RW_STRIDE + (p & 127) * 16) = src[p]; }
    if (tid < 32) { lcount[tid] = 0; lfill[tid] = 0; }
    __syncthreads();
    const bool lat_deal = last && G == NB * 32;
    const int rpb = lat_deal ? 128 : (NR + G - 1) / G, row0 = lat_deal ? (bx >> 5) * SEG + CTXL + (bx & 31) * 128 : bx * rpb, row1 = lat_deal ? row0 + 128 : min(NR, row0 + rpb), nrows = row1 - row0;
    const float* g2 = a->in[I_N2G] + layer * DM; const float* rb = a->in[I_RB] + layer * 32;
    LAS unsigned char* Hl = lds + 32 * RW_STRIDE;
    const int s_row0 = row0 - (row0 / SEG) * SEG;
    const int hi = lane >> 5, tk = lane & 31;
    u32x2 xw[4][4];
#define RT_LOAD(g_) do { _Pragma("unroll") for (int q_ = 0; q_ < 4; ++q_) { const int lr_ = 32 * (g_) + 8 * q_ + wave; if (lr_ < nrows) { \
        const bf16* xr_ = (const bf16*)(a->ws + WS_XS) + (size_t)(row0 + lr_) * DM; _Pragma("unroll") for (int j_ = 0; j_ < 4; ++j_) xw[q_][j_] = *(const GAS u32x2*)(xr_ + 256 * j_ + 4 * lane); } } } while (0)
    RT_LOAD(0);
    const int ngroups = (nrows + 31) >> 5;
    for (int g = 0; g < ngroups; ++g) {
#pragma unroll
        for (int q = 0; q < 4; ++q) {
            const int lr = 32 * g + 8 * q + wave;
            if (lr < nrows) {
                int sl = s_row0 + lr; int bb = row0 / SEG; if (sl >= SEG) { sl -= SEG; bb += 1; }
                if (!(last && sl < CTXL)) {
                    const float* md = mods_ptr(a, layer, sl < CTXL ? 8 : bb);
                    f32x4 v[4];
#pragma unroll
                    for (int j = 0; j < 4; ++j) v[j] = bf4_to_f32(xw[q][j]);
                    norm_mod<false>(v, lane, g2, md + 3 * DM, md + 4 * DM);
                    unsigned char* o8 = a->ws + WS_B3F + (size_t)(row0 + lr) * DM;
#pragma unroll
                    for (int j = 0; j < 4; ++j) { *(LAS u32x2*)(Hl + (8 * q + wave) * RW_STRIDE + (256 * j + 4 * lane) * 2) = f32_to_bf4(v[j]);
                        if constexpr (MOE1_FMT != 2) *(GAS unsigned*)(o8 + 256 * j + 4 * lane) = cvt_pk4_fp8(v[j].x, v[j].y, v[j].z, v[j].w); }
                }
            }
        }
        if (g + 1 < ngroups) RT_LOAD(g + 1);
        LDS_WAIT(); __syncthreads();
        if constexpr (MOE1_FMT == 2) {
#pragma unroll
            for (int ps = 0; ps < 2; ++ps) {
                const int lr32 = 4 * wave + 2 * ps + (lane >> 5), lr = 32 * g + lr32, c = lane & 31;
                if (lr < nrows) {
                    const LAS unsigned char* hp = Hl + lr32 * RW_STRIDE + c * 64;
                    const u32x4 w0 = *(const LAS u32x4*)hp, w1 = *(const LAS u32x4*)(hp + 16), w2 = *(const LAS u32x4*)(hp + 32), w3 = *(const LAS u32x4*)(hp + 48);
                    const v16u32 x = {w0.x, w0.y, w0.z, w0.w, w1.x, w1.y, w1.z, w1.w, w2.x, w2.y, w2.z, w2.w, w3.x, w3.y, w3.z, w3.w};
                    fp6_chunk_store(x, a->ws + WS_B3F + (size_t)(row0 + lr) * DM, c);
                }
            }
        }
        const int wa = g & 7, wb = (g + 1) & 7;
        LAS float* part = (LAS float*)(lds + RPART_OFF);
        f32x16 acc = f32x16{};
        if (wave == wa || wave == wb) {
            const LAS unsigned char* hp = Hl + tk * RW_STRIDE + 16 * hi + (wave == wa ? 0 : 1024);
            const LAS unsigned char* wp = Wl + tk * RW_STRIDE + 16 * hi + (wave == wa ? 0 : 1024);
            f32x16 acc1 = f32x16{};
#pragma unroll 4
            for (int s0 = 0; s0 < 32; s0 += 2) {
                const bf16x8 af0 = *(const LAS bf16x8*)(wp + 32 * s0), bf0 = *(const LAS bf16x8*)(hp + 32 * s0), af1 = *(const LAS bf16x8*)(wp + 32 * s0 + 32), bf1 = *(const LAS bf16x8*)(hp + 32 * s0 + 32);
                acc = __builtin_amdgcn_mfma_f32_32x32x16_bf16(af0, bf0, acc, 0, 0, 0); acc1 = __builtin_amdgcn_mfma_f32_32x32x16_bf16(af1, bf1, acc1, 0, 0, 0); }
            acc = acc + acc1;
            if (wave == wb) {
#pragma unroll
                for (int r = 0; r < 16; ++r) part[r * 64 + lane] = acc[r];
            }
        }
        LDS_WAIT(); __syncthreads();
        if (wave == wa) {
            const int lrow = 32 * g + tk; const bool inrange = lrow < nrows;
            bool valid = inrange; { int sl_ = s_row0 + lrow; if (sl_ >= SEG) sl_ -= SEG; if (last && sl_ < CTXL) valid = false; }
#pragma unroll
            for (int r = 0; r < 16; ++r) acc[r] += part[r * 64 + lane];
            float NEG = -3.0e38f; asm volatile("" : "+v"(NEG));
            float v[16];
#pragma unroll
            for (int r = 0; r < 16; ++r) v[r] = acc[r] + rb[(r & 3) + 8 * (r >> 2) + 4 * hi];
            float cv[8]; int ce[8];
#pragma unroll
            for (int k = 0; k < 4; ++k) {
                float best = NEG; int bi = 0;
#pragma unroll
                for (int r = 0; r < 16; ++r) if (v[r] > best) { best = v[r]; bi = r; }
#pragma unroll
                for (int r = 0; r < 16; ++r) if (r == bi) v[r] = NEG;
                cv[k] = best; ce[k] = (bi & 3) + 8 * (bi >> 2) + 4 * hi;
            }
#pragma unroll
            for (int k = 0; k < 4; ++k) { cv[4 + k] = __shfl_xor(cv[k], 32); ce[4 + k] = __shfl_xor(ce[k], 32); }
            float sv[4]; int se[4];
#pragma unroll
            for (int k = 0; k < 4; ++k) {
                float best = NEG; int be = 64, bi = 0;
#pragma unroll
                for (int q = 0; q < 8; ++q) if (cv[q] > best || (cv[q] == best && ce[q] < be)) { best = cv[q]; be = ce[q]; bi = q; }
#pragma unroll
                for (int q = 0; q < 8; ++q) if (q == bi) cv[q] = NEG;
                sv[k] = best; se[k] = be;
            }
            if (hi == 0 && inrange) {
                const float e1 = __expf(sv[1] - sv[0]), e2 = __expf(sv[2] - sv[0]), e3 = __expf(sv[3] - sv[0]);
                const float isum = 1.f / (1.f + e1 + e2 + e3);
                const int inv = valid ? 0 : -1;
                ent_e[lrow * 4 + 0] = se[0] | inv; ent_g[lrow * 4 + 0] = isum;
                ent_e[lrow * 4 + 1] = se[1] | inv; ent_g[lrow * 4 + 1] = e1 * isum;
                ent_e[lrow * 4 + 2] = se[2] | inv; ent_g[lrow * 4 + 2] = e2 * isum;
                ent_e[lrow * 4 + 3] = se[3] | inv; ent_g[lrow * 4 + 3] = e3 * isum;
                if (valid) {
#pragma unroll
                    for (int k = 0; k < 4; ++k) atomicAdd((int*)&lcount[se[k]], 1);
                }
            }
        }
    }
#undef RT_LOAD
    __syncthreads();
    unsigned* cnt = (unsigned*)(a->ws + WS_CTL) + CW_CNT + layer * 32;
    if (tid < 32) lbase[tid] = (int)__hip_atomic_fetch_add(cnt + tid, (unsigned)lcount[tid], __ATOMIC_RELAXED, __HIP_MEMORY_SCOPE_AGENT);
    __syncthreads();
    int* list = (int*)(a->ws + WS_LIST); float* gate = (float*)(a->ws + WS_GATE);
    for (int i = tid; i < (row1 - row0) * 4; i += NTHR) {
        const int e = ent_e[i];
        if (e >= 0) { const int pos = lbase[e] + atomicAdd((int*)&lfill[e], 1); const int ent = (row0 + (i >> 2)) * 4 + (i & 3); list[(size_t)e * NR + pos] = ent; gate[(size_t)e * NR + pos] = ent_g[i]; }
    }
    __syncthreads();
}

typedef f32x4 AccT[2][2][4][2];
struct EpiResid {
    static constexpr int PERM = 2;
    bf16* xs; const float* mods_layer; const float* pscale;
    const float* in_x; const float* in_ctx;
    const bf16* src_bf;
    __device__ __forceinline__ void operator()(const AccT& acc, const pg8::Unit& u, int wr, int wc, int fr, int fq, const LAS int* tab) const {
        const int tile = u.pm, bb = tile / 17, tt = tile - bb * 17, mrow = tt == 0 ? 8 : bb;
        const float* gate = mods_layer + (size_t)mrow * NMOD + 2 * DM;
        const float* srcf = in_x ? (tt == 0 ? in_ctx + (size_t)bb * CTXL * DM : in_x + ((size_t)bb * SEQ + (tt - 1) * 256) * DM) : nullptr;
        bf16* dst = xs + (size_t)tile * 256 * DM; const bf16* srcb = (src_bf ? src_bf : xs) + (size_t)tile * 256 * DM;
        const int col0 = u.pn * 256 + wc * 64 + fq * 16;
        f32x4 gv[2][2];
#pragma unroll
        for (int bj = 0; bj < 2; ++bj)
#pragma unroll
            for (int n = 0; n < 2; ++n) { gv[bj][n] = *(const GAS f32x4*)(gate + col0 + 8 * bj + 4 * n); if (pscale) gv[bj][n] = gv[bj][n] * *(const GAS f32x4*)(pscale + col0 + 8 * bj + 4 * n); }
#pragma unroll
        for (int ai = 0; ai < 2; ++ai)
#pragma unroll
            for (int m = 0; m < 4; ++m) {
                const size_t o = (size_t)(ai * 128 + wr * 64 + m * 16 + fr) * DM + col0;
                f32x4 x[2][2];
                if (srcf) {
#pragma unroll
                    for (int bj = 0; bj < 2; ++bj)
#pragma unroll
                        for (int n = 0; n < 2; ++n) x[bj][n] = *(const GAS f32x4*)(srcf + o + 8 * bj + 4 * n);
                } else {
#pragma unroll
                    for (int bj = 0; bj < 2; ++bj) { const u32x4 w = *(const GAS u32x4*)(srcb + o + 8 * bj); x[bj][0] = bf4_to_f32((u32x2){w.x, w.y}); x[bj][1] = bf4_to_f32((u32x2){w.z, w.w}); }
                }
#pragma unroll
                for (int bj = 0; bj < 2; ++bj) { const u32x2 lo = f32_to_bf4(x[bj][0] + gv[bj][0] * acc[ai][bj][m][0]), hi2 = f32_to_bf4(x[bj][1] + gv[bj][1] * acc[ai][bj][m][1]);
                    *(GAS u32x4*)(dst + o + 8 * bj) = (u32x4){lo.x, lo.y, hi2.x, hi2.y}; }
            }
    }
};
struct EpiGlu {
    static constexpr int PERM = 1;
    bf16* xs; const float* mods_layer; const float* bias;
    __device__ __forceinline__ void operator()(const AccT& acc, const pg8::Unit& u, int wr, int wc, int fr, int fq, const LAS int* tab) const {
        const int tile = u.pm, mrow = (tile % 17 == 0) ? 8 : tile / 17;
        const float* gate = mods_layer + (size_t)mrow * NMOD + 2 * DM;
        const int col0 = u.pn * 128 + wc * 32 + 8 * fq;
        f32x4 gv[2], bv[2], bg[2];
#pragma unroll
        for (int n = 0; n < 2; ++n) { gv[n] = *(const GAS f32x4*)(gate + col0 + 4 * n); bv[n] = *(const GAS f32x4*)(bias + col0 + 4 * n); bg[n] = *(const GAS f32x4*)(bias + DM + col0 + 4 * n); }
#pragma unroll
        for (int ai = 0; ai < 2; ++ai)
#pragma unroll
            for (int m = 0; m < 4; ++m) {
                bf16* p = xs + (size_t)(tile * 256 + ai * 128 + wr * 64 + m * 16 + fr) * DM + col0;
                const u32x4 w = *(const GAS u32x4*)p;
                f32x4 x[2] = {bf4_to_f32((u32x2){w.x, w.y}), bf4_to_f32((u32x2){w.z, w.w})};
                u32x2 ow[2];
#pragma unroll
                for (int n = 0; n < 2; ++n) {
                    const f32x4 val = acc[ai][0][m][n] + bv[n], gt = acc[ai][1][m][n] + bg[n];
                    f32x4 o; o.x = val.x * sigmoidf_(gt.x); o.y = val.y * sigmoidf_(gt.y); o.z = val.z * sigmoidf_(gt.z); o.w = val.w * sigmoidf_(gt.w);
                    ow[n] = f32_to_bf4(x[n] + gv[n] * o);
                }
                *(GAS u32x4*)p = (u32x4){ow[0].x, ow[0].y, ow[1].x, ow[1].y};
            }
    }
};
struct EpiQkv {
    static constexpr int PERM = 2;
    bf16* q; bf16* k; bf16* v;
    __device__ __forceinline__ void operator()(const AccT& acc, const pg8::Unit& u, int wr, int wc, int fr, int fq, const LAS int* tab) const {
        bf16* base = u.pn < 4 ? q + u.pn * 256 : (u.pn == 4 ? k : v); const int ldc = u.pn < 4 ? 1024 : 256;
#pragma unroll
        for (int ai = 0; ai < 2; ++ai)
#pragma unroll
            for (int m = 0; m < 4; ++m) { bf16* rowp = base + (size_t)(u.pm * 256 + ai * 128 + wr * 64 + m * 16 + fr) * ldc + wc * 64 + 16 * fq;
#pragma unroll
                for (int bj = 0; bj < 2; ++bj) { const f32x4 v0 = acc[ai][bj][m][0], v1 = acc[ai][bj][m][1];
                    u32x4 w; w.x = cvt_pk_bf16(v0[0], v0[1]); w.y = cvt_pk_bf16(v0[2], v0[3]); w.z = cvt_pk_bf16(v1[0], v1[1]); w.w = cvt_pk_bf16(v1[2], v1[3]);
                    *(GAS u32x4*)(rowp + bj * 8) = w; } }
    }
};
struct EpiMoe1 {
    static constexpr int PERM = 1;
    unsigned char* act;
    __device__ __forceinline__ void operator()(const AccT& acc, const pg8::Unit& u, int wr, int wc, int fr, int fq, const LAS int* tab) const {
        const int cl = wc * 32 + 8 * fq, col0 = u.pn * 128 + cl;
        const LAS float* bt = (const LAS float*)(tab + 512);
        float c7 = 7.0f, ck = -2.4554669595930156f; asm volatile("" : "+v"(c7), "+v"(ck));
        f32x4 bg[2], bl[2];
#pragma unroll
        for (int n = 0; n < 2; ++n) { bg[n] = *(const LAS f32x4*)(bt + cl + 4 * n); bl[n] = *(const LAS f32x4*)(bt + 128 + cl + 4 * n); }
#pragma unroll
        for (int ai = 0; ai < 2; ++ai)
#pragma unroll
            for (int m = 0; m < 4; ++m) {
                float o[8];
#pragma unroll
                for (int n = 0; n < 2; ++n)
#pragma unroll
                    for (int jp = 0; jp < 2; ++jp) {
                        f32x2 g = (f32x2){acc[ai][0][m][n][2 * jp], acc[ai][0][m][n][2 * jp + 1]} + (f32x2){bg[n][2 * jp], bg[n][2 * jp + 1]};
                        f32x2 l = (f32x2){acc[ai][1][m][n][2 * jp], acc[ai][1][m][n][2 * jp + 1]} + (f32x2){bl[n][2 * jp], bl[n][2 * jp + 1]};
                        g.x = fminf(g.x, c7); g.y = fminf(g.y, c7);
                        l.x = __builtin_amdgcn_fmed3f(l.x, -c7, c7); l.y = __builtin_amdgcn_fmed3f(l.y, -c7, c7);
                        f32x2 t = g * ck;
                        t.x = __builtin_amdgcn_exp2f(t.x); t.y = __builtin_amdgcn_exp2f(t.y);
                        t = t + 1.0f;
                        t.x = __builtin_amdgcn_rcpf(t.x); t.y = __builtin_amdgcn_rcpf(t.y);
                        const f32x2 r = (g * t) * (l + 1.0f);
                        o[4 * n + 2 * jp] = r.x; o[4 * n + 2 * jp + 1] = r.y;
                    }
                u32x2 w; w.x = cvt_pk4_fp8(o[0], o[1], o[2], o[3]); w.y = cvt_pk4_fp8(o[4], o[5], o[6], o[7]);
                *(GAS u32x2*)(act + (size_t)(u.pm * 256 + ai * 128 + wr * 64 + m * 16 + fr) * DFF + col0) = w;
            }
    }
};
struct EpiNull {
    static constexpr int PERM = 1;
    float* sink;
    __device__ __forceinline__ void operator()(const AccT& acc, const pg8::Unit& u, int wr, int wc, int fr, int fq, const LAS int* tab) const {
        f32x4 s = (f32x4){0.f, 0.f, 0.f, 0.f};
#pragma unroll
        for (int ai = 0; ai < 2; ++ai)
#pragma unroll
            for (int bj = 0; bj < 2; ++bj)
#pragma unroll
                for (int m = 0; m < 4; ++m)
#pragma unroll
                    for (int n = 0; n < 2; ++n) s = s + acc[ai][bj][m][n];
        sink[(size_t)(u.pm * 256 + wr * 64 + fr) * 64 + wc * 16 + fq * 4 + (u.pn & 3)] = (s.x + s.y) + (s.z + s.w);
    }
};
struct EpiMoe2 {
    static constexpr int PERM = 2;
    unsigned char* yb;
    __device__ __forceinline__ void operator()(const AccT& acc, const pg8::Unit& u, int wr, int wc, int fr, int fq, const LAS int* tab) const {
        const int cl = wc * 64 + 16 * fq, col0 = u.pn * 256 + cl;
        const LAS float* bt = (const LAS float*)(tab + 512); const LAS float* gt = (const LAS float*)(tab + 256);
        f32x4 bv[2][2];
#pragma unroll
        for (int bj = 0; bj < 2; ++bj)
#pragma unroll
            for (int n = 0; n < 2; ++n) bv[bj][n] = *(const LAS f32x4*)(bt + cl + 8 * bj + 4 * n);
#pragma unroll
        for (int ai = 0; ai < 2; ++ai)
#pragma unroll
            for (int m = 0; m < 4; ++m) {
                const int rl = ai * 128 + wr * 64 + m * 16 + fr;
                const int ent = (u.rb * 256 + rl < u.cnt) ? tab[rl] : NR * 4; const float g = gt[rl] * Y8_SCALE;
                u32x4 w;
#pragma unroll
                for (int bj = 0; bj < 2; ++bj) { const f32x4 v0 = (acc[ai][bj][m][0] + bv[bj][0]) * g, v1 = (acc[ai][bj][m][1] + bv[bj][1]) * g;
                    w[2 * bj] = cvt_pk4_fp8(v0[0], v0[1], v0[2], v0[3]); w[2 * bj + 1] = cvt_pk4_fp8(v1[0], v1[1], v1[2], v1[3]); }
                *(GAS u32x4*)(yb + (size_t)ent * DM + col0) = w;
            }
    }
};

constexpr int PH_PER_LAYER = 8, PH_FINAL = 1 + MK_LAYERS * PH_PER_LAYER, N_PHASES = PH_FINAL + 1;

__global__ void __launch_bounds__(NTHR, 2) mega_fwd(Args args_byval) {
    KArgs args = (KArgs)__builtin_amdgcn_kernarg_segment_ptr();
    extern __shared__ __attribute__((aligned(16))) unsigned char lds_raw[];
    LAS unsigned char* lds = (LAS unsigned char*)lds_raw;
    int tid = threadIdx.x, lane = tid & 63, wave = __builtin_amdgcn_readfirstlane(tid >> 6);
    const int G = gridDim.x, bx = blockIdx.x;
    volatile LAS unsigned* MISC = (volatile LAS unsigned*)(lds + MISC_OFF);
    if (tid < 16) MISC[tid] = 0u;
    __syncthreads();
    unsigned* ctl = (unsigned*)(args->ws + WS_CTL);
    XcdBarrier bar; bar.bar = ctl + CW_BAR; bar.x = 0; bar.st = nullptr;
    if (!MK_SPLIT) bar = xcd_barrier_post(ctl + CW_BAR, MISC);
    const int lo = args->ph_lo, hi = args->ph_hi;
#define IN(k) (lo <= (k) && (k) < hi)
#define SEAM(k) do { if (!MK_SPLIT && (k) + 1 < hi) xcd_barrier(bar); } while (0)
    LAS int* rowtab = (LAS int*)(lds + ROWTAB_OFF);

    if (IN(0)) { if (EN(0)) for (int rep = 0; rep < NREP(0); ++rep) prologue(args, lds, tid, lane, wave); }
    if (!MK_SPLIT) xcd_barrier_census(bar);
    if (IN(0)) SEAM(0);

    for (int layer = 0; layer < MK_LAYERS; ++layer) {
        const int kind = layer % 3, base = 1 + layer * PH_PER_LAYER;
        asm volatile("" : "+s"(args));
        tid = threadIdx.x; asm volatile("" : "+v"(tid)); lane = tid & 63; wave = __builtin_amdgcn_readfirstlane(tid >> 6);
        const float* mods_layer = (const float*)(args->ws + WS_MODS) + (size_t)layer * 9 * NMOD;
        bf16* xs = (bf16*)(args->ws + WS_XS);
        if (IN(base + 0)) {
            if (EN(1)) { if (kind == 1) phase_norm1<true>(args, layer, lane, wave); else if (kind == 2) phase_norm1<false>(args, layer, lane, wave); }
            if (kind != 0) SEAM(base + 0);
        }
        if (IN(base + 1)) {
            if (kind == 0) { if (EN(2)) phase_norm1_pooldiff(args, lds, layer, tid, lane, wave); }
            else if (kind == 1) { if (EN(3)) for (int rep = 0; rep < NREP(3); ++rep) phase_s5_scan(args, lds, lane, wave); }
            else if (EN(4)) for (int rep = 0; rep < NREP(4); ++rep) {
                pg8::StaticSchedG S{{(const char*)(args->ws + WS_B1), (const char*)(args->ws + WS_WQKV), (size_t)256 * DM, (size_t)256 * DM, NTILE, 6, NTILE * 6, G, bx, 0, 0}};
                EpiQkv E{(bf16*)(args->ws + WS_B2), (bf16*)(args->ws + WS_KB), (bf16*)(args->ws + WS_VB)};
                pg8::gemm_phase<EpiQkv, pg8::StaticSchedG, true, true>(tid, lds, rowtab, DM / 2, DM / 2, DM / 2, S, E);
            }
            SEAM(base + 1);
        }
        if (IN(base + 2)) {
            if (kind == 0) { if (EN(5)) for (int rep = 0; rep < NREP(5); ++rep) {
                const int j = layer / 3;
                const int pool_skip = (layer == MK_LAYERS - 1) ? 1 : 0, pool_nm = pool_skip ? NTILE - NB : NTILE;
                pg8::StaticSchedG S{{(const char*)(args->ws + WS_B2), (const char*)(args->ws + WS_POOLW) + (size_t)j * 4 * 65536, (size_t)256 * DM, (size_t)256 * 256, pool_nm, 4, pool_nm * 4, G, bx, (size_t)256, pool_skip}};
                EpiResid E{rep + 1 < NREP(5) ? (bf16*)(args->ws + WS_YG) : xs, mods_layer, args->in[I_POOLS] + j * DM, layer == 0 ? args->in[I_X] : nullptr, args->in[I_CTX], layer == 0 ? nullptr : (const bf16*)(args->ws + WS_B1)};
                pg8::gemm_phase<EpiResid, pg8::StaticSchedG, true, true>(tid, lds, rowtab, DM / 2, 128, 128, S, E);
            } } else if (kind == 1) { if (EN(6)) for (int rep = 0; rep < NREP(6); ++rep) phase_s5_readout(args, layer, lane, wave); }
            else { if (EN(7)) phase_qkpost(args, lds, tid, lane, wave); }
            SEAM(base + 2);
        }
        if (IN(base + 3) && kind != 0) {
            if (kind == 1) { if (EN(8)) for (int rep = 0; rep < NREP(8); ++rep) {
                pg8::StaticSchedG S{{(const char*)(args->ws + WS_B2), (const char*)(args->ws + WS_GLUW), (size_t)256 * DM, (size_t)256 * DM, NTILE, 8, NTILE * 8, G, bx, 0, 0}};
                EpiGlu E{rep + 1 < NREP(8) ? (bf16*)(args->ws + WS_YG) : xs, mods_layer, args->in[I_GLUB]};
                pg8::gemm_phase<EpiGlu, pg8::StaticSchedG, true, true>(tid, lds, rowtab, DM / 2, DM / 2, DM / 2, S, E);
            } } else if (EN(9)) for (int rep = 0; rep < NREP(9); ++rep) {
                const bf16* Q = (const bf16*)(args->ws + WS_B2); const unsigned char* Kb = args->ws + WS_B3  ; const unsigned char* Vt = args->ws + WS_YG  ; unsigned char* O = args->ws + WS_B1;
                const int vcu = (G % 8 == 0) ? (bx % 8) * (G / 8) + bx / 8 : bx;
                float gqm = fmaxf(fabsf(args->in[I_QG][lane]), fabsf(args->in[I_QG][lane + 64])), gkm = fmaxf(fabsf(args->in[I_KG][lane]), fabsf(args->in[I_KG][lane + 64]));
#pragma unroll
                for (int o_ = 1; o_ < 64; o_ <<= 1) { gqm = fmaxf(gqm, __shfl_xor(gqm, o_)); gkm = fmaxf(gkm, __shfl_xor(gkm, o_)); }
                const float mnC = __uint_as_float(__builtin_amdgcn_readfirstlane(__float_as_uint(-(128.0f * 1.02f) * gqm * gkm * (att::SCALE * 1.4426950408889634f))));
                for (int u = vcu; u < 1024; u += G) {
                    const int grp = u >> 6, b = grp >> 1, kvh = grp & 1, h = kvh * 4 + ((u & 63) >> 4), qb = u & 15;
                    const size_t qrow = (size_t)b * SEG + CTXL + qb * 256, krow = (size_t)b * SEG;
                    att::attn_dense_body(tid, Q + qrow * DM + h * 128, Kb + krow * 256 + kvh * 128, Vt + (size_t)(b * 2 + kvh) * 68 * att::V8T_TILE_, O + qrow * DM + h * 128, SEG, (char*)lds_raw, args->in[I_QG], (const f32x2*)(args->ws + WS_ROPE), qb * 256, mnC);
                }
                if constexpr (MK_LAYERS > 4) if (MK_LAYERS - layer > 2) for (int u = vcu; u < 64; u += G) {
                    const int b = u >> 3, h = u & 7, kvh = h >> 2;
                    const size_t qrow = (size_t)b * SEG;
                    att::attn_dense_body(tid, Q + qrow * DM + h * 128, Kb + qrow * 256 + kvh * 128, Vt + (size_t)(b * 2 + kvh) * 68 * att::V8T_TILE_, O + qrow * DM + h * 128, CTXL, (char*)lds_raw, args->in[I_QG], (const f32x2*)(args->ws + WS_ROPE), -1, mnC);
                }
            }
            SEAM(base + 3);
        }
        if (IN(base + 4) && kind == 2) { if (EN(10)) for (int rep = 0; rep < NREP(10); ++rep) {
            pg8::StaticSchedG S{{(const char*)(args->ws + WS_B1), (const char*)(args->ws + WS_WO), (size_t)256 * DM, (size_t)256 * DM, 128, 4, 128 * 4, G, bx, 0, 1}};
            EpiResid E{rep + 1 < NREP(10) ? (bf16*)(args->ws + WS_YG) : xs, mods_layer, nullptr, nullptr, nullptr, nullptr};
            pg8::gemm_phase<EpiResid, pg8::StaticSchedG, true, true>(tid, lds, rowtab, DM / 2, DM / 2, DM / 2, S, E); }
            SEAM(base + 4);
        }
        if (IN(base + 5)) { if (EN(11)) phase_router(args, lds, layer, tid, lane, wave); SEAM(base + 5); }
        if (IN(base + 6) || IN(base + 7)) {
            const unsigned* cnt = (const unsigned*)(args->ws + WS_CTL) + CW_CNT + layer * 32;
            const int cntl = (int)__hip_atomic_load(cnt + (lane & 31), __ATOMIC_RELAXED, __HIP_MEMORY_SCOPE_AGENT);
            const int nrb = (cntl + 255) >> 8;
            int incl = nrb;
#pragma unroll
            for (int o = 1; o < 32; o <<= 1) { const int t = __shfl_up(incl, o, 32); if ((lane & 31) >= o) incl += t; }
            const int pbl = incl - nrb, TB = __builtin_amdgcn_readlane(incl, 31);
            if (IN(base + 6)) { if (EN(12)) for (int rep = 0; rep < NREP(12); ++rep) {
                pg8::MoeSched<1> S{(const char*)(args->ws + WS_B3F), (const char*)(args->ws + WS_W1T) + (size_t)layer * 32 * 2048 * 1024, 0, (size_t)256 * DM, (size_t)2048 * 1024,
                                (const int*)(args->ws + WS_LIST), (const float*)(args->ws + WS_GATE), args->in[I_B1] + (size_t)layer * 32 * 2048, 8, TB * 8, G, bx, pbl, cntl};
                EpiMoe1 E{args->ws + WS_ACT};
                pg8::gemm_phase<EpiMoe1, pg8::MoeSched<1>, true, MOE1_FMT>(tid, lds, rowtab, DM / 2, DM / 2, DM / 2, S, E); }
                if (MK_PROBE_NULL) {
                    pg8::MoeSched<1> S{(const char*)(args->ws + WS_B3F), (const char*)(args->ws + WS_W1T) + (size_t)layer * 32 * 2048 * 1024, 0, (size_t)256 * DM, (size_t)2048 * 1024,
                                    (const int*)(args->ws + WS_LIST), (const float*)(args->ws + WS_GATE), args->in[I_B1] + (size_t)layer * 32 * 2048, 8, TB * 8, G, bx, pbl, cntl};
                    EpiNull E{(float*)(args->ws + WS_YG)};
                    pg8::gemm_phase<EpiNull, pg8::MoeSched<1>, true, MOE1_FMT>(tid, lds, rowtab, DM / 2, DM / 2, DM / 2, S, E);
                }
                SEAM(base + 6);
            }
            if (IN(base + 7)) { if (EN(13)) for (int rep = 0; rep < NREP(13); ++rep) {
                pg8::MoeSched<2> S{(const char*)(args->ws + WS_ACT), (const char*)(args->ws + WS_W2T) + (size_t)layer * 32 * 1024 * 1024, (size_t)256 * DFF, (size_t)256 * DFF, (size_t)1024 * 1024,
                                (const int*)(args->ws + WS_LIST), (const float*)(args->ws + WS_GATE), args->in[I_B2] + (size_t)layer * 32 * DM, 4, TB * 4, G, bx, pbl, cntl};
                EpiMoe2 E{args->ws + WS_YB};
                pg8::gemm_phase<EpiMoe2, pg8::MoeSched<2>, true, true>(tid, lds, rowtab, DFF / 2, DFF / 2, DFF / 2, S, E); }
                SEAM(base + 7);
            }
        }
    }
    if (IN(PH_FINAL)) { if (EN(14)) phase_final(args, lane, wave); }
#undef IN
#undef SEAM
}

extern "C" void kernel_launch(void* const* d_in, const int* in_sizes, int n_in, void* d_out, int out_size, void* d_ws, size_t ws_size, hipStream_t stream) {
    static int grid = 0;
    if (grid == 0) {
        if (n_in != N_IN || out_size != NB * SEQ * DM || ws_size < WS_END) { fprintf(stderr, "kernel_launch: shape/workspace mismatch: n_in %d out %d ws %zu (need %zu)\n", n_in, out_size, ws_size, (size_t)WS_END); grid = -1; return; }
        int dev = 0, cus = 0, per_cu = 0;
        if (hipGetDevice(&dev) != hipSuccess || hipDeviceGetAttribute(&cus, hipDeviceAttributeMultiprocessorCount, dev) != hipSuccess) { grid = -1; return; }
        if (hipFuncSetAttribute((const void*)mega_fwd, hipFuncAttributeMaxDynamicSharedMemorySize, LDS_BYTES) != hipSuccess) { fprintf(stderr, "kernel_launch: hipFuncSetAttribute failed\n"); grid = -1; return; }
        if (hipOccupancyMaxActiveBlocksPerMultiprocessor(&per_cu, (const void*)mega_fwd, NTHR, LDS_BYTES) != hipSuccess || per_cu < 1) { fprintf(stderr, "kernel_launch: occupancy query reports %d blocks per CU\n", per_cu); }
        (void)hipGetLastError();
        grid = cus;
        if (grid > 256) grid = 256;
    }
    if (grid < 0) return;
    (void)hipMemsetAsync((char*)d_ws + WS_CTL, 0, 65536, stream);
    Args a{};
    for (int i = 0; i < N_IN; ++i) a.in[i] = (const float*)d_in[i];
    a.out = (float*)d_out; a.ws = (unsigned char*)d_ws;
#if MK_SPLIT
    for (int p = 0; p < N_PHASES; ++p) { a.ph_lo = p; a.ph_hi = p + 1; hipLaunchKernelGGL(mega_fwd, dim3(grid), dim3(NTHR), LDS_BYTES, stream, a); }
#else
    a.ph_lo = 0; a.ph_hi = N_PHASES;
    hipLaunchKernelGGL(mega_fwd, dim3(grid), dim3(NTHR), LDS_BYTES, stream, a);
#endif
    const hipError_t le = hipPeekAtLastError();
    if (le != hipSuccess) fprintf(stderr, "kernel_launch: launch failed: %s\n", hipGetErrorName(le));
}
```

```cpp
#include <hip/hip_runtime.h>
#include <cstdio>
#include <cstdint>

#ifndef MK_SPLIT
#define MK_SPLIT 0
#endif
#ifndef MK_LAYERS
#define MK_LAYERS 4
#endif
#ifndef MK_EN
#define MK_EN 0xFFFFF
#endif
#define EN(n) ((MK_EN >> (n)) & 1)
#ifndef MK_REP
#define MK_REP 0
#endif
#ifndef MK_PROBE_NULL
#define MK_PROBE_NULL 0
#endif
#define NREP(n) (1 + ((MK_REP >> (n)) & 1))

#define GAS __attribute__((address_space(1)))
#define LAS __attribute__((address_space(3)))
typedef unsigned short bf16;
typedef float f32x4 __attribute__((ext_vector_type(4)));
typedef float f32x2 __attribute__((ext_vector_type(2)));
typedef float f32x16 __attribute__((ext_vector_type(16)));
typedef float f32x8 __attribute__((ext_vector_type(8)));
typedef short bf16x8 __attribute__((ext_vector_type(8)));
typedef short s16x4 __attribute__((ext_vector_type(4)));
typedef unsigned u32x4 __attribute__((ext_vector_type(4)));
typedef unsigned u32x2 __attribute__((ext_vector_type(2)));
typedef int v8i __attribute__((ext_vector_type(8)));
typedef int v4i __attribute__((ext_vector_type(4)));
constexpr float W8_SCALE = 32.0f;
constexpr float Y8_SCALE = 8.0f;

constexpr int DM = 1024, NB = 8, SEQ = 4096, CTXL = 256, SEG = SEQ + CTXL  , NR = NB * SEG  , NTILE = NR / 256  ;
constexpr int NE = 32, TOPK = 4, DFF = 1024, NMOD = 6 * DM;
constexpr int CAPROWS = NR * TOPK + NE * 256;
constexpr float NORM_EPS = 1e-6f;
constexpr int NWAVES = 8, NTHR = 512;

enum { I_X = 0, I_C, I_CTX, I_CCTX, I_ADAW, I_ADAB, I_N1G, I_N2G, I_POOLW, I_POOLS, I_LAMRE, I_LAMIM, I_LOGDT, I_BRE, I_BIM, I_CRE, I_CIM, I_SSMD, I_GLUW, I_GLUB,
       I_WQKV, I_QG, I_KG, I_WO, I_RW, I_RB, I_W1, I_B1, I_W2, I_B2, N_IN };

constexpr size_t al256(size_t x) { return (x + 255) & ~(size_t)255; }
constexpr size_t WS_CTL = 0, CTL_BYTES = 1u << 20;
constexpr size_t WS_MODS = WS_CTL + CTL_BYTES;
constexpr size_t WS_ROPE = al256(WS_MODS + (size_t)4 * 9 * NMOD * 4);
constexpr size_t WS_S5LAM = al256(WS_ROPE + 64 * 32 * 8);
constexpr size_t WS_S5BF = al256(WS_S5LAM + 2 * 64 * 64 * 8);
constexpr size_t WS_S5CF = al256(WS_S5BF + (size_t)2 * 64 * 4 * 64 * 16);
constexpr size_t WS_RT = al256(WS_S5CF + (size_t)2 * 64 * 4 * 64 * 16);
constexpr size_t WS_POOLW = al256(WS_RT + (size_t)4 * 32 * 1024 * 4);
constexpr size_t WS_GLUW = al256(WS_POOLW + (size_t)2 * 4 * 256 * 256 * 2);
constexpr size_t WS_WQKV = al256(WS_GLUW + (size_t)2048 * 1024 * 2);
constexpr size_t WS_WO = al256(WS_WQKV + (size_t)1536 * 1024 * 2);
constexpr size_t WS_GATE = al256(WS_WO + (size_t)1024 * 1024 * 2);
constexpr size_t WS_LIST = al256(WS_GATE + (size_t)32 * NR * 4);
constexpr size_t WS_XS = al256(WS_LIST + (size_t)32 * NR * 4);
constexpr size_t WS_B1 = al256(WS_XS + (size_t)NR * DM * 4);
constexpr size_t WS_B2 = al256(WS_B1 + (size_t)NR * DM * 2);
constexpr size_t WS_B3 = al256(WS_B2 + (size_t)NR * DM * 2);
constexpr size_t WS_KB = al256(WS_B3 + (size_t)NR * DM * 2);
constexpr size_t WS_VB = al256(WS_KB + (size_t)NR * 256 * 2);
constexpr size_t WS_YG = al256(WS_VB + (size_t)NR * 256 * 2);
constexpr size_t WS_ACT = al256(WS_YG + (size_t)2 * NR * DM * 4);
constexpr size_t WS_YB = al256(WS_ACT + (size_t)CAPROWS * DFF * 2);
constexpr size_t WS_B3F = al256(WS_YB + (size_t)(NR * 4 + 1) * DM * 2);
constexpr size_t WS_W1T = al256(WS_B3F + (size_t)NR * DM);
constexpr size_t WS_W2T = al256(WS_W1T + (size_t)4 * 32 * 2048 * 1024);
constexpr size_t WS_END = al256(WS_W2T + (size_t)4 * 32 * 1024 * 1024);

constexpr int CW_CNT = 64;
constexpr int CW_BAR = 4096;

constexpr int RING_BYTES = 131072;
constexpr int ROWTAB_OFF = RING_BYTES;
constexpr int RSCR_OFF = 132096;
constexpr int LDS_BYTES = 147456;
constexpr int MISC_OFF = LDS_BYTES - 64;
constexpr int RPB_MAX = 280;
constexpr int RPART_OFF = RSCR_OFF + RPB_MAX * 4 * 8 + 3 * 32 * 4 + 64;
static_assert(RPART_OFF + 16 * 64 * 4 <= MISC_OFF, "LDS map");

__device__ __forceinline__ unsigned cvt_pk_bf16(float lo, float hi) { unsigned r; asm volatile("v_cvt_pk_bf16_f32 %0, %1, %2" : "=v"(r) : "v"(lo), "v"(hi)); return r; }
__device__ __forceinline__ unsigned cvt_pk4_fp8(float a, float b, float c, float d) { unsigned w = 0; w = __builtin_amdgcn_cvt_pk_fp8_f32(a, b, w, false); w = __builtin_amdgcn_cvt_pk_fp8_f32(c, d, w, true); return w; }
__device__ __forceinline__ float bf_lo(unsigned w) { return __uint_as_float(w << 16); }
__device__ __forceinline__ float bf_hi(unsigned w) { return __uint_as_float(w & 0xffff0000u); }
__device__ __forceinline__ float wave_sum(float v) {
#pragma unroll
    for (int o = 1; o < 64; o <<= 1) v += __shfl_xor(v, o);
    return v;
}
__device__ __forceinline__ float sigmoidf_(float x) { return 1.0f / (1.0f + __expf(-x)); }
#define LDS_WAIT() asm volatile("s_waitcnt lgkmcnt(0)" ::: "memory")
#define VM_WAIT() asm volatile("s_waitcnt vmcnt(0)" ::: "memory")

#define XB_TMO      128
#define XB_XCNT(j)  (256  + 64 * (j))
#define XB_XSUB(j)  (1280 + 64 * (j))
#define XB_XGEN(j)  (2304 + 64 * (j))
#define XB_TOP      3328
#define XB_TOPGEN   3392
#define XCD_BAR_WORDS 3456
#define XB_SPIN_CAP (1u << 18)
__device__ __forceinline__ unsigned xb_ld(unsigned* p)              { return __hip_atomic_load(p, __ATOMIC_RELAXED, __HIP_MEMORY_SCOPE_AGENT); }
__device__ __forceinline__ unsigned xb_add(unsigned* p, unsigned v) { return __hip_atomic_fetch_add(p, v, __ATOMIC_RELAXED, __HIP_MEMORY_SCOPE_AGENT); }
__device__ __forceinline__ unsigned xb_xcc_id() { return (unsigned)__builtin_amdgcn_s_getreg((3 << 11) | 20) & 0xFu; }
#define XB_SPIN(cond, bar) do { unsigned _sp = 0; while (cond) { __builtin_amdgcn_s_sleep(1); \
    if ((++_sp & 255u) == 0u) { if (xb_ld(&(bar)[XB_TMO])) break; if (_sp > XB_SPIN_CAP) { atomicAdd(&(bar)[XB_TMO], 1u); break; } } } } while (0)
struct XcdBarrier { unsigned* bar; unsigned x; volatile LAS unsigned* st; };
__device__ __forceinline__ XcdBarrier xcd_barrier_post(unsigned* bar, volatile LAS unsigned* st) {
    XcdBarrier b; b.bar = bar; b.x = xb_xcc_id(); b.st = st;
    if (threadIdx.x == 0) (void)xb_add(&bar[XB_XCNT(b.x)], 1u);
    return b;
}
__device__ __forceinline__ void xcd_barrier_complete(unsigned* bar, unsigned x, unsigned& nloc, unsigned& nx) {
    const unsigned G = gridDim.x * gridDim.y * gridDim.z;
    unsigned sum, cnt, mine, sp = 0u;
    for (;;) {
        sum = 0u; cnt = 0u; mine = 0u;
#pragma unroll
        for (unsigned j = 0; j < 16; ++j) { const unsigned c = xb_ld(&bar[XB_XCNT(j)]); sum += c; cnt += (c > 0u) ? 1u : 0u; mine = (j == x) ? c : mine; }
        if (sum == G) break;
        __builtin_amdgcn_s_sleep(1);
        if ((++sp & 255u) == 0u) { if (xb_ld(&bar[XB_TMO])) break; if (sp > XB_SPIN_CAP) { atomicAdd(&bar[XB_TMO], 1u); break; } }
    }
    nloc = mine > 0u ? mine : 1u; nx = cnt > 0u ? cnt : 1u;
}
__device__ __forceinline__ void xcd_barrier_census(const XcdBarrier& b) {
    if (threadIdx.x == 0) { unsigned nloc, nx; xcd_barrier_complete(b.bar, b.x, nloc, nx); b.st[0] = nloc; b.st[1] = nx; }
}
__device__ __forceinline__ void xcd_barrier(const XcdBarrier& b) {
    asm volatile("s_waitcnt vmcnt(0)" ::: "memory");
    __syncthreads();
    if (threadIdx.x == 0) {
        unsigned* bar = b.bar; asm volatile("" : "+s"(bar));
        __builtin_amdgcn_s_waitcnt(0);
        unsigned nloc = b.st[0], nx = b.st[1];
        const unsigned old = xb_add(&bar[XB_XSUB(b.x)], 1u);
        const unsigned gen = old / nloc;
        if (old + 1u == (gen + 1u) * nloc) {
            __builtin_amdgcn_fence(__ATOMIC_RELEASE, "agent");
            asm volatile("s_waitcnt vmcnt(0)" ::: "memory");
            const unsigned og = xb_add(&bar[XB_TOP], 1u);
            const unsigned tg = og / nx;
            if (og + 1u == (tg + 1u) * nx) xb_add(&bar[XB_TOPGEN], 1u);
            else XB_SPIN(xb_ld(&bar[XB_TOPGEN]) == tg, bar);
            __builtin_amdgcn_fence(__ATOMIC_ACQUIRE, "agent");
            xb_add(&bar[XB_XGEN(b.x)], 1u);
            asm volatile("s_waitcnt vmcnt(0)" ::: "memory");
        } else {
            XB_SPIN(xb_ld(&bar[XB_XGEN(b.x)]) == gen, bar);
            __builtin_amdgcn_fence(__ATOMIC_ACQUIRE, "agent");
            asm volatile("s_waitcnt vmcnt(0)" ::: "memory");
        }
    }
    __syncthreads();
}

namespace pg8 {
constexpr int BM = 256, BK = 64, HALF = 128, HTB = HALF * BK * 2, STAGE_BYTES = 8 * HTB, NXCD = 8;
__device__ __forceinline__ int lds_byte(int r, int c) { const int st = (r >> 4) * 2 + (c >> 5), rr = r & 15, cc = c & 31, ob = rr * 64 + cc * 2; return st * 1024 + (ob ^ (((ob >> 9) & 1) << 5)); }
__device__ __forceinline__ void stage_rc(int b, int& R, int& C) { const int st = b / 1024, sb = b % 1024, swz = sb ^ (((sb >> 9) & 1) << 5); R = (st >> 1) * 16 + swz / 64; C = (st & 1) * 32 + (swz % 64) / 2; }
__device__ __forceinline__ int perm32(int rho) { const int n = rho >> 4, i = rho & 15; return 8 * (i >> 2) + 4 * n + (i & 3); }

struct Unit { int pm, pn, e, rb, cnt; };

__device__ __forceinline__ int xcd_remap(int L, int nwg) { const int q = nwg / NXCD, r = nwg % NXCD, xcd = L % NXCD, off = L / NXCD; return (xcd < r ? xcd * (q + 1) : r * (q + 1) + (xcd - r) * q) + off; }

template <class Epi, class Sched, bool GATHER, int FP8 = 0>
__device__ __forceinline__ void gemm_phase(const int tid, LAS unsigned char* lds, LAS int* rowtab, const int lda, const int ldb, const int K, const Sched& S, const Epi& E) {
    const int wid = __builtin_amdgcn_readfirstlane(tid >> 6), lane = tid & 63, wr = wid >> 2, wc = wid & 3, fr = lane & 15, fq = lane >> 4;
    int nt = K / BK;
    if (K <= 2 * BK) asm volatile("" : "+s"(nt));
    int Rr[2], Cc[2];
    constexpr int PM = (int)Epi::PERM;
    unsigned voffB[2][2];
#pragma unroll
    for (int i = 0; i < 2; ++i) { stage_rc(tid * 16 + i * 8192, Rr[i], Cc[i]);
        if constexpr (PM == 2) { const int p = perm32(Rr[i] & 31);
#pragma unroll
            for (int bj = 0; bj < 2; ++bj) voffB[bj][i] = (unsigned)((64 * (Rr[i] >> 5) + 16 * (p >> 3) + 8 * bj + (p & 7)) * ldb + Cc[i]) * 2u; }
        else { const int Rb = PM ? ((Rr[i] & ~31) + perm32(Rr[i] & 31)) : Rr[i]; voffB[0][i] = voffB[1][i] = (unsigned)(Rb * ldb + Cc[i]) * 2u; } }
    const size_t kstep = (size_t)(BK * 2);
    const size_t hstepA = GATHER ? 0 : (size_t)HALF * lda * 2, hstepB = PM == 2 ? 0 : (size_t)HALF * ldb * 2;
    const unsigned ldsw = (unsigned)wid * 1024u;
    const int aoff = lds_byte(wr * 64 + fr, fq * 8), boff = lds_byte(wc * 32 + fr, fq * 8);
#define PG8_SA(b, h) (((b) * 2 + (h)) * HTB)
#define PG8_SB(b, h) ((4 + (b) * 2 + (h)) * HTB)
#define PG8_STAGE(bufoff, gbase, voff) do { _Pragma("unroll") for (int _i = 0; _i < 2; ++_i) \
        __builtin_amdgcn_global_load_lds((const unsigned*)((const char*)(gbase) + (voff)[_i]), (LAS unsigned*)(lds + (bufoff) + ldsw + _i * 8192), 16, 0, 0); } while (0)
#define PG8_LDA(dst, b, h) do { _Pragma("unroll") for (int m = 0; m < 4; ++m) _Pragma("unroll") for (int k = 0; k < 2; ++k) dst[m][k] = *(const LAS bf16x8*)(lds + PG8_SA(b, h) + aoff + m * 2048 + k * 1024); } while (0)
#define PG8_LDB(dst, b, h) do { _Pragma("unroll") for (int n = 0; n < 2; ++n) _Pragma("unroll") for (int k = 0; k < 2; ++k) dst[n][k] = *(const LAS bf16x8*)(lds + PG8_SB(b, h) + boff + n * 2048 + k * 1024); } while (0)
#define PG8_MMA(ai, bj, At, Bt) do { __builtin_amdgcn_s_setprio(1); _Pragma("unroll") for (int m = 0; m < 4; ++m) _Pragma("unroll") for (int n = 0; n < 2; ++n) { \
        if constexpr (FP8) { const v8i bv_ = __builtin_shufflevector(__builtin_bit_cast(v4i, Bt[n][0]), __builtin_bit_cast(v4i, Bt[n][1]), 0, 1, 2, 3, 4, 5, 6, 7); \
                             const v8i av_ = __builtin_shufflevector(__builtin_bit_cast(v4i, At[m][0]), __builtin_bit_cast(v4i, At[m][1]), 0, 1, 2, 3, 4, 5, 6, 7); \
                             if constexpr (FP8 == 2) acc[ai][bj][m][n] = __builtin_amdgcn_mfma_scale_f32_16x16x128_f8f6f4(bv_, av_, acc[ai][bj][m][n], 2, 2, 0, bv_[6], 0, av_[6]); \
                             else acc[ai][bj][m][n] = __builtin_amdgcn_mfma_scale_f32_16x16x128_f8f6f4(bv_, av_, acc[ai][bj][m][n], 0, 0, 0, scale_w, 0, scale_x); } \
        else { _Pragma("unroll") for (int k = 0; k < 2; ++k) acc[ai][bj][m][n] = __builtin_amdgcn_mfma_f32_16x16x32_bf16(Bt[n][k], At[m][k], acc[ai][bj][m][n], 0, 0, 0); } } \
        __builtin_amdgcn_s_setprio(0); } while (0)
#define PG8_WAIT_V(n) asm volatile("s_waitcnt vmcnt(" #n ")" ::: "memory")
#define PG8_WAIT_L(n) asm volatile("s_waitcnt lgkmcnt(" #n ")" ::: "memory")
#define PG8_BAR __builtin_amdgcn_s_barrier()
#define PG8_SCHED __builtin_amdgcn_sched_barrier(0)
    Unit cur, nxt; int ui = 0;
    if (!S.next(0, cur)) return;
    int scale_w = 0x7A7A7A7A, scale_x = 0x7F7F7F7F; asm volatile("" : "+v"(scale_w), "+v"(scale_x));
    unsigned vA[2][2];
    constexpr int NTAB = Sched::NTAB;
    if constexpr (NTAB > 0) {
        if (tid < 256) {
#pragma unroll
            for (int sl = 0; sl < 3; ++sl) if (NTAB & (1 << sl)) rowtab[sl * 256 + tid] = (int)*S.tab_src(cur, sl, tid);
        }
        LDS_WAIT(); __syncthreads();
    }
    if constexpr (GATHER) {
#pragma unroll
        for (int h = 0; h < 2; ++h)
#pragma unroll
            for (int i = 0; i < 2; ++i) vA[h][i] = (unsigned)(S.a_rowidx(cur, rowtab, h * 128 + Rr[i]) * lda + Cc[i]) * 2u;
    } else {
#pragma unroll
        for (int h = 0; h < 2; ++h)
#pragma unroll
            for (int i = 0; i < 2; ++i) vA[h][i] = (unsigned)(Rr[i] * lda + Cc[i]) * 2u;
    }
    bf16x8 At[4][2], B0[2][2], B1[2][2];
    const char* cA = S.a_base(cur); const char* cB = S.b_base(cur);
    PG8_STAGE(PG8_SB(0, 0), cB, voffB[0]); PG8_STAGE(PG8_SB(0, 1), cB + hstepB, voffB[1]); PG8_STAGE(PG8_SA(0, 0), cA, vA[0]); PG8_STAGE(PG8_SA(0, 1), cA + hstepA, vA[1]);
    if (wr == 1) PG8_BAR;
    PG8_WAIT_V(2); PG8_BAR;
    PG8_STAGE(PG8_SB(1, 0), cB + kstep, voffB[0]); PG8_STAGE(PG8_SA(1, 0), cA + kstep, vA[0]); PG8_STAGE(PG8_SB(1, 1), cB + hstepB + kstep, voffB[1]);
    PG8_WAIT_V(6); PG8_BAR;
    for (;;) {
        f32x4 acc[2][2][4][2];
#pragma unroll
        for (int a = 0; a < 2; ++a)
#pragma unroll
            for (int b = 0; b < 2; ++b)
#pragma unroll
                for (int m = 0; m < 4; ++m)
#pragma unroll
                    for (int n = 0; n < 2; ++n) acc[a][b][m][n] = (f32x4){0.f, 0.f, 0.f, 0.f};
        const bool has_next = S.next(ui + 1, nxt);
        const char* nA = has_next ? S.a_base(nxt) : cA; const char* nB = has_next ? S.b_base(nxt) : cB;
        if constexpr (NTAB > 0) {
            if (has_next && tid < 256) {
#pragma unroll
                for (int sl = 0; sl < 3; ++sl) if (NTAB & (1 << sl))
                    __builtin_amdgcn_global_load_lds(S.tab_src(nxt, sl, tid), (LAS unsigned*)((LAS unsigned char*)rowtab + (((ui + 1) % 3) * 3072) + sl * 1024 + wid * 256), 4, 0, 0);
            }
        }
#pragma nounroll
        for (int t = 0; t < nt; t += 2) {
            const bool last = (t == nt - 2);
            if constexpr (PM == 2) asm volatile("" : "+v"(voffB[1][0]), "+v"(voffB[1][1])); else { voffB[1][0] = voffB[0][0]; voffB[1][1] = voffB[0][1]; }
            asm volatile("" : "+v"(vA[0][0]), "+v"(vA[0][1]), "+v"(vA[1][0]), "+v"(vA[1][1]), "+v"(voffB[0][0]), "+v"(voffB[0][1]));
            const char* a1 = cA + (size_t)(t + 1) * kstep;
            const char* a2 = last ? nA : cA + (size_t)(t + 2) * kstep; const char* b2 = last ? nB : cB + (size_t)(t + 2) * kstep;
            const char* a3 = a2 + kstep; const char* b3 = b2 + kstep;
            PG8_LDB(B0, 0, 0); PG8_LDB(B1, 0, 1); PG8_SCHED; PG8_LDA(At, 0, 0); PG8_STAGE(PG8_SA(1, 1), a1 + hstepA, vA[1]);
            if constexpr (GATHER) {
                if (last && has_next) {
                    LAS int* rt = rowtab + ((ui + 1) % 3) * 768;
#pragma unroll
                    for (int h = 0; h < 2; ++h)
#pragma unroll
                        for (int i = 0; i < 2; ++i) vA[h][i] = (unsigned)(S.a_rowidx(nxt, rt, h * 128 + Rr[i]) * lda + Cc[i]) * 2u;
                }
            }
            PG8_WAIT_V(8); PG8_WAIT_L(0); PG8_BAR; PG8_MMA(0, 0, At, B0); PG8_MMA(0, 1, At, B1); PG8_BAR; PG8_SCHED;
            PG8_LDA(At, 0, 1); PG8_STAGE(PG8_SB(0, 0), b2, voffB[0]); PG8_STAGE(PG8_SB(0, 1), b2 + hstepB, voffB[1]); PG8_STAGE(PG8_SA(0, 0), a2, vA[0]);
            PG8_WAIT_V(8); PG8_WAIT_L(0); PG8_BAR; PG8_MMA(1, 0, At, B0); PG8_MMA(1, 1, At, B1); PG8_BAR; PG8_SCHED;
            PG8_LDB(B0, 1, 0); PG8_LDB(B1, 1, 1); PG8_SCHED; PG8_LDA(At, 1, 0); PG8_STAGE(PG8_SA(0, 1), a2 + hstepA, vA[1]);
            PG8_WAIT_V(8); PG8_WAIT_L(0); PG8_BAR; PG8_MMA(0, 0, At, B0); PG8_MMA(0, 1, At, B1); PG8_BAR; PG8_SCHED;
            PG8_LDA(At, 1, 1); PG8_STAGE(PG8_SB(1, 0), b3, voffB[0]); PG8_STAGE(PG8_SB(1, 1), b3 + hstepB, voffB[1]); PG8_STAGE(PG8_SA(1, 0), a3, vA[0]);
            PG8_WAIT_V(8); PG8_WAIT_L(0); PG8_BAR; PG8_MMA(1, 0, At, B0); PG8_MMA(1, 1, At, B1); PG8_BAR; PG8_SCHED;
        }
        if (wr == 0) PG8_BAR;
        { int fr_ = fr, fq_ = fq; asm volatile("" : "+v"(fr_), "+v"(fq_));
          E(acc, cur, wr, wc, fr_, fq_, rowtab + (ui % 3) * 768); }
        if (!has_next) break;
        cur = nxt; cA = nA; cB = nB; ++ui;
        if (wr == 1) PG8_BAR;
    }
    PG8_WAIT_V(0);
    PG8_BAR;
#undef PG8_SA
#undef PG8_SB
#undef PG8_STAGE
#undef PG8_LDA
#undef PG8_LDB
#undef PG8_MMA
#undef PG8_WAIT_V
#undef PG8_WAIT_L
#undef PG8_BAR
#undef PG8_SCHED
}

struct StaticSched {
    const char* A; const char* B; size_t atile, btile; int nM, nN, nwg, G, c;
    size_t acol; int skipctx;
    __device__ __forceinline__ bool next(int i, Unit& u) const {
        const int L = i * G + c; if (L >= nwg) return false;
        const int wgid = xcd_remap(L, nwg);
        constexpr int WGM = 8;
        const int nig = WGM * nN, gid = wgid / nig, fm = gid * WGM, gsz = (nM - fm) < WGM ? (nM - fm) : WGM;
        const int pm0 = fm + ((wgid % nig) % gsz); u.pm = pm0 + skipctx * ((pm0 >> 4) + 1); u.pn = (wgid % nig) / gsz; u.e = 0; u.rb = 0; u.cnt = 0; return true;
    }
    __device__ __forceinline__ const char* a_base(const Unit& u) const { return A + (size_t)u.pm * atile + (size_t)u.pn * acol; }
    __device__ __forceinline__ const char* b_base(const Unit& u) const { return B + (size_t)u.pn * btile; }
    static constexpr int NTAB = 0;
    __device__ __forceinline__ const unsigned* tab_src(const Unit&, int, int) const { return nullptr; }
    __device__ __forceinline__ int a_rowidx(const Unit&, const LAS int*, int) const { return 0; }
};
struct StaticSchedG : StaticSched {
    __device__ __forceinline__ const char* a_base(const Unit& u) const { return A + (size_t)u.pn * acol; }
    __device__ __forceinline__ int a_rowidx(const Unit& u, const LAS int*, int rl) const { return u.pm * 256 + rl; }
};

template <int KIND>
struct MoeSched {
    static constexpr int NTAB = KIND == 1 ? 0x5 : 0x7;
    const char* A; const char* B; size_t atile, btile, bexp; const int* list; const float* glist; const float* bias; int NPN, U, G, c; int pbl, cntl;
    __device__ __forceinline__ bool next(int i, Unit& u) const {
        const int L = i * G + c; if (L >= U) return false;
        const int idx = xcd_remap(L, U);
        const int rbg = idx / NPN; u.pn = idx % NPN; u.pm = rbg;
        const unsigned long long m = __ballot(pbl <= rbg);
        const int e = __builtin_popcount((unsigned)(m & 0xffffffffull)) - 1;
        u.e = e; u.rb = rbg - __builtin_amdgcn_readlane(pbl, e); u.cnt = __builtin_amdgcn_readlane(cntl, e); return true;
    }
    __device__ __forceinline__ const char* a_base(const Unit& u) const { return A; }
    __device__ __forceinline__ int a_rowidx(const Unit& u, const LAS int* tab, int rl) const { return KIND == 1 ? (tab[rl] >> 2) : u.pm * 256 + rl; }
    __device__ __forceinline__ const char* b_base(const Unit& u) const { return B + (size_t)u.e * bexp + (size_t)u.pn * btile; }
    __device__ __forceinline__ const unsigned* tab_src(const Unit& u, int sl, int t) const {
        if (sl == 2) { const int col = KIND == 1 ? ((t >> 7) * DFF + u.pn * 128 + (t & 127)) : (u.pn * 256 + t); return (const unsigned*)(bias + (size_t)u.e * (KIND == 1 ? 2 * DFF : DM) + col); }
        int idx = u.rb * 256 + t; idx = idx < u.cnt ? idx : u.cnt - 1;
        return (sl == 0 ? (const unsigned*)list : (const unsigned*)glist) + (size_t)u.e * NR + idx;
    }
};
}

namespace att {
constexpr int D = 128, NW = 8, QBLK = 32, KVBLK = 64;
constexpr float SCALE = 0.088388347648318440f;
constexpr float THR = 8.f;
constexpr int LDQ = 1024, LDK = 256, LDO = 1024;
constexpr int V8T_TILE_ = 128 * 64;
#ifndef ATT_NS
#define ATT_NS 6
#endif
constexpr int NS = ATT_NS, SLOT = 16384;
#ifndef ATT_SDEPTH
#define ATT_SDEPTH 1
#endif
constexpr int SDEPTH = ATT_SDEPTH;
constexpr size_t SHM_V = KVBLK * D * 2, SHM_K = KVBLK * D * 2, SHM_ATTN = 2 * SHM_V + 2 * SHM_K + NW * 64 * 4;
#define KSWZ(row, colB) ((row) * 256 + ((colB) ^ (((row) & 7) << 4)))
#define SBAR() __builtin_amdgcn_sched_barrier(0)
__device__ __forceinline__ int crow(int r, int hi) { return (r & 3) + 8 * (r >> 2) + 4 * hi; }
__device__ __forceinline__ unsigned cvtpk(float lo, float hi) { unsigned r; asm volatile("v_cvt_pk_bf16_f32 %0, %1, %2" : "=v"(r) : "v"(lo), "v"(hi)); return r; }
__device__ __forceinline__ bf16x8 ld8(const bf16* p) { return *reinterpret_cast<const bf16x8*>(p); }
__device__ __forceinline__ void partialSM(f32x16& p0, f32x16& p1, float& m_reg, float& mn, float& alpha) {
  constexpr float C = SCALE * 1.4426950408889634f;
  float pmax = p0[0]; for (int r = 1; r < 16; ++r) pmax = fmaxf(pmax, p0[r]); for (int r = 0; r < 16; ++r) pmax = fmaxf(pmax, p1[r]);
  { auto rr = __builtin_amdgcn_permlane32_swap(__float_as_uint(pmax), __float_as_uint(pmax), false, false);
    pmax = fmaxf(__uint_as_float(rr[0]), __uint_as_float(rr[1])); }
  if (__builtin_expect(__all(pmax - m_reg <= THR / SCALE), 1)) { mn = m_reg; alpha = 1.f; }
  else { mn = fmaxf(m_reg, pmax); alpha = __builtin_amdgcn_exp2f((m_reg - mn) * C); m_reg = mn; }
  float mnC = -mn * C;
  for (int r = 0; r < 16; ++r) p0[r] = fmaf(p0[r], C, mnC); for (int r = 0; r < 16; ++r) p1[r] = fmaf(p1[r], C, mnC);
  for (int r = 0; r < 16; ++r) p0[r] = __builtin_amdgcn_exp2f(p0[r]);
}
__device__ __forceinline__ void partialSMb(f32x16& p0, f32x16& p1) {
  for (int r = 0; r < 16; ++r) p0[r] = __builtin_amdgcn_exp2f(p0[r]);
}
__device__ __forceinline__ void finishSMb(f32x16& p0, f32x16& p1, float& l_part, bf16x8& pa0, bf16x8& pa1, bf16x8& pa2, bf16x8& pa3) {
  for (int r = 0; r < 16; ++r) p1[r] = __builtin_amdgcn_exp2f(p1[r]);
  float ps = 0; for (int r = 0; r < 16; ++r) ps += p0[r]; for (int r = 0; r < 16; ++r) ps += p1[r];
  l_part += ps;
#define PK4(P, BASE, OUT) do { unsigned a0 = cvtpk(P[BASE + 0], P[BASE + 1]), a1 = cvtpk(P[BASE + 2], P[BASE + 3]);   \
    unsigned b0 = cvtpk(P[BASE + 4], P[BASE + 5]), b1 = cvtpk(P[BASE + 6], P[BASE + 7]);                              \
    auto r0 = __builtin_amdgcn_permlane32_swap(a0, b0, false, false); auto r1 = __builtin_amdgcn_permlane32_swap(a1, b1, false, false); \
    u32x4 w = {r0[0], r1[0], r0[1], r1[1]}; OUT = *reinterpret_cast<bf16x8*>(&w); } while (0)
  PK4(p0, 0, pa0); PK4(p0, 8, pa1); PK4(p1, 0, pa2); PK4(p1, 8, pa3);
#undef PK4
}
typedef short v2s16 __attribute__((ext_vector_type(2)));
__device__ __forceinline__ int cvt_pk4_fp8_sc(float a, float b, float c, float d, float sc) {
  v2s16 w = {0, 0};
  w = __builtin_amdgcn_cvt_scalef32_pk_fp8_f32(w, a, b, sc, false);
  w = __builtin_amdgcn_cvt_scalef32_pk_fp8_f32(w, c, d, sc, true);
  return __builtin_bit_cast(int, w);
}
__device__ __forceinline__ void exp32(f32x16& p0, f32x16& p1) {
  for (int r = 0; r < 16; ++r) p0[r] = __builtin_amdgcn_exp2f(p0[r]);
  for (int r = 0; r < 16; ++r) p1[r] = __builtin_amdgcn_exp2f(p1[r]);
}
__device__ __forceinline__ void finishSM8(const f32x16& p0, const f32x16& p1, float& l_part, v8i& pf, int& E) {
  float ps = 0; for (int r = 0; r < 16; ++r) ps += p0[r]; for (int r = 0; r < 16; ++r) ps += p1[r];
  l_part += ps;
  float pm = fmaxf(p0[0], p1[0]);
  for (int r = 1; r < 16; ++r) pm = fmaxf(fmaxf(pm, p0[r]), p1[r]);
  int e = (int)(__float_as_uint(pm) >> 23) - 7; e = e < 1 ? 1 : e;
  E = e;
  const float sc = __uint_as_float((unsigned)e << 23);
  pf = (v8i){cvt_pk4_fp8_sc(p0[0], p0[1], p0[2], p0[3], sc), cvt_pk4_fp8_sc(p0[4], p0[5], p0[6], p0[7], sc), cvt_pk4_fp8_sc(p0[8], p0[9], p0[10], p0[11], sc), cvt_pk4_fp8_sc(p0[12], p0[13], p0[14], p0[15], sc),
             cvt_pk4_fp8_sc(p1[0], p1[1], p1[2], p1[3], sc), cvt_pk4_fp8_sc(p1[4], p1[5], p1[6], p1[7], sc), cvt_pk4_fp8_sc(p1[8], p1[9], p1[10], p1[11], sc), cvt_pk4_fp8_sc(p1[12], p1[13], p1[14], p1[15], sc)};
}
__device__ __forceinline__ void pv8(f32x16* o, const char* Vs, v8i pf, int E, int r32, int hi) {
  int s1 = 0x7F7F7F7F; asm volatile("" : "+v"(s1));
  const int f = (r32 >> 2) & 3;
  const char* vrow = Vs + r32 * 64;
#pragma unroll
  for (int d0 = 0; d0 < 4; ++d0) {
    const v4i v0 = *reinterpret_cast<const v4i*>(vrow + d0 * 2048 + (((2 * hi) ^ f) << 4)), v1 = *reinterpret_cast<const v4i*>(vrow + d0 * 2048 + (((2 * hi + 1) ^ f) << 4));
    o[d0] = __builtin_amdgcn_mfma_scale_f32_32x32x64_f8f6f4(pf, __builtin_shufflevector(v0, v1, 0, 1, 2, 3, 4, 5, 6, 7), o[d0], 0, 0, 0, E, 0, s1);
  }
}
__device__ __forceinline__ void finishSM(f32x16& p0, f32x16& p1, float alpha, float& l_reg, bf16x8& pa0, bf16x8& pa1, bf16x8& pa2, bf16x8& pa3) {
  for (int r = 0; r < 16; ++r) p1[r] = __builtin_amdgcn_exp2f(p1[r]);
  float ps = 0; for (int r = 0; r < 16; ++r) ps += p0[r]; for (int r = 0; r < 16; ++r) ps += p1[r];
  { auto rr = __builtin_amdgcn_permlane32_swap(__float_as_uint(ps), __float_as_uint(ps), false, false);
    ps = __uint_as_float(rr[0]) + __uint_as_float(rr[1]); }
  l_reg = l_reg * alpha + ps;
#define PK4(P, BASE, OUT) do { unsigned a0 = cvtpk(P[BASE + 0], P[BASE + 1]), a1 = cvtpk(P[BASE + 2], P[BASE + 3]);   \
    unsigned b0 = cvtpk(P[BASE + 4], P[BASE + 5]), b1 = cvtpk(P[BASE + 6], P[BASE + 7]);                              \
    auto r0 = __builtin_amdgcn_permlane32_swap(a0, b0, false, false); auto r1 = __builtin_amdgcn_permlane32_swap(a1, b1, false, false); \
    u32x4 w = {r0[0], r1[0], r0[1], r1[1]}; OUT = *reinterpret_cast<bf16x8*>(&w); } while (0)
  PK4(p0, 0, pa0); PK4(p0, 8, pa1); PK4(p1, 0, pa2); PK4(p1, 8, pa3);
#undef PK4
}
__device__ __forceinline__ void qkt(f32x16& p0, f32x16& p1, const char* Ks, const v8i* qf, int r32, int hi) {
  int sc = 0x7F7F7F7F; asm volatile("" : "+v"(sc));
  p0 = f32x16{}; p1 = f32x16{};
#pragma unroll
  for (int st = 0; st < 2; ++st) {
    const int ua = 4 * hi + 2 * st, f0 = (r32 >> 1) & 7;
    const v4i a0 = *reinterpret_cast<const v4i*>(Ks + r32 * 128 + ((ua ^ f0) << 4)), a1 = *reinterpret_cast<const v4i*>(Ks + r32 * 128 + (((ua + 1) ^ f0) << 4));
    const v4i b0 = *reinterpret_cast<const v4i*>(Ks + (32 + r32) * 128 + ((ua ^ f0) << 4)), b1 = *reinterpret_cast<const v4i*>(Ks + (32 + r32) * 128 + (((ua + 1) ^ f0) << 4));
    p0 = __builtin_amdgcn_mfma_scale_f32_32x32x64_f8f6f4(__builtin_shufflevector(a0, a1, 0, 1, 2, 3, 4, 5, 6, 7), qf[st], p0, 0, 0, 0, sc, 0, sc);
    p1 = __builtin_amdgcn_mfma_scale_f32_32x32x64_f8f6f4(__builtin_shufflevector(b0, b1, 0, 1, 2, 3, 4, 5, 6, 7), qf[st], p1, 0, 0, 0, sc, 0, sc);
  }
}
__device__ __forceinline__ int v_st(int k, int c) { const int kk = (k & ~0xC) | ((k & 4) << 1) | ((k & 8) >> 1); return ((kk >> 3) * 4 + (c >> 5)) * 512 + ((kk & 7) * 32 + (c & 31)) * 2; }
__device__ __forceinline__ int v_rd_base(int lane) { return ((lane & 3) << 3) | (((lane >> 2) & 3) << 6) | (((lane >> 4) & 1) << 5) | (((lane >> 5) & 1) << 8); }
constexpr int v_rd_off(int d0, int ks, int half) { return d0 * 512 + ks * 4096 + half * 2048; }
template <int OFF> __device__ __forceinline__ s16x4 tr_read(int vb) {
  s16x4 r; asm volatile("ds_read_b64_tr_b16 %0, %1 offset:%2" : "=&v"(r) : "v"(vb), "i"(OFF) : "memory"); return r;
}
template <int D0> __device__ __forceinline__ void pv_one(f32x16& od, int vb, bf16x8 pa0, bf16x8 pa1, bf16x8 pa2, bf16x8 pa3) {
  const s16x4 l0 = tr_read<v_rd_off(D0, 0, 0)>(vb), h0 = tr_read<v_rd_off(D0, 0, 1)>(vb), l1 = tr_read<v_rd_off(D0, 1, 0)>(vb), h1 = tr_read<v_rd_off(D0, 1, 1)>(vb);
  const s16x4 l2 = tr_read<v_rd_off(D0, 2, 0)>(vb), h2 = tr_read<v_rd_off(D0, 2, 1)>(vb), l3 = tr_read<v_rd_off(D0, 3, 0)>(vb), h3 = tr_read<v_rd_off(D0, 3, 1)>(vb);
  asm volatile("s_waitcnt lgkmcnt(0)" ::: "memory"); SBAR();
#define PK(L, H) (bf16x8){L[0], L[1], L[2], L[3], H[0], H[1], H[2], H[3]}
  od = __builtin_amdgcn_mfma_f32_32x32x16_bf16(pa0, PK(l0, h0), od, 0, 0, 0);
  od = __builtin_amdgcn_mfma_f32_32x32x16_bf16(pa1, PK(l1, h1), od, 0, 0, 0);
  od = __builtin_amdgcn_mfma_f32_32x32x16_bf16(pa2, PK(l2, h2), od, 0, 0, 0);
  od = __builtin_amdgcn_mfma_f32_32x32x16_bf16(pa3, PK(l3, h3), od, 0, 0, 0);
#undef PK
}
__device__ __forceinline__ void pv_d0(f32x16* o, int vb, bf16x8 pa0, bf16x8 pa1, bf16x8 pa2, bf16x8 pa3) {
  pv_one<0>(o[0], vb, pa0, pa1, pa2, pa3); pv_one<1>(o[1], vb, pa0, pa1, pa2, pa3); pv_one<2>(o[2], vb, pa0, pa1, pa2, pa3); pv_one<3>(o[3], vb, pa0, pa1, pa2, pa3);
}
#define MFMA8(A, B, C, SA, SB) __builtin_amdgcn_mfma_scale_f32_32x32x64_f8f6f4(A, B, C, 0, 0, 0, SA, 0, SB)
#define CAT8(x, y) __builtin_shufflevector(x, y, 0, 1, 2, 3, 4, 5, 6, 7)
template <bool QK, bool PV>
__device__ __forceinline__ void att_step(f32x16& c0, f32x16& c1, const f32x16& q0, const f32x16& q1, f32x16* o, const v8i* qf, const char* Ks, const char* Vs, int r32, int hi, float& l_part) {
  int one = 0x7F7F7F7F; asm volatile("" : "+v"(one));
  const int f0 = (r32 >> 1) & 7, f = (r32 >> 2) & 3;
  const char* kr = Ks + r32 * 128; const char* vr = Vs + r32 * 64;
  v4i ka[4], kb[4];
  if (QK) {
#pragma unroll
    for (int u = 0; u < 4; ++u) { ka[u] = *reinterpret_cast<const v4i*>(kr + (((4 * hi + u) ^ f0) << 4)); kb[u] = *reinterpret_cast<const v4i*>(kr + 4096 + (((4 * hi + u) ^ f0) << 4)); }
  }
  SBAR();
  float ps = 0.f, pm = 0.f; v8i pf; int E = 0; float scf = 0.f;
  if (QK) { c0 = MFMA8(CAT8(ka[0], ka[1]), qf[0], f32x16{}, one, one); SBAR(); }
  if (PV) {
#pragma unroll
    for (int r = 0; r < 16; ++r) ps += q0[r];
    pm = fmaxf(q0[0], q0[1]);
#pragma unroll
    for (int r = 2; r < 16; r += 2) pm = fmaxf(fmaxf(pm, q0[r]), q0[r + 1]);
    SBAR();
  }
  if (QK) { c1 = MFMA8(CAT8(kb[0], kb[1]), qf[0], f32x16{}, one, one); SBAR(); }
  if (PV) {
#pragma unroll
    for (int r = 0; r < 16; ++r) ps += q1[r];
#pragma unroll
    for (int r = 0; r < 16; r += 2) pm = fmaxf(fmaxf(pm, q1[r]), q1[r + 1]);
    l_part += ps;
    int e = (int)(__float_as_uint(pm) >> 23) - 7; e = e < 1 ? 1 : e;
    E = e; scf = __uint_as_float((unsigned)e << 23);
    SBAR();
  }
  if (QK) { c0 = MFMA8(CAT8(ka[2], ka[3]), qf[1], c0, one, one); SBAR(); }
  v4i va[4], vb[4];
  if (PV) {
#pragma unroll
    for (int d0 = 0; d0 < 4; ++d0) { va[d0] = *reinterpret_cast<const v4i*>(vr + d0 * 2048 + (((2 * hi) ^ f) << 4)); vb[d0] = *reinterpret_cast<const v4i*>(vr + d0 * 2048 + (((2 * hi + 1) ^ f) << 4)); }
    pf[0] = cvt_pk4_fp8_sc(q0[0], q0[1], q0[2], q0[3], scf); pf[1] = cvt_pk4_fp8_sc(q0[4], q0[5], q0[6], q0[7], scf);
    pf[2] = cvt_pk4_fp8_sc(q0[8], q0[9], q0[10], q0[11], scf); pf[3] = cvt_pk4_fp8_sc(q0[12], q0[13], q0[14], q0[15], scf);
    SBAR();
  }
  if (QK) { c1 = MFMA8(CAT8(kb[2], kb[3]), qf[1], c1, one, one); SBAR(); }
  if (PV) {
    pf[4] = cvt_pk4_fp8_sc(q1[0], q1[1], q1[2], q1[3], scf); pf[5] = cvt_pk4_fp8_sc(q1[4], q1[5], q1[6], q1[7], scf);
    pf[6] = cvt_pk4_fp8_sc(q1[8], q1[9], q1[10], q1[11], scf); pf[7] = cvt_pk4_fp8_sc(q1[12], q1[13], q1[14], q1[15], scf);
    SBAR();
    o[0] = MFMA8(pf, CAT8(va[0], vb[0]), o[0], E, one); SBAR();
  }
  if (QK) {
#pragma unroll
    for (int r = 0; r < 8; ++r) c0[r] = __builtin_amdgcn_exp2f(c0[r]);
    SBAR();
  }
  if (PV) { o[1] = MFMA8(pf, CAT8(va[1], vb[1]), o[1], E, one); SBAR(); }
  if (QK) {
#pragma unroll
    for (int r = 8; r < 16; ++r) c0[r] = __builtin_amdgcn_exp2f(c0[r]);
    SBAR();
  }
  if (PV) { o[2] = MFMA8(pf, CAT8(va[2], vb[2]), o[2], E, one); SBAR(); }
  if (QK) {
#pragma unroll
    for (int r = 0; r < 8; ++r) c1[r] = __builtin_amdgcn_exp2f(c1[r]);
    SBAR();
  }
  if (PV) { o[3] = MFMA8(pf, CAT8(va[3], vb[3]), o[3], E, one); SBAR(); }
  if (QK) {
#pragma unroll
    for (int r = 8; r < 16; ++r) c1[r] = __builtin_amdgcn_exp2f(c1[r]);
    SBAR();
  }
}
constexpr size_t SHM_RING = (size_t)NS * SLOT, SHM_ATTN3 = SHM_RING + NW * 64 * 4;
__device__ __forceinline__ void attn_dense_body(const int tid, const bf16* __restrict__ Qb, const unsigned char* __restrict__ Kh, const unsigned char* __restrict__ Vh, unsigned char* __restrict__ Ob, int seq, char* lds,
                                                const float* __restrict__ q_g, const f32x2* __restrict__ rope, int t0, float mnC) {
  const int wid = __builtin_amdgcn_readfirstlane(tid >> 6), lane = tid & 63, r32 = lane & 31, hi = lane >> 5;
  float* ws = (float*)(lds + SHM_RING) + wid * 64; float* li_l = ws; float* al_l = ws + 32;
  float l_reg = 0; bf16x8 qr[8]; v8i qf[2];
  const bf16* Qw = Qb + (long)(wid * QBLK + r32) * LDQ + hi * 8;
#pragma unroll
  for (int d0 = 0; d0 < 8; ++d0) qr[d0] = ld8(Qw + d0 * 16);
  unsigned koff, voff;
  { int l_ = lane; asm volatile("" : "+v"(l_)); const int pk_ = wid * 64 + l_, key_ = pk_ >> 3;
    koff = (unsigned)(key_ * 256 + (((pk_ & 7) ^ ((key_ >> 1) & 7)) << 4)); voff = (unsigned)(wid * 1024 + l_ * 16); }
#define DMA_TILE(tile, slot) do { const int tl_ = (tile); \
    __builtin_amdgcn_global_load_lds((const unsigned*)(Kh + (size_t)tl_ * (64 * 256) + koff), (LAS unsigned*)(uintptr_t)(unsigned)((uintptr_t)lds + (slot) * SLOT + wid * 1024), 16, 0, 0); \
    __builtin_amdgcn_global_load_lds((const unsigned*)(Vh + (size_t)tl_ * 8192 + voff), (LAS unsigned*)(uintptr_t)(unsigned)((uintptr_t)lds + (slot) * SLOT + 8192 + wid * 1024), 16, 0, 0); } while (0)
#pragma unroll
  for (int i = 0; i < NS - 2; ++i) DMA_TILE(i, i);
  {
    float ss = 0.f;
#pragma unroll
    for (int d0 = 0; d0 < 8; ++d0)
#pragma unroll
      for (int j = 0; j < 8; ++j) { const float xv = __uint_as_float((unsigned)(unsigned short)qr[d0][j] << 16); ss += xv * xv; }
    ss += __shfl_xor(ss, 32);
    const float inv = rsqrtf(ss * (1.f / 128.f) + 1e-6f) * (SCALE * 1.4426950408889634f);
    const int t = t0 + wid * QBLK + r32;
#pragma unroll
    for (int ax = 0; ax < 2; ++ax) {
      float x[4][8];
#pragma unroll
      for (int dd = 0; dd < 4; ++dd) {
        const int d0 = ax * 4 + dd;
        const f32x4 g0 = *(const f32x4*)(q_g + d0 * 16 + hi * 8), g1 = *(const f32x4*)(q_g + d0 * 16 + hi * 8 + 4);
#pragma unroll
        for (int j = 0; j < 4; ++j) { x[dd][j] = __uint_as_float((unsigned)(unsigned short)qr[d0][j] << 16) * inv * g0[j]; x[dd][4 + j] = __uint_as_float((unsigned)(unsigned short)qr[d0][4 + j] << 16) * inv * g1[j]; }
      }
      if (t0 >= 0) {
        const int pos = ax == 0 ? (t >> 6) : (t & 63);
#pragma unroll
        for (int dd = 0; dd < 2; ++dd)
#pragma unroll
          for (int j = 0; j < 8; j += 2) {
            const f32x4 cs = *(const f32x4*)(rope + pos * 32 + dd * 16 + hi * 8 + j);
            const float a0 = x[dd][j], b0 = x[dd + 2][j], a1 = x[dd][j + 1], b1 = x[dd + 2][j + 1];
            x[dd][j] = a0 * cs.x - b0 * cs.y; x[dd + 2][j] = b0 * cs.x + a0 * cs.y; x[dd][j + 1] = a1 * cs.z - b1 * cs.w; x[dd + 2][j + 1] = b1 * cs.z + a1 * cs.w;
          }
      }
      qf[ax] = (v8i){(int)cvt_pk4_fp8(x[0][0], x[0][1], x[0][2], x[0][3]), (int)cvt_pk4_fp8(x[0][4], x[0][5], x[0][6], x[0][7]), (int)cvt_pk4_fp8(x[1][0], x[1][1], x[1][2], x[1][3]), (int)cvt_pk4_fp8(x[1][4], x[1][5], x[1][6], x[1][7]),
                     (int)cvt_pk4_fp8(x[2][0], x[2][1], x[2][2], x[2][3]), (int)cvt_pk4_fp8(x[2][4], x[2][5], x[2][6], x[2][7]), (int)cvt_pk4_fp8(x[3][0], x[3][1], x[3][2], x[3][3]), (int)cvt_pk4_fp8(x[3][4], x[3][5], x[3][6], x[3][7])};
    }
  }
  f32x16 pA0, pA1, pB0, pB1; const int NT = seq / KVBLK;
  int sc = 0, sp = NS - 1, sd = NS - 2;
#define STEP_HEAD(t_) do { asm volatile("s_waitcnt vmcnt(%0)\n\ts_barrier" :: "n"(2 * (NS - 3)) : "memory"); \
    { int tn_ = (t_) + NS - 2; tn_ = tn_ < NT ? tn_ : NT - 1; DMA_TILE(tn_, sd); } SBAR(); } while (0)
#define STEP_TAIL() do { sd = sp; sp = sc; sc = sc == NS - 1 ? 0 : sc + 1; } while (0)
#define PIN2(a, b) asm volatile("" : "+v"(a), "+v"(b))
#define STEP(PC0, PC1, PP0, PP1, t_) do { STEP_HEAD(t_); \
    att_step<true, true>(PC0, PC1, PP0, PP1, o, qf, lds + sc * SLOT, lds + sp * SLOT + 8192, r32, hi, l_reg); \
    PIN2(PC0, PC1); PIN2(o[0], o[1]); PIN2(o[2], o[3]); \
    STEP_TAIL(); } while (0)
  f32x16 o[4];
  STEP_HEAD(0);
  att_step<true, false>(pA0, pA1, pB0, pB1, o, qf, lds + sc * SLOT, lds, r32, hi, l_reg); PIN2(pA0, pA1);
  STEP_TAIL();
#pragma unroll
  for (int d = 0; d < 4; ++d) o[d] = f32x16{};
  for (int t = 1; t + 1 < NT; t += 2) {
    STEP(pB0, pB1, pA0, pA1, t);
    STEP(pA0, pA1, pB0, pB1, t + 1);
  }
  STEP(pB0, pB1, pA0, pA1, NT - 1);
  att_step<false, true>(pA0, pA1, pB0, pB1, o, qf, lds, lds + sp * SLOT + 8192, r32, hi, l_reg);
  asm volatile("s_waitcnt vmcnt(0)" ::: "memory");
  l_reg += __shfl_xor(l_reg, 32);
  if (hi == 0) li_l[r32] = l_reg; asm volatile("s_waitcnt lgkmcnt(0)" ::: "memory");
  float rli[16];
#pragma unroll
  for (int r = 0; r < 16; ++r) rli[r] = __builtin_amdgcn_rcpf(li_l[crow(r, hi)]);
  asm volatile("s_waitcnt lgkmcnt(0)\n\ts_barrier" ::: "memory");
  {
    int l2 = lane; asm volatile("" : "+v"(l2));
    char* stg = lds + 4 * SLOT + wid * 4096;
    char* sp_ = stg + (4 * (l2 >> 5)) * 128 + (l2 & 31);
#pragma unroll
    for (int r = 0; r < 16; r += 2) {
#pragma unroll
      for (int d0 = 0; d0 < 4; ++d0) {
        const int w = __builtin_amdgcn_cvt_pk_fp8_f32(o[d0][r] * rli[r], o[d0][r + 1] * rli[r + 1], 0, false);
        *(unsigned char*)(sp_ + crow(r, 0) * 128 + d0 * 32) = (unsigned char)w;
        *(unsigned char*)(sp_ + crow(r + 1, 0) * 128 + d0 * 32) = (unsigned char)(w >> 8);
      }
    }
    asm volatile("s_waitcnt lgkmcnt(0)" ::: "memory");
    unsigned char* Ow = Ob + (size_t)(wid * QBLK) * 1024;
#pragma unroll
    for (int i = 0; i < 4; ++i) {
      const int rowl = (l2 >> 3) + 8 * i;
      const u32x4 v = *reinterpret_cast<const u32x4*>(stg + rowl * 128 + (l2 & 7) * 16);
      *reinterpret_cast<u32x4*>(Ow + (size_t)rowl * 1024 + (l2 & 7) * 16) = v;
    }
    asm volatile("s_waitcnt lgkmcnt(0)" ::: "memory");
  }
#undef DMA_TILE
#undef STEP
#undef STEP_HEAD
#undef STEP_TAIL
#undef PIN2
}
}

struct Args { const float* in[N_IN]; float* out; unsigned char* ws; int ph_lo, ph_hi; };
typedef const Args __attribute__((address_space(4)))* KArgs;

__device__ __forceinline__ const float* mods_ptr(KArgs a, int layer, int mrow) { return (const float*)(a->ws + WS_MODS) + ((size_t)layer * 9 + mrow) * NMOD; }
__device__ __forceinline__ int mrow_of(int row) { const int b = row / SEG, s = row - b * SEG; return s < CTXL ? 8 : b; }


#ifndef MOE1_FMT
#define MOE1_FMT 2
#endif
typedef __bf16 v32bf16 __attribute__((ext_vector_type(32)));
typedef unsigned v6u32 __attribute__((ext_vector_type(6)));
typedef unsigned v16u32 __attribute__((ext_vector_type(16)));
__device__ __forceinline__ void fp6_chunk_store(const v16u32 x, unsigned char* rowp, int c) {
    float m = 0.f;
#pragma unroll
    for (int i = 0; i < 16; ++i) m = fmaxf(fmaxf(m, fabsf(__uint_as_float(x[i] << 16))), fabsf(__uint_as_float(x[i] & 0xffff0000u)));
    int E = (int)(__float_as_uint(m * 1.0666667f) >> 23) - 2; E = E < 1 ? 1 : E;
    const v6u32 r = __builtin_amdgcn_cvt_scalef32_pk32_fp6_bf16(__builtin_bit_cast(v32bf16, x), __uint_as_float((unsigned)E << 23));
    unsigned char* o = rowp + (c >> 2) * 128 + (c & 3) * 16;
    *(GAS u32x4*)o = (u32x4){r[0], r[1], r[2], r[3]};
    *(GAS u32x4*)(o + 64) = (u32x4){r[4], r[5], (unsigned)E, 0u};
}
__device__ __forceinline__ void tr_item(const float* __restrict__ W, int ldw, bf16* __restrict__ WT, int ldt, int k0, int n0, int drow0, LAS unsigned char* scr, int lane) {
    const int n4 = lane & 15, kg = lane >> 4;
    f32x4 v[4][4];
#pragma unroll
    for (int i = 0; i < 4; ++i)
#pragma unroll
        for (int kk = 0; kk < 4; ++kk) v[i][kk] = __builtin_nontemporal_load((const GAS f32x4*)(W + (size_t)(k0 + 4 * (kg + 4 * i) + kk) * ldw + n0 + 4 * n4));
#pragma unroll
    for (int i = 0; i < 4; ++i)
#pragma unroll
        for (int j = 0; j < 4; ++j) {
            u32x2 w; w.x = cvt_pk_bf16(v[i][0][j], v[i][1][j]); w.y = cvt_pk_bf16(v[i][2][j], v[i][3][j]);
            *(LAS u32x2*)(scr + ((4 * n4 + j) * 17 + (kg + 4 * i)) * 8) = w;
        }
    LDS_WAIT(); asm volatile("" ::: "memory");
#pragma unroll
    for (int q = 0; q < 16; ++q) {
        const int n = (lane >> 4) + 4 * q;
        const u32x2 w = *(const LAS u32x2*)(scr + (n * 17 + (lane & 15)) * 8);
        __builtin_nontemporal_store(w, (GAS u32x2*)(WT + (size_t)(drow0 + n) * ldt + k0 + 4 * (lane & 15)));
    }
    LDS_WAIT(); asm volatile("" ::: "memory");
}
__device__ __forceinline__ void tr_item8(const float* __restrict__ W, int ldw, unsigned char* __restrict__ WT, int ldt, int k0, int n0, int drow0, LAS unsigned char* scr, int lane, float scale) {
    const int n4 = lane & 15, kg = lane >> 4;
#pragma unroll
    for (int hf = 0; hf < 2; ++hf) {
        f32x4 v[4][4];
#pragma unroll
        for (int i = 0; i < 4; ++i)
#pragma unroll
            for (int kk = 0; kk < 4; ++kk) v[i][kk] = __builtin_nontemporal_load((const GAS f32x4*)(W + (size_t)(k0 + 64 * hf + 4 * (kg + 4 * i) + kk) * ldw + n0 + 4 * n4));
#pragma unroll
        for (int i = 0; i < 4; ++i)
#pragma unroll
            for (int j = 0; j < 4; ++j)
                *(LAS unsigned*)(scr + (4 * n4 + j) * 136 + 64 * hf + 4 * (kg + 4 * i)) = cvt_pk4_fp8(v[i][0][j] * scale, v[i][1][j] * scale, v[i][2][j] * scale, v[i][3][j] * scale);
    }
    LDS_WAIT(); asm volatile("" ::: "memory");
#pragma unroll
    for (int q = 0; q < 16; ++q) {
        const int n = (lane >> 4) + 4 * q;
        const u32x2 w = *(const LAS u32x2*)(scr + n * 136 + 8 * (lane & 15));
        __builtin_nontemporal_store(w, (GAS u32x2*)(WT + (size_t)(drow0 + n) * ldt + k0 + 8 * (lane & 15)));
    }
    LDS_WAIT(); asm volatile("" ::: "memory");
}
__device__ __forceinline__ void tr_item6(const float* __restrict__ W, int ldw, unsigned char* __restrict__ WT, int k0, int n0, int drow0, LAS unsigned char* scr, int lane) {
    const int n4 = lane & 15, kg = lane >> 4;
    v6u32 rr[4]; unsigned ee[4];
#pragma unroll
    for (int hf = 0; hf < 2; ++hf) {
        f32x4 v[4][4];
#pragma unroll
        for (int i = 0; i < 4; ++i)
#pragma unroll
            for (int kk = 0; kk < 4; ++kk) v[i][kk] = __builtin_nontemporal_load((const GAS f32x4*)(W + (size_t)(k0 + 64 * hf + 4 * (kg + 4 * i) + kk) * ldw + n0 + 4 * n4));
#pragma unroll
        for (int i = 0; i < 4; ++i)
#pragma unroll
            for (int j = 0; j < 4; ++j) {
                u32x2 w; w.x = cvt_pk_bf16(v[i][0][j], v[i][1][j]); w.y = cvt_pk_bf16(v[i][2][j], v[i][3][j]);
                *(LAS u32x2*)(scr + ((4 * n4 + j) * 17 + (kg + 4 * i)) * 8) = w;
            }
        LDS_WAIT(); asm volatile("" ::: "memory");
#pragma unroll
        for (int ch = 0; ch < 2; ++ch) {
            v16u32 x;
#pragma unroll
            for (int i = 0; i < 8; ++i) { const u32x2 w = *(const LAS u32x2*)(scr + (lane * 17 + 8 * ch + i) * 8); x[2 * i] = w.x; x[2 * i + 1] = w.y; }
            float m = 0.f;
#pragma unroll
            for (int i = 0; i < 16; ++i) m = fmaxf(fmaxf(m, fabsf(__uint_as_float(x[i] << 16))), fabsf(__uint_as_float(x[i] & 0xffff0000u)));
            int E = (int)(__float_as_uint(m * 1.0666667f) >> 23) - 2; E = E < 1 ? 1 : E;
            rr[2 * hf + ch] = __builtin_amdgcn_cvt_scalef32_pk32_fp6_bf16(__builtin_bit_cast(v32bf16, x), __uint_as_float((unsigned)E << 23)); ee[2 * hf + ch] = (unsigned)E;
        }
        LDS_WAIT(); asm volatile("" ::: "memory");
    }
#pragma unroll
    for (int q = 0; q < 4; ++q) {
        LAS unsigned char* o = scr + lane * 136 + 16 * q;
        *(LAS u32x2*)o = (u32x2){rr[q][0], rr[q][1]}; *(LAS u32x2*)(o + 8) = (u32x2){rr[q][2], rr[q][3]};
        *(LAS u32x2*)(o + 64) = (u32x2){rr[q][4], rr[q][5]}; *(LAS u32x2*)(o + 72) = (u32x2){ee[q], 0u};
    }
    LDS_WAIT(); asm volatile("" ::: "memory");
#pragma unroll
    for (int q = 0; q < 16; ++q) {
        const int n = (lane >> 4) + 4 * q;
        const u32x2 w = *(const LAS u32x2*)(scr + n * 136 + 8 * (lane & 15));
        __builtin_nontemporal_store(w, (GAS u32x2*)(WT + (size_t)(drow0 + n) * 1024 + k0 + 8 * (lane & 15)));
    }
    LDS_WAIT(); asm volatile("" ::: "memory");
}
__device__ __forceinline__ int glu_row(int n, int F) { const int hf = n >= F ? 1 : 0, m = n - hf * F; return (m >> 7) * 256 + hf * 128 + (m & 127); }

constexpr int CONV_SPLIT = 1;
constexpr int CONV_SCAN_SHARE = 34816;
__device__ __forceinline__ void convert_weights(KArgs a, LAS unsigned char* scr, int lane, int w, int nw, bool small, int l0, int l1, int it_lo, int it_hi) {
    unsigned char* ws = a->ws;
    constexpr int IT_POOL = 8 * 8, IT_GLU = 8 * 32, IT_QKV = 8 * 24, IT_WO = 8 * 16, IT_W1 = 8 * 32, IT_W2 = 8 * 16;
    const int n_small = small ? IT_POOL + IT_GLU + IT_QKV + IT_WO : 0;
    const int n_w1 = (l1 - l0) * 32 * IT_W1, n_w2 = (l1 - l0) * 32 * IT_W2;
    const int it_end = min(it_hi, n_small + n_w1 + n_w2);
    for (int it = it_lo + w; it < it_end; it += nw) {
        int r = it;
        if (r < n_small) {
            if (r < IT_POOL) { const int mat = r >> 3, q = r & 7, kb = q >> 2, nb = q & 3;
                tr_item8(a->in[I_POOLW] + (size_t)mat * 65536, 256, ws + WS_POOLW + (size_t)mat * 65536, 256, kb * 128, nb * 64, nb * 64, scr, lane, W8_SCALE); continue; }
            r -= IT_POOL;
            if (r < IT_GLU) { const int kb = r >> 5, nb = r & 31;
                tr_item8(a->in[I_GLUW], 2048, ws + WS_GLUW, 1024, kb * 128, nb * 64, glu_row(nb * 64, 1024), scr, lane, W8_SCALE); continue; }
            r -= IT_GLU;
            if (r < IT_QKV) { const int kb = r / 24, nb = r % 24;
                tr_item8(a->in[I_WQKV], 1536, ws + WS_WQKV, 1024, kb * 128, nb * 64, nb * 64, scr, lane, W8_SCALE); continue; }
            r -= IT_QKV;
            { const int kb = r >> 4, nb = r & 15;
                tr_item8(a->in[I_WO], 1024, ws + WS_WO, 1024, kb * 128, nb * 64, nb * 64, scr, lane, W8_SCALE); continue; }
        }
        r -= n_small;
        if (r < n_w1) { const int mat = l0 * 32 + (r >> 8), q = r & 255, kb = q >> 5, nb = q & 31;
            if constexpr (MOE1_FMT == 2) tr_item6(a->in[I_W1] + (size_t)mat * 1024 * 2048, 2048, ws + WS_W1T + (size_t)mat * 2048 * 1024, kb * 128, nb * 64, glu_row(nb * 64, 1024), scr, lane);
            else tr_item8(a->in[I_W1] + (size_t)mat * 1024 * 2048, 2048, ws + WS_W1T + (size_t)mat * 2048 * 1024, 1024, kb * 128, nb * 64, glu_row(nb * 64, 1024), scr, lane, W8_SCALE);
            continue; }
        r -= n_w1;
        { const int mat = l0 * 32 + (r >> 7), q = r & 127, kb = q >> 4, nb = q & 15;
            tr_item8(a->in[I_W2] + (size_t)mat * 1024 * 1024, 1024, ws + WS_W2T + (size_t)mat * 1024 * 1024, 1024, kb * 128, nb * 64, nb * 64, scr, lane, W8_SCALE); }
    }
}

__device__ __forceinline__ void prologue(KArgs a, LAS unsigned char* lds, int tid, int lane, int wave) {
    const int G = gridDim.x, bx = blockIdx.x;
    unsigned char* ws = a->ws;
    __syncthreads();
    {
        LAS float* sv = (LAS float*)lds;
        LAS float* red = (LAS float*)(lds + 9 * 1024 * 4);
        bool staged = false;
        for (int it = bx; it < 4 * 48; it += G) {
            if (!staged) {
                for (int i = tid; i < 9 * 1024; i += NTHR) { const int r = i >> 10, k = i & 1023; const float c = r < 8 ? a->in[I_C][r * 1024 + k] : a->in[I_CCTX][k]; sv[i] = c * sigmoidf_(c); }
                staged = true;
            }
            __syncthreads();
            const int layer = it / 48, col0 = (it % 48) * 128;
            const float* W = a->in[I_ADAW] + (size_t)layer * 1024 * NMOD + col0 + 2 * lane;
            f32x2 acc[9];
#pragma unroll
            for (int r = 0; r < 9; ++r) acc[r] = (f32x2){0.f, 0.f};
            const int kb = wave * 128;
#pragma unroll 8
            for (int k = 0; k < 128; ++k) {
                const f32x2 w = __builtin_nontemporal_load((const GAS f32x2*)(W + (size_t)(kb + k) * NMOD));
#pragma unroll
                for (int r = 0; r < 9; ++r) { const float s = sv[r * 1024 + kb + k]; acc[r].x += s * w.x; acc[r].y += s * w.y; }
            }
#pragma unroll
            for (int r = 0; r < 9; ++r) { red[(wave * 9 + r) * 128 + 2 * lane] = acc[r].x; red[(wave * 9 + r) * 128 + 2 * lane + 1] = acc[r].y; }
            __syncthreads();
            float* mods = (float*)(ws + WS_MODS);
            for (int i = tid; i < 9 * 128; i += NTHR) {
                const int r = i >> 7, cc = i & 127; float s = 0.f;
#pragma unroll
                for (int w = 0; w < 8; ++w) s += red[(w * 9 + r) * 128 + cc];
                mods[((size_t)layer * 9 + r) * NMOD + col0 + cc] = s + a->in[I_ADAB][layer * NMOD + col0 + cc];
            }
        }
        __syncthreads();
    }
    const int gt = bx * NTHR + tid, NGT = G * NTHR;
    for (int i = gt; i < 64 * 32; i += NGT) {
        const int pos = i >> 5, f = i & 31; const float inv = powf(10000.f, -(float)f / 32.f); const float ang = (float)pos * inv;
        ((f32x2*)(ws + WS_ROPE))[i] = (f32x2){cosf(ang), sinf(ang)};
    }
    for (int i = gt; i < 4 * 32 * 512; i += NGT) {
        const int layer = i >> 14, e = (i >> 9) & 31, c = (i & 511) * 2;
        ((unsigned*)(ws + WS_RT))[i] = cvt_pk_bf16(a->in[I_RW][((size_t)layer * 1024 + c) * 32 + e], a->in[I_RW][((size_t)layer * 1024 + c + 1) * 32 + e]);
    }
    for (int i = gt; i < 2 * 64 * 64; i += NGT) {
        const int d = i >> 12, g = (i >> 6) & 63;
        const float lr = a->in[I_LAMRE][i], li = a->in[I_LAMIM][i], dt = expf(a->in[I_LOGDT][d * 64 + g]);
        const float zr = lr * dt, zi = li * dt, mag = expf(zr);
        ((f32x2*)(ws + WS_S5LAM))[i] = (f32x2){mag * cosf(zi), mag * sinf(zi)};
    }
    for (int i = gt; i < 2 * 64 * 4 * 64; i += NGT) {
        const int l = i & 63, nt_ = (i >> 6) & 3, g = (i >> 8) & 63, d = i >> 14;
        const int p = (nt_ >> 1) * 32 + (l & 31), im = nt_ & 1, dg = d * 64 + g;
        const float lr = a->in[I_LAMRE][dg * 64 + p], li = a->in[I_LAMIM][dg * 64 + p], dt = expf(a->in[I_LOGDT][dg]);
        const float zr = lr * dt, zi = li * dt, mag = expf(zr), ar = mag * cosf(zi), ai = mag * sinf(zi), den = lr * lr + li * li;
        const float cr = ((ar - 1.f) * lr + ai * li) / den, ci = (ai * lr - (ar - 1.f) * li) / den;
        float o[8];
#pragma unroll
        for (int j = 0; j < 8; ++j) { const int h = 8 * (l >> 5) + j; const float br = a->in[I_BRE][((size_t)dg * 64 + p) * 16 + h], bi = a->in[I_BIM][((size_t)dg * 64 + p) * 16 + h];
            o[j] = im ? (cr * bi + ci * br) : (cr * br - ci * bi); }
        u32x4 w; w.x = cvt_pk_bf16(o[0], o[1]); w.y = cvt_pk_bf16(o[2], o[3]); w.z = cvt_pk_bf16(o[4], o[5]); w.w = cvt_pk_bf16(o[6], o[7]);
        ((u32x4*)(ws + WS_S5BF))[i] = w;
    }
    for (int i = gt; i < 2 * 64 * 4 * 64; i += NGT) {
        const int l = i & 63, ks = (i >> 6) & 3, g = (i >> 8) & 63, d = i >> 14, dg = d * 64 + g, hp = l & 15;
        float o[8];
#pragma unroll
        for (int j = 0; j < 8; ++j) { const int k = 32 * ks + 8 * (l >> 4) + j, p = k >> 1;
            o[j] = (k & 1) ? -a->in[I_CIM][((size_t)dg * 16 + hp) * 64 + p] : a->in[I_CRE][((size_t)dg * 16 + hp) * 64 + p]; }
        u32x4 w; w.x = cvt_pk_bf16(o[0], o[1]); w.y = cvt_pk_bf16(o[2], o[3]); w.z = cvt_pk_bf16(o[4], o[5]); w.w = cvt_pk_bf16(o[6], o[7]);
        ((u32x4*)(ws + WS_S5CF))[i] = w;
    }
    const int gw = bx * NWAVES + wave, NGW = G * NWAVES;
    convert_weights(a, lds + wave * 8704, lane, gw, NGW, true, 0, CONV_SPLIT, 0, 1 << 30);
}

template <bool BLOCKED> __device__ __forceinline__ int colof(int lane, int j) { return BLOCKED ? 16 * lane + 4 * j : 256 * j + 4 * lane; }

__device__ __forceinline__ const void* x_row_ptr(KArgs a, int layer, int row, int b, int s) {
    if (layer == 0) return s < CTXL ? a->in[I_CTX] + ((size_t)b * CTXL + s) * DM : a->in[I_X] + ((size_t)b * SEQ + (s - CTXL)) * DM;
    return (const bf16*)(a->ws + WS_XS) + (size_t)row * DM;
}
__device__ __forceinline__ f32x4 bf4_to_f32(u32x2 w) { return (f32x4){bf_lo(w.x), bf_hi(w.x), bf_lo(w.y), bf_hi(w.y)}; }
__device__ __forceinline__ u32x2 f32_to_bf4(f32x4 v) { u32x2 w; w.x = cvt_pk_bf16(v.x, v.y); w.y = cvt_pk_bf16(v.z, v.w); return w; }
template <bool BLOCKED>
__device__ __forceinline__ void row_loads(KArgs a, const void* xr, bool f32src, int row, int lane, bool combine, f32x4 (&v)[4], unsigned (&yw)[4][4]) {
    if (f32src) {
#pragma unroll
        for (int j = 0; j < 4; ++j) v[j] = *(const GAS f32x4*)((const float*)xr + colof<BLOCKED>(lane, j));
    } else {
#pragma unroll
        for (int j = 0; j < 4; ++j) v[j] = bf4_to_f32(*(const GAS u32x2*)((const bf16*)xr + colof<BLOCKED>(lane, j)));
    }
    if (combine) {
        const unsigned char* yb = a->ws + WS_YB + (size_t)row * 4 * DM;
#pragma unroll
        for (int j = 0; j < 4; ++j)
#pragma unroll
            for (int k = 0; k < 4; ++k) yw[j][k] = *(const GAS unsigned*)(yb + (size_t)k * DM + colof<BLOCKED>(lane, j));
    }
}
__device__ __forceinline__ f32x4 y8_sum(const unsigned (&w)[4]) {
    f32x4 s = (f32x4){0.f, 0.f, 0.f, 0.f};
#pragma unroll
    for (int k = 0; k < 4; ++k) { const f32x2 lo = __builtin_amdgcn_cvt_pk_f32_fp8(w[k], false), hi = __builtin_amdgcn_cvt_pk_f32_fp8(w[k], true); s.x += lo.x; s.y += lo.y; s.z += hi.x; s.w += hi.y; }
    return s * (1.0f / Y8_SCALE);
}
template <bool BLOCKED>
__device__ __forceinline__ void row_combine(KArgs a, int row, int lane, const float* gate_prev, f32x4 (&v)[4], const unsigned (&yw)[4][4]) {
    bf16* xw = (bf16*)(a->ws + WS_XS) + (size_t)row * DM;
#pragma unroll
    for (int j = 0; j < 4; ++j) {
        const int c = colof<BLOCKED>(lane, j);
        const f32x4 s = y8_sum(yw[j]);
        const f32x4 g = *(const GAS f32x4*)(gate_prev + c);
        v[j] = v[j] + g * s;
        *(GAS u32x2*)(xw + c) = f32_to_bf4(v[j]);
    }
}
template <bool BLOCKED>
__device__ __forceinline__ void load_x_row(KArgs a, int row, int lane, bool combine, const float* gate_prev, f32x4 (&v)[4]) {
    unsigned yw[4][4];
    row_loads<BLOCKED>(a, (const bf16*)(a->ws + WS_XS) + (size_t)row * DM, false, row, lane, combine, v, yw);
    if (combine) row_combine<BLOCKED>(a, row, lane, gate_prev, v, yw);
}
template <bool BLOCKED>
__device__ __forceinline__ void norm_mod(f32x4 (&v)[4], int lane, const float* g, const float* shift, const float* scale) {
    float ss = 0.f;
#pragma unroll
    for (int j = 0; j < 4; ++j) ss += (v[j].x * v[j].x + v[j].y * v[j].y) + (v[j].z * v[j].z + v[j].w * v[j].w);
    const float inv = rsqrtf(wave_sum(ss) * (1.f / DM) + NORM_EPS);
#pragma unroll
    for (int j = 0; j < 4; ++j) {
        const int c = colof<BLOCKED>(lane, j);
        const f32x4 gg = *(const GAS f32x4*)(g + c), sh = *(const GAS f32x4*)(shift + c), sc = *(const GAS f32x4*)(scale + c);
        v[j] = (v[j] * inv) * gg * (sc + 1.f) + sh;
    }
}

template <bool BLOCKED>
__device__ __forceinline__ void norm1_finish(KArgs a, int layer, int row, int b, int s, int lane, bool combine, f32x4 (&v)[4], const unsigned (&yw)[4][4]) {
    const int mrow = s < CTXL ? 8 : b;
    const float* md = mods_ptr(a, layer, mrow);
    if (combine) row_combine<BLOCKED>(a, row, lane, mods_ptr(a, layer - 1, mrow) + 5 * DM, v, yw);
    norm_mod<BLOCKED>(v, lane, a->in[I_N1G] + layer * DM, md, md + DM);
    if constexpr (!BLOCKED) {
        if (layer % 3 == 2) {
            unsigned char* o8 = a->ws + WS_B1 + (size_t)row * DM;
#pragma unroll
            for (int j = 0; j < 4; ++j) *(GAS unsigned*)(o8 + 256 * j + 4 * lane) = cvt_pk4_fp8(v[j].x, v[j].y, v[j].z, v[j].w);
        } else {
            bf16* o = (bf16*)(a->ws + WS_B1) + (size_t)row * DM;
#pragma unroll
            for (int j = 0; j < 4; ++j) { u32x2 w; w.x = cvt_pk_bf16(v[j].x, v[j].y); w.y = cvt_pk_bf16(v[j].z, v[j].w); *(GAS u32x2*)(o + 256 * j + 4 * lane) = w; }
        }
    } else {
        bf16* o = (bf16*)(a->ws + WS_B1) + (((size_t)b * 64 + lane) * SEG + s) * 16;
        u32x4 w0, w1;
        w0.x = cvt_pk_bf16(v[0].x, v[0].y); w0.y = cvt_pk_bf16(v[0].z, v[0].w); w0.z = cvt_pk_bf16(v[1].x, v[1].y); w0.w = cvt_pk_bf16(v[1].z, v[1].w);
        w1.x = cvt_pk_bf16(v[2].x, v[2].y); w1.y = cvt_pk_bf16(v[2].z, v[2].w); w1.z = cvt_pk_bf16(v[3].x, v[3].y); w1.w = cvt_pk_bf16(v[3].z, v[3].w);
        *(GAS u32x4*)o = w0; *(GAS u32x4*)(o + 8) = w1;
    }
}
template <bool BLOCKED>
__device__ __forceinline__ void phase_norm1(KArgs a, int layer, int lane, int wave) {
    const int gw = blockIdx.x * NWAVES + wave, NGW = gridDim.x * NWAVES;
    const bool combine = layer > 0, last = layer == MK_LAYERS - 1;
    for (int rowA = gw; rowA < NR; rowA += 2 * NGW) {
        const int rowB = rowA + NGW;
        const int bA = rowA / SEG, sA = rowA - bA * SEG, bB = rowB / SEG, sB = rowB - bB * SEG;
        const bool doA = !(last && sA < CTXL), doB = rowB < NR && !(last && sB < CTXL);
        f32x4 vA[4], vB[4]; unsigned yA[4][4], yB[4][4];
        if (doA) row_loads<BLOCKED>(a, x_row_ptr(a, layer, rowA, bA, sA), layer == 0, rowA, lane, combine, vA, yA);
        if (doB) row_loads<BLOCKED>(a, x_row_ptr(a, layer, rowB, bB, sB), layer == 0, rowB, lane, combine, vB, yB);
        if (doA) norm1_finish<BLOCKED>(a, layer, rowA, bA, sA, lane, combine, vA, yA);
        if (doB) norm1_finish<BLOCKED>(a, layer, rowB, bB, sB, lane, combine, vB, yB);
    }
}

__device__ __forceinline__ void phase_pooldiff(KArgs a, LAS unsigned char* lds, int layer, int tid, int lane, int wave) {
    const bool last = layer == MK_LAYERS - 1;
    const bf16* H = (const bf16*)(a->ws + WS_B1); bf16* Dd = (bf16*)(a->ws + WS_B2);
    constexpr int NCH = NR / 32;
    const int nch = last ? NB * 128 : NCH;
    for (int c = blockIdx.x; c < nch; c += gridDim.x) {
        const int b = last ? (c >> 7) : c / 136, cc = last ? 8 + (c & 127) : c - b * 136, s0 = cc * 32;
        const int seg_lo = cc < 8 ? 0 : CTXL, seg_hi = cc < 8 ? CTXL : SEG;
        const int st_lo = max(s0 - 8, seg_lo), st_hi = min(s0 + 40, seg_hi);
        __syncthreads();
        for (int p = tid; p < (st_hi - st_lo) * 128; p += NTHR) {
            const int r = p >> 7, q = p & 127;
            *(LAS u32x4*)(lds + (size_t)(st_lo + r - (s0 - 8)) * 2048 + q * 16) = *(const GAS u32x4*)(H + ((size_t)b * SEG + st_lo + r) * DM + q * 8);
        }
        __syncthreads();
#pragma unroll 1
        for (int rr = 0; rr < 4; ++rr) {
            const int s = s0 + wave * 4 + rr;
#pragma unroll
            for (int j = 0; j < 4; ++j) {
                const int half = 1 << j;
                const int lo = max(s - half, seg_lo), hi = min(s + half, seg_hi);
                f32x4 sum = (f32x4){0.f, 0.f, 0.f, 0.f};
                for (int t = lo; t < hi; ++t) { const u32x2 w = *(const LAS u32x2*)(lds + (size_t)(t - (s0 - 8)) * 2048 + (256 * j + 4 * lane) * 2); sum.x += bf_lo(w.x); sum.y += bf_hi(w.x); sum.z += bf_lo(w.y); sum.w += bf_hi(w.y); }
                const u32x2 w = *(const LAS u32x2*)(lds + (size_t)(s - (s0 - 8)) * 2048 + (256 * j + 4 * lane) * 2);
                const float ic = 1.f / (float)(hi - lo);
                *(GAS unsigned*)((unsigned char*)Dd + ((size_t)b * SEG + s) * DM + 256 * j + 4 * lane) = cvt_pk4_fp8(sum.x * ic - bf_lo(w.x), sum.y * ic - bf_hi(w.x), sum.z * ic - bf_lo(w.y), sum.w * ic - bf_hi(w.y));
            }
        }
    }
    __syncthreads();
}

__device__ __forceinline__ void phase_norm1_pooldiff(KArgs a, LAS unsigned char* lds, int layer, int tid, int lane, int wave) {
    const bool last = layer == MK_LAYERS - 1, combine = layer > 0;
    bf16* Dd = (bf16*)(a->ws + WS_B2);
    constexpr int NCH = NR / 32;
    const int nch = last ? NB * 128 : NCH;
    for (int c = blockIdx.x; c < nch; c += gridDim.x) {
        const int b = last ? (c >> 7) : c / 136, cc = last ? 8 + (c & 127) : c - b * 136, s0 = cc * 32;
        const int seg_lo = cc < 8 ? 0 : CTXL, seg_hi = cc < 8 ? CTXL : SEG, mrow = cc < 8 ? 8 : b;
        const int st_lo = max(s0 - 8, seg_lo), st_hi = min(s0 + 40, seg_hi);
        const float* md = mods_ptr(a, layer, mrow);
        __syncthreads();
#pragma unroll 1
        for (int i = 0; i < 6; i += 3) {
            int sR[3], rowR[3]; bool doR[3];
            f32x4 vR[3][4]; unsigned yR[3][4][4];
#pragma unroll
            for (int q = 0; q < 3; ++q) { sR[q] = s0 - 8 + wave + 8 * (i + q); doR[q] = sR[q] >= st_lo && sR[q] < st_hi; rowR[q] = b * SEG + sR[q]; }
#pragma unroll
            for (int q = 0; q < 3; ++q) if (doR[q]) row_loads<false>(a, x_row_ptr(a, layer, rowR[q], b, sR[q]), layer == 0, rowR[q], lane, combine, vR[q], yR[q]);
#pragma unroll
            for (int q = 0; q < 3; ++q) {
                if (!doR[q]) continue;
                f32x4 (&v)[4] = vR[q]; const unsigned (&yw)[4][4] = yR[q]; const int s = sR[q], row = rowR[q];
                if (combine) {
                    const float* gate_prev = mods_ptr(a, layer - 1, mrow) + 5 * DM;
                    const bool own = s >= s0 && s < s0 + 32;
                    bf16* xw = (bf16*)(a->ws + WS_B1) + (size_t)row * DM;
#pragma unroll
                    for (int j = 0; j < 4; ++j) { const int cidx = 256 * j + 4 * lane; v[j] = v[j] + *(const GAS f32x4*)(gate_prev + cidx) * y8_sum(yw[j]); if (own) *(GAS u32x2*)(xw + cidx) = f32_to_bf4(v[j]); }
                }
                norm_mod<false>(v, lane, a->in[I_N1G] + layer * DM, md, md + DM);
#pragma unroll
                for (int j = 0; j < 4; ++j) *(LAS u32x2*)(lds + (size_t)(s - (s0 - 8)) * 2048 + (256 * j + 4 * lane) * 2) = f32_to_bf4(v[j]);
            }
        }
        LDS_WAIT(); __syncthreads();
#pragma unroll 1
        for (int rr = 0; rr < 4; ++rr) {
            const int s = s0 + wave * 4 + rr;
#pragma unroll
            for (int j = 0; j < 4; ++j) {
                const int half = 1 << j;
                const int lo = max(s - half, seg_lo), hi = min(s + half, seg_hi);
                f32x4 sum = (f32x4){0.f, 0.f, 0.f, 0.f};
                for (int t = lo; t < hi; ++t) { const u32x2 w = *(const LAS u32x2*)(lds + (size_t)(t - (s0 - 8)) * 2048 + (256 * j + 4 * lane) * 2); sum.x += bf_lo(w.x); sum.y += bf_hi(w.x); sum.z += bf_lo(w.y); sum.w += bf_hi(w.y); }
                const u32x2 w = *(const LAS u32x2*)(lds + (size_t)(s - (s0 - 8)) * 2048 + (256 * j + 4 * lane) * 2);
                const float ic = 1.f / (float)(hi - lo);
                *(GAS unsigned*)((unsigned char*)Dd + ((size_t)b * SEG + s) * DM + 256 * j + 4 * lane) = cvt_pk4_fp8(sum.x * ic - bf_lo(w.x), sum.y * ic - bf_hi(w.x), sum.z * ic - bf_lo(w.y), sum.w * ic - bf_hi(w.y));
            }
        }
    }
    __syncthreads();
}

__device__ __forceinline__ void phase_s5_readout(KArgs a, int layer, int lane, int wave) {
    const int gw = blockIdx.x * NWAVES + wave, NGW = gridDim.x * NWAVES;
    const float* g1 = a->in[I_N1G] + layer * DM; const float* dsk = a->in[I_SSMD];
    const bf16* YG = (const bf16*)(a->ws + WS_YG);
    for (int row = gw; row < NR; row += NGW) {
        const int b = row / SEG, s = row - b * SEG, mrow = s < CTXL ? 8 : b;
        const float* md = mods_ptr(a, layer, mrow);
        f32x4 v[4];
        load_x_row<true>(a, row, lane, false, nullptr, v);
        norm_mod<true>(v, lane, g1, md, md + DM);
        const unsigned yoff = (unsigned)(b * 64 * SEG + s) * 16u + (unsigned)lane * (unsigned)(SEG * 16);
        const bf16* y0 = YG + yoff;
        const bf16* y1 = YG + yoff + (unsigned)(NB * 64 * SEG * 16);
        u32x4 ya[2], yb[2];
        ya[0] = *(const GAS u32x4*)y0; ya[1] = *(const GAS u32x4*)(y0 + 8); yb[0] = *(const GAS u32x4*)y1; yb[1] = *(const GAS u32x4*)(y1 + 8);
        unsigned pk[4];
#pragma unroll
        for (int j = 0; j < 4; ++j) {
            const unsigned a0 = ya[j >> 1][(j & 1) * 2], a1 = ya[j >> 1][(j & 1) * 2 + 1], b0 = yb[j >> 1][(j & 1) * 2], b1 = yb[j >> 1][(j & 1) * 2 + 1];
            const f32x4 ysum = (f32x4){bf_lo(a0) + bf_lo(b0), bf_hi(a0) + bf_hi(b0), bf_lo(a1) + bf_lo(b1), bf_hi(a1) + bf_hi(b1)};
            const f32x4 dd = *(const GAS f32x4*)(dsk + 16 * lane + 4 * j);
            f32x4 y = ysum + dd * v[j];
            float o[4];
#pragma unroll
            for (int i = 0; i < 4; ++i) { const float t = y[i]; o[i] = t * __builtin_amdgcn_rcpf(1.0f + __builtin_amdgcn_exp2f(-2.3022082f * (t + 0.044715f * t * t * t))); }
            pk[j] = cvt_pk4_fp8(o[0], o[1], o[2], o[3]);
        }
        *(GAS u32x4*)(a->ws + WS_B2 + (size_t)row * DM + 16 * lane) = (u32x4){pk[0], pk[1], pk[2], pk[3]};
    }
}

__device__ __forceinline__ void qk_head(bf16* p, unsigned char* p8, const float* g, const f32x2* rope, int t, bool latent, int q8) {
    const int ax = q8 >> 2, f0 = (q8 & 3) * 8, d1 = ax * 64 + f0;
    const u32x4 w1 = *(const GAS u32x4*)(p + d1), w2 = *(const GAS u32x4*)(p + d1 + 32);
    float x1[8], x2[8];
#pragma unroll
    for (int j = 0; j < 4; ++j) { x1[2 * j] = bf_lo(w1[j]); x1[2 * j + 1] = bf_hi(w1[j]); x2[2 * j] = bf_lo(w2[j]); x2[2 * j + 1] = bf_hi(w2[j]); }
    float ss = 0.f;
#pragma unroll
    for (int j = 0; j < 8; ++j) ss += x1[j] * x1[j] + x2[j] * x2[j];
    ss += __shfl_xor(ss, 1); ss += __shfl_xor(ss, 2); ss += __shfl_xor(ss, 4);
    const float inv = rsqrtf(ss * (1.f / 128.f) + NORM_EPS);
    const int pos = ax == 0 ? (t >> 6) : (t & 63);
    float y1[8], y2[8];
#pragma unroll
    for (int j = 0; j < 4; ++j) {
        const f32x2 ga = *(const GAS f32x2*)(g + d1 + 2 * j), gb = *(const GAS f32x2*)(g + d1 + 32 + 2 * j);
        float a0 = x1[2 * j] * inv * ga.x, a1 = x1[2 * j + 1] * inv * ga.y, b0 = x2[2 * j] * inv * gb.x, b1 = x2[2 * j + 1] * inv * gb.y;
        if (latent) {
            const f32x4 cs = *(const GAS f32x4*)(rope + pos * 32 + f0 + 2 * j);
            const float r0 = a0 * cs.x - b0 * cs.y, s0 = b0 * cs.x + a0 * cs.y, r1 = a1 * cs.z - b1 * cs.w, s1 = b1 * cs.z + a1 * cs.w;
            a0 = r0; b0 = s0; a1 = r1; b1 = s1;
        }
        y1[2 * j] = a0; y1[2 * j + 1] = a1; y2[2 * j] = b0; y2[2 * j + 1] = b1;
    }
    const int off = 64 * (q8 & 1) + 32 * ax + 8 * ((q8 & 3) >> 1);
    *(GAS u32x2*)(p8 + off) = (u32x2){cvt_pk4_fp8(y1[0], y1[1], y1[2], y1[3]), cvt_pk4_fp8(y1[4], y1[5], y1[6], y1[7])};
    *(GAS u32x2*)(p8 + off + 16) = (u32x2){cvt_pk4_fp8(y2[0], y2[1], y2[2], y2[3]), cvt_pk4_fp8(y2[4], y2[5], y2[6], y2[7])};
}
constexpr int V8T_TILE = 128 * 64;
__device__ __forceinline__ void phase_qkpost(KArgs a, LAS unsigned char* lds, int tid, int lane, int wave) {
    const int gw = blockIdx.x * NWAVES + wave, NGW = gridDim.x * NWAVES;
    const f32x2* rope = (const f32x2*)(a->ws + WS_ROPE);
    for (int row4 = gw * 4; row4 < NR; row4 += NGW * 4) {
        const int row = row4 + (lane >> 4), l16 = lane & 15;
        int s = (row4 - (row4 / SEG) * SEG) + (lane >> 4); if (s >= SEG) s -= SEG;
        const bool latent = s >= CTXL; const int t = s - CTXL;
        qk_head((bf16*)(a->ws + WS_KB) + (size_t)row * 256 + (l16 >> 3) * 128, a->ws + WS_B3 + (size_t)row * 256 + (l16 >> 3) * 128, a->in[I_KG], rope, t, latent, l16 & 7);
    }
    const bf16* Vb = (const bf16*)(a->ws + WS_VB); unsigned char* VT = a->ws + WS_YG;
    for (int item = blockIdx.x; item < NB * 2 * 68; item += gridDim.x) {
        const int b = item / 136, rem = item - b * 136, kvh = rem / 68, j = rem - kvh * 68;
        __syncthreads();
#pragma unroll
        for (int i = 0; i < 2; ++i) { const int p = tid + i * NTHR, key = p >> 4, piece = p & 15;
            *(LAS u32x4*)(lds + key * 272 + piece * 16) = *(const GAS u32x4*)(Vb + ((size_t)b * SEG + j * 64 + key) * 256 + kvh * 128 + piece * 8); }
        LDS_WAIT(); __syncthreads();
        const int d = tid >> 2, c = tid & 3, hh = c >> 1, kb = c & 1;
        float v[16];
#pragma unroll
        for (int t = 0; t < 16; ++t) { const int key = 32 * kb + (t & 3) + 8 * (t >> 2) + 4 * hh; v[t] = __uint_as_float((unsigned)*(const LAS unsigned short*)(lds + key * 272 + d * 2) << 16); }
        *(GAS u32x4*)(VT + (size_t)item * V8T_TILE + d * 64 + ((c ^ ((d >> 2) & 3)) << 4)) = (u32x4){cvt_pk4_fp8(v[0], v[1], v[2], v[3]), cvt_pk4_fp8(v[4], v[5], v[6], v[7]), cvt_pk4_fp8(v[8], v[9], v[10], v[11]), cvt_pk4_fp8(v[12], v[13], v[14], v[15])};
    }
    __syncthreads();
}

__device__ __forceinline__ void phase_final(KArgs a, int lane, int wave) {
    const int gw = blockIdx.x * NWAVES + wave, NGW = gridDim.x * NWAVES;
    for (int row = gw; row < NR; row += NGW) {
        const int b = row / SEG, s = row - b * SEG;
        if (s < CTXL) continue;
        f32x4 v[4]; unsigned yw[4][4];
        row_loads<false>(a, (const bf16*)(a->ws + WS_XS) + (size_t)row * DM, false, row, lane, true, v, yw);
        const float* gate = mods_ptr(a, MK_LAYERS - 1, b) + 5 * DM;
        float* o = a->out + ((size_t)b * SEQ + (s - CTXL)) * DM;
#pragma unroll
        for (int j = 0; j < 4; ++j) { const int c = 256 * j + 4 * lane; *(GAS f32x4*)(o + c) = v[j] + *(const GAS f32x4*)(gate + c) * y8_sum(yw[j]); }
    }
}

__device__ __forceinline__ int s5_token(int d, int j) { return d == 0 ? j : (j < CTXL ? (CTXL - 1 - j) : (SEG + CTXL - 1 - j)); }
__device__ __forceinline__ void phase_s5_scan(KArgs a, LAS unsigned char* lds, int lane, int wave) {
    if (wave >= 4) {
        convert_weights(a, lds + 4 * 8704 + (wave - 4) * 8704, lane, blockIdx.x * 4 + (wave - 4), gridDim.x * 4, false, CONV_SPLIT, MK_LAYERS, 0, CONV_SCAN_SHARE);
        return;
    }
    const int G = gridDim.x;
    __builtin_amdgcn_s_setprio(3);
    LAS unsigned* Hs = (LAS unsigned*)(lds + wave * 8704);
    const int hi = lane >> 5, c = lane & 31;
    const int rho = lane & 31, posA = 16 * ((rho >> 2) & 1) + (rho & 3) + 4 * (rho >> 3);
    for (int sid = blockIdx.x * 4 + wave; sid < NB * 64 * 2; sid += G * 4) {
        const int d = sid & 1, g = (sid >> 1) & 63, b = sid >> 7, dg = d * 64 + g;
        const bf16* U = (const bf16*)(a->ws + WS_B1) + ((size_t)b * 64 + g) * SEG * 16;
        unsigned* Y = (unsigned*)(a->ws + WS_YG) + ((size_t)(d * NB + b) * 64 + g) * SEG * 8;
        bf16x8 bfr[4], cfr[4];
#pragma unroll
        for (int n = 0; n < 4; ++n) { bfr[n] = *(const GAS bf16x8*)(a->ws + WS_S5BF + ((size_t)(dg * 4 + n) * 64 + lane) * 16); cfr[n] = *(const GAS bf16x8*)(a->ws + WS_S5CF + ((size_t)(dg * 4 + n) * 64 + lane) * 16); }
        const f32x2 lam0 = ((const f32x2*)(a->ws + WS_S5LAM))[dg * 64 + c], lam1 = ((const f32x2*)(a->ws + WS_S5LAM))[dg * 64 + 32 + c];
        float car[2][2] = {{0.f, 0.f}, {0.f, 0.f}};
        float pwr[2][8], pwi[2][8];
#pragma unroll
        for (int pp = 0; pp < 2; ++pp) { const float ar = pp ? lam1.x : lam0.x, ai = pp ? lam1.y : lam0.y; float pr = ar, pi = ai;
#pragma unroll
            for (int r = 0; r < 8; ++r) { pwr[pp][r] = pr; pwi[pp][r] = pi; const float tr = ar * pr - ai * pi, ti = ar * pi + ai * pr; pr = tr; pi = ti; } }
        bf16x8 uf[4];
#pragma unroll
        for (int q = 0; q < 4; ++q) uf[q] = *(const GAS bf16x8*)(U + (size_t)s5_token(d, 32 * q + posA) * 16 + 8 * hi);
        for (int jb = 0; jb < SEG; jb += 128) {
#pragma unroll
          for (int q = 0; q < 4; ++q) {
            const int j0 = jb + 32 * q;
            const bf16x8 ufr = uf[q];
            if (j0 + 128 < SEG) uf[q] = *(const GAS bf16x8*)(U + (size_t)s5_token(d, j0 + 128 + posA) * 16 + 8 * hi);
            f32x16 x[4];
#pragma unroll
            for (int n = 0; n < 4; ++n) { x[n] = f32x16{}; x[n] = __builtin_amdgcn_mfma_f32_32x32x16_bf16(ufr, bfr[n], x[n], 0, 0, 0); }
#pragma unroll
            for (int pp = 0; pp < 2; ++pp) {
                const float ar = pp ? lam1.x : lam0.x, ai = pp ? lam1.y : lam0.y;
                float sr = hi == 0 ? car[pp][0] : 0.f, si = hi == 0 ? car[pp][1] : 0.f;
#pragma unroll
                for (int r = 0; r < 16; ++r) {
                    const float nr = fmaf(ar, sr, fmaf(-ai, si, x[2 * pp][r])), ni = fmaf(ar, si, fmaf(ai, sr, x[2 * pp + 1][r]));
                    sr = nr; si = ni; x[2 * pp][r] = sr; x[2 * pp + 1][r] = si;
                }
                float wr_ = __shfl(sr, c), wi_ = __shfl(si, c);
                if (hi == 0) { wr_ = 0.f; wi_ = 0.f; }
#pragma unroll
                for (int r = 0; r < 16; ++r) {
                    if (r == 8) { const float tr = pwr[pp][7] * wr_ - pwi[pp][7] * wi_, ti = pwr[pp][7] * wi_ + pwi[pp][7] * wr_; wr_ = tr; wi_ = ti; }
                    x[2 * pp][r] = fmaf(pwr[pp][r & 7], wr_, fmaf(-pwi[pp][r & 7], wi_, x[2 * pp][r])); x[2 * pp + 1][r] = fmaf(pwr[pp][r & 7], wi_, fmaf(pwi[pp][r & 7], wr_, x[2 * pp + 1][r]));
                }
                car[pp][0] = __shfl(x[2 * pp][15], c + 32); car[pp][1] = __shfl(x[2 * pp + 1][15], c + 32);
#pragma unroll
                for (int r = 0; r < 16; ++r) Hs[(16 * hi + r) * 68 + c + 32 * pp] = cvt_pk_bf16(x[2 * pp][r], x[2 * pp + 1][r]);
            }
            LDS_WAIT(); asm volatile("" ::: "memory");
#pragma unroll
            for (int mt = 0; mt < 2; ++mt) {
                f32x4 y = (f32x4){0.f, 0.f, 0.f, 0.f};
#pragma unroll
                for (int ks = 0; ks < 4; ++ks) {
                    const bf16x8 af = *(const LAS bf16x8*)(Hs + (16 * mt + (lane & 15)) * 68 + 16 * ks + 4 * (lane >> 4));
                    y = __builtin_amdgcn_mfma_f32_16x16x32_bf16(af, cfr[ks], y, 0, 0, 0);
                }
#pragma unroll
                for (int i = 0; i < 4; ++i) { const int pos = 16 * mt + 4 * (lane >> 4) + i; const float nb_ = __shfl_xor(y[i], 1);
                    if ((lane & 1) == 0) Y[(size_t)s5_token(d, j0 + pos) * 8 + ((lane & 15) >> 1)] = cvt_pk_bf16(y[i], nb_); }
            }
            LDS_WAIT(); asm volatile("" ::: "memory");
          }
        }
    }
    __builtin_amdgcn_s_setprio(0);
    convert_weights(a, lds + wave * 8704, lane, blockIdx.x * 4 + wave, gridDim.x * 4, false, CONV_SPLIT, MK_LAYERS, CONV_SCAN_SHARE, 1 << 30);
}

constexpr int RW_STRIDE = 2064;
__device__ __forceinline__ void phase_router(KArgs a, LAS unsigned char* lds, int layer, int tid, int lane, int wave) {
    const int G = gridDim.x, bx = blockIdx.x;
    const bool last = layer >= MK_LAYERS - 2;
    LAS unsigned char* Wl = lds;
    LAS int* ent_e = (LAS int*)(lds + RSCR_OFF); LAS float* ent_g = (LAS float*)(lds + RSCR_OFF + RPB_MAX * 16);
    LAS int* lcount = (LAS int*)(lds + RSCR_OFF + RPB_MAX * 32); LAS int* lbase = lcount + 32; LAS int* lfill = lcount + 64;
    { const u32x4* src = (const u32x4*)(a->ws + WS_RT) + (size_t)layer * 4096;
      for (int p = tid; p < 4096; p += NTHR) *(LAS u32x4*)(Wl + (p >> 7) * RW_STRIDE + (p & 127) * 16) = src[p]; }
    if (tid < 32) { lcount[tid] = 0; lfill[tid] = 0; }
    __syncthreads();
    const bool lat_deal = last && G == NB * 32;
    const int rpb = lat_deal ? 128 : (NR + G - 1) / G, row0 = lat_deal ? (bx >> 5) * SEG + CTXL + (bx & 31) * 128 : bx * rpb, row1 = lat_deal ? row0 + 128 : min(NR, row0 + rpb), nrows = row1 - row0;
    const float* g2 = a->in[I_N2G] + layer * DM; const float* rb = a->in[I_RB] + layer * 32;
    LAS unsigned char* Hl = lds + 32 * RW_STRIDE;
    const int s_row0 = row0 - (row0 / SEG) * SEG;
    const int hi = lane >> 5, tk = lane & 31;
    u32x2 xw[4][4];
#define RT_LOAD(g_) do { _Pragma("unroll") for (int q_ = 0; q_ < 4; ++q_) { const int lr_ = 32 * (g_) + 8 * q_ + wave; if (lr_ < nrows) { \
        const bf16* xr_ = (const bf16*)(a->ws + WS_XS) + (size_t)(row0 + lr_) * DM; _Pragma("unroll") for (int j_ = 0; j_ < 4; ++j_) xw[q_][j_] = *(const GAS u32x2*)(xr_ + 256 * j_ + 4 * lane); } } } while (0)
    RT_LOAD(0);
    const int ngroups = (nrows + 31) >> 5;
    for (int g = 0; g < ngroups; ++g) {
#pragma unroll
        for (int q = 0; q < 4; ++q) {
            const int lr = 32 * g + 8 * q + wave;
            if (lr < nrows) {
                int sl = s_row0 + lr; int bb = row0 / SEG; if (sl >= SEG) { sl -= SEG; bb += 1; }
                if (!(last && sl < CTXL)) {
                    const float* md = mods_ptr(a, layer, sl < CTXL ? 8 : bb);
                    f32x4 v[4];
#pragma unroll
                    for (int j = 0; j < 4; ++j) v[j] = bf4_to_f32(xw[q][j]);
                    norm_mod<false>(v, lane, g2, md + 3 * DM, md + 4 * DM);
                    unsigned char* o8 = a->ws + WS_B3F + (size_t)(row0 + lr) * DM;
#pragma unroll
                    for (int j = 0; j < 4; ++j) { *(LAS u32x2*)(Hl + (8 * q + wave) * RW_STRIDE + (256 * j + 4 * lane) * 2) = f32_to_bf4(v[j]);
                        if constexpr (MOE1_FMT != 2) *(GAS unsigned*)(o8 + 256 * j + 4 * lane) = cvt_pk4_fp8(v[j].x, v[j].y, v[j].z, v[j].w); }
                }
            }
        }
        if (g + 1 < ngroups) RT_LOAD(g + 1);
        LDS_WAIT(); __syncthreads();
        if constexpr (MOE1_FMT == 2) {
#pragma unroll
            for (int ps = 0; ps < 2; ++ps) {
                const int lr32 = 4 * wave + 2 * ps + (lane >> 5), lr = 32 * g + lr32, c = lane & 31;
                if (lr < nrows) {
                    const LAS unsigned char* hp = Hl + lr32 * RW_STRIDE + c * 64;
                    const u32x4 w0 = *(const LAS u32x4*)hp, w1 = *(const LAS u32x4*)(hp + 16), w2 = *(const LAS u32x4*)(hp + 32), w3 = *(const LAS u32x4*)(hp + 48);
                    const v16u32 x = {w0.x, w0.y, w0.z, w0.w, w1.x, w1.y, w1.z, w1.w, w2.x, w2.y, w2.z, w2.w, w3.x, w3.y, w3.z, w3.w};
                    fp6_chunk_store(x, a->ws + WS_B3F + (size_t)(row0 + lr) * DM, c);
                }
            }
        }
        const int wa = g & 7, wb = (g + 1) & 7;
        LAS float* part = (LAS float*)(lds + RPART_OFF);
        f32x16 acc = f32x16{};
        if (wave == wa || wave == wb) {
            const LAS unsigned char* hp = Hl + tk * RW_STRIDE + 16 * hi + (wave == wa ? 0 : 1024);
            const LAS unsigned char* wp = Wl + tk * RW_STRIDE + 16 * hi + (wave == wa ? 0 : 1024);
            f32x16 acc1 = f32x16{};
#pragma unroll 4
            for (int s0 = 0; s0 < 32; s0 += 2) {
                const bf16x8 af0 = *(const LAS bf16x8*)(wp + 32 * s0), bf0 = *(const LAS bf16x8*)(hp + 32 * s0), af1 = *(const LAS bf16x8*)(wp + 32 * s0 + 32), bf1 = *(const LAS bf16x8*)(hp + 32 * s0 + 32);
                acc = __builtin_amdgcn_mfma_f32_32x32x16_bf16(af0, bf0, acc, 0, 0, 0); acc1 = __builtin_amdgcn_mfma_f32_32x32x16_bf16(af1, bf1, acc1, 0, 0, 0); }
            acc = acc + acc1;
            if (wave == wb) {
#pragma unroll
                for (int r = 0; r < 16; ++r) part[r * 64 + lane] = acc[r];
            }
        }
        LDS_WAIT(); __syncthreads();
        if (wave == wa) {
            const int lrow = 32 * g + tk; const bool inrange = lrow < nrows;
            bool valid = inrange; { int sl_ = s_row0 + lrow; if (sl_ >= SEG) sl_ -= SEG; if (last && sl_ < CTXL) valid = false; }
#pragma unroll
            for (int r = 0; r < 16; ++r) acc[r] += part[r * 64 + lane];
            float NEG = -3.0e38f; asm volatile("" : "+v"(NEG));
            float v[16];
#pragma unroll
            for (int r = 0; r < 16; ++r) v[r] = acc[r] + rb[(r & 3) + 8 * (r >> 2) + 4 * hi];
            float cv[8]; int ce[8];
#pragma unroll
            for (int k = 0; k < 4; ++k) {
                float best = NEG; int bi = 0;
#pragma unroll
                for (int r = 0; r < 16; ++r) if (v[r] > best) { best = v[r]; bi = r; }
#pragma unroll
                for (int r = 0; r < 16; ++r) if (r == bi) v[r] = NEG;
                cv[k] = best; ce[k] = (bi & 3) + 8 * (bi >> 2) + 4 * hi;
            }
#pragma unroll
            for (int k = 0; k < 4; ++k) { cv[4 + k] = __shfl_xor(cv[k], 32); ce[4 + k] = __shfl_xor(ce[k], 32); }
            float sv[4]; int se[4];
#pragma unroll
            for (int k = 0; k < 4; ++k) {
                float best = NEG; int be = 64, bi = 0;
#pragma unroll
                for (int q = 0; q < 8; ++q) if (cv[q] > best || (cv[q] == best && ce[q] < be)) { best = cv[q]; be = ce[q]; bi = q; }
#pragma unroll
                for (int q = 0; q < 8; ++q) if (q == bi) cv[q] = NEG;
                sv[k] = best; se[k] = be;
            }
            if (hi == 0 && inrange) {
                const float e1 = __expf(sv[1] - sv[0]), e2 = __expf(sv[2] - sv[0]), e3 = __expf(sv[3] - sv[0]);
                const float isum = 1.f / (1.f + e1 + e2 + e3);
                const int inv = valid ? 0 : -1;
                ent_e[lrow * 4 + 0] = se[0] | inv; ent_g[lrow * 4 + 0] = isum;
                ent_e[lrow * 4 + 1] = se[1] | inv; ent_g[lrow * 4 + 1] = e1 * isum;
                ent_e[lrow * 4 + 2] = se[2] | inv; ent_g[lrow * 4 + 2] = e2 * isum;
                ent_e[lrow * 4 + 3] = se[3] | inv; ent_g[lrow * 4 + 3] = e3 * isum;
                if (valid) {
#pragma unroll
                    for (int k = 0; k < 4; ++k) atomicAdd((int*)&lcount[se[k]], 1);
                }
            }
        }
    }
#undef RT_LOAD
    __syncthreads();
    unsigned* cnt = (unsigned*)(a->ws + WS_CTL) + CW_CNT + layer * 32;
    if (tid < 32) lbase[tid] = (int)__hip_atomic_fetch_add(cnt + tid, (unsigned)lcount[tid], __ATOMIC_RELAXED, __HIP_MEMORY_SCOPE_AGENT);
    __syncthreads();
    int* list = (int*)(a->ws + WS_LIST); float* gate = (float*)(a->ws + WS_GATE);
    for (int i = tid; i < (row1 - row0) * 4; i += NTHR) {
        const int e = ent_e[i];
        if (e >= 0) { const int pos = lbase[e] + atomicAdd((int*)&lfill[e], 1); const int ent = (row0 + (i >> 2)) * 4 + (i & 3); list[(size_t)e * NR + pos] = ent; gate[(size_t)e * NR + pos] = ent_g[i]; }
    }
    __syncthreads();
}

typedef f32x4 AccT[2][2][4][2];
struct EpiResid {
    static constexpr int PERM = 2;
    bf16* xs; const float* mods_layer; const float* pscale;
    const float* in_x; const float* in_ctx;
    const bf16* src_bf;
    __device__ __forceinline__ void operator()(const AccT& acc, const pg8::Unit& u, int wr, int wc, int fr, int fq, const LAS int* tab) const {
        const int tile = u.pm, bb = tile / 17, tt = tile - bb * 17, mrow = tt == 0 ? 8 : bb;
        const float* gate = mods_layer + (size_t)mrow * NMOD + 2 * DM;
        const float* srcf = in_x ? (tt == 0 ? in_ctx + (size_t)bb * CTXL * DM : in_x + ((size_t)bb * SEQ + (tt - 1) * 256) * DM) : nullptr;
        bf16* dst = xs + (size_t)tile * 256 * DM; const bf16* srcb = (src_bf ? src_bf : xs) + (size_t)tile * 256 * DM;
        const int col0 = u.pn * 256 + wc * 64 + fq * 16;
        f32x4 gv[2][2];
#pragma unroll
        for (int bj = 0; bj < 2; ++bj)
#pragma unroll
            for (int n = 0; n < 2; ++n) { gv[bj][n] = *(const GAS f32x4*)(gate + col0 + 8 * bj + 4 * n); if (pscale) gv[bj][n] = gv[bj][n] * *(const GAS f32x4*)(pscale + col0 + 8 * bj + 4 * n); }
#pragma unroll
        for (int ai = 0; ai < 2; ++ai)
#pragma unroll
            for (int m = 0; m < 4; ++m) {
                const size_t o = (size_t)(ai * 128 + wr * 64 + m * 16 + fr) * DM + col0;
                f32x4 x[2][2];
                if (srcf) {
#pragma unroll
                    for (int bj = 0; bj < 2; ++bj)
#pragma unroll
                        for (int n = 0; n < 2; ++n) x[bj][n] = *(const GAS f32x4*)(srcf + o + 8 * bj + 4 * n);
                } else {
#pragma unroll
                    for (int bj = 0; bj < 2; ++bj) { const u32x4 w = *(const GAS u32x4*)(srcb + o + 8 * bj); x[bj][0] = bf4_to_f32((u32x2){w.x, w.y}); x[bj][1] = bf4_to_f32((u32x2){w.z, w.w}); }
                }
#pragma unroll
                for (int bj = 0; bj < 2; ++bj) { const u32x2 lo = f32_to_bf4(x[bj][0] + gv[bj][0] * acc[ai][bj][m][0]), hi2 = f32_to_bf4(x[bj][1] + gv[bj][1] * acc[ai][bj][m][1]);
                    *(GAS u32x4*)(dst + o + 8 * bj) = (u32x4){lo.x, lo.y, hi2.x, hi2.y}; }
            }
    }
};
struct EpiGlu {
    static constexpr int PERM = 1;
    bf16* xs; const float* mods_layer; const float* bias;
    __device__ __forceinline__ void operator()(const AccT& acc, const pg8::Unit& u, int wr, int wc, int fr, int fq, const LAS int* tab) const {
        const int tile = u.pm, mrow = (tile % 17 == 0) ? 8 : tile / 17;
        const float* gate = mods_layer + (size_t)mrow * NMOD + 2 * DM;
        const int col0 = u.pn * 128 + wc * 32 + 8 * fq;
        f32x4 gv[2], bv[2], bg[2];
#pragma unroll
        for (int n = 0; n < 2; ++n) { gv[n] = *(const GAS f32x4*)(gate + col0 + 4 * n); bv[n] = *(const GAS f32x4*)(bias + col0 + 4 * n); bg[n] = *(const GAS f32x4*)(bias + DM + col0 + 4 * n); }
#pragma unroll
        for (int ai = 0; ai < 2; ++ai)
#pragma unroll
            for (int m = 0; m < 4; ++m) {
                bf16* p = xs + (size_t)(tile * 256 + ai * 128 + wr * 64 + m * 16 + fr) * DM + col0;
                const u32x4 w = *(const GAS u32x4*)p;
                f32x4 x[2] = {bf4_to_f32((u32x2){w.x, w.y}), bf4_to_f32((u32x2){w.z, w.w})};
                u32x2 ow[2];
#pragma unroll
                for (int n = 0; n < 2; ++n) {
                    const f32x4 val = acc[ai][0][m][n] + bv[n], gt = acc[ai][1][m][n] + bg[n];
                    f32x4 o; o.x = val.x * sigmoidf_(gt.x); o.y = val.y * sigmoidf_(gt.y); o.z = val.z * sigmoidf_(gt.z); o.w = val.w * sigmoidf_(gt.w);
                    ow[n] = f32_to_bf4(x[n] + gv[n] * o);
                }
                *(GAS u32x4*)p = (u32x4){ow[0].x, ow[0].y, ow[1].x, ow[1].y};
            }
    }
};
struct EpiQkv {
    static constexpr int PERM = 2;
    bf16* q; bf16* k; bf16* v;
    __device__ __forceinline__ void operator()(const AccT& acc, const pg8::Unit& u, int wr, int wc, int fr, int fq, const LAS int* tab) const {
        bf16* base = u.pn < 4 ? q + u.pn * 256 : (u.pn == 4 ? k : v); const int ldc = u.pn < 4 ? 1024 : 256;
#pragma unroll
        for (int ai = 0; ai < 2; ++ai)
#pragma unroll
            for (int m = 0; m < 4; ++m) { bf16* rowp = base + (size_t)(u.pm * 256 + ai * 128 + wr * 64 + m * 16 + fr) * ldc + wc * 64 + 16 * fq;
#pragma unroll
                for (int bj = 0; bj < 2; ++bj) { const f32x4 v0 = acc[ai][bj][m][0], v1 = acc[ai][bj][m][1];
                    u32x4 w; w.x = cvt_pk_bf16(v0[0], v0[1]); w.y = cvt_pk_bf16(v0[2], v0[3]); w.z = cvt_pk_bf16(v1[0], v1[1]); w.w = cvt_pk_bf16(v1[2], v1[3]);
                    *(GAS u32x4*)(rowp + bj * 8) = w; } }
    }
};
struct EpiMoe1 {
    static constexpr int PERM = 1;
    unsigned char* act;
    __device__ __forceinline__ void operator()(const AccT& acc, const pg8::Unit& u, int wr, int wc, int fr, int fq, const LAS int* tab) const {
        const int cl = wc * 32 + 8 * fq, col0 = u.pn * 128 + cl;
        const LAS float* bt = (const LAS float*)(tab + 512);
        float c7 = 7.0f, ck = -2.4554669595930156f; asm volatile("" : "+v"(c7), "+v"(ck));
        f32x4 bg[2], bl[2];
#pragma unroll
        for (int n = 0; n < 2; ++n) { bg[n] = *(const LAS f32x4*)(bt + cl + 4 * n); bl[n] = *(const LAS f32x4*)(bt + 128 + cl + 4 * n); }
#pragma unroll
        for (int ai = 0; ai < 2; ++ai)
#pragma unroll
            for (int m = 0; m < 4; ++m) {
                float o[8];
#pragma unroll
                for (int n = 0; n < 2; ++n)
#pragma unroll
                    for (int jp = 0; jp < 2; ++jp) {
                        f32x2 g = (f32x2){acc[ai][0][m][n][2 * jp], acc[ai][0][m][n][2 * jp + 1]} + (f32x2){bg[n][2 * jp], bg[n][2 * jp + 1]};
                        f32x2 l = (f32x2){acc[ai][1][m][n][2 * jp], acc[ai][1][m][n][2 * jp + 1]} + (f32x2){bl[n][2 * jp], bl[n][2 * jp + 1]};
                        g.x = fminf(g.x, c7); g.y = fminf(g.y, c7);
                        l.x = __builtin_amdgcn_fmed3f(l.x, -c7, c7); l.y = __builtin_amdgcn_fmed3f(l.y, -c7, c7);
                        f32x2 t = g * ck;
                        t.x = __builtin_amdgcn_exp2f(t.x); t.y = __builtin_amdgcn_exp2f(t.y);
                        t = t + 1.0f;
                        t.x = __builtin_amdgcn_rcpf(t.x); t.y = __builtin_amdgcn_rcpf(t.y);
                        const f32x2 r = (g * t) * (l + 1.0f);
                        o[4 * n + 2 * jp] = r.x; o[4 * n + 2 * jp + 1] = r.y;
                    }
                u32x2 w; w.x = cvt_pk4_fp8(o[0], o[1], o[2], o[3]); w.y = cvt_pk4_fp8(o[4], o[5], o[6], o[7]);
                *(GAS u32x2*)(act + (size_t)(u.pm * 256 + ai * 128 + wr * 64 + m * 16 + fr) * DFF + col0) = w;
            }
    }
};
struct EpiNull {
    static constexpr int PERM = 1;
    float* sink;
    __device__ __forceinline__ void operator()(const AccT& acc, const pg8::Unit& u, int wr, int wc, int fr, int fq, const LAS int* tab) const {
        f32x4 s = (f32x4){0.f, 0.f, 0.f, 0.f};
#pragma unroll
        for (int ai = 0; ai < 2; ++ai)
#pragma unroll
            for (int bj = 0; bj < 2; ++bj)
#pragma unroll
                for (int m = 0; m < 4; ++m)
#pragma unroll
                    for (int n = 0; n < 2; ++n) s = s + acc[ai][bj][m][n];
        sink[(size_t)(u.pm * 256 + wr * 64 + fr) * 64 + wc * 16 + fq * 4 + (u.pn & 3)] = (s.x + s.y) + (s.z + s.w);
    }
};
struct EpiMoe2 {
    static constexpr int PERM = 2;
    unsigned char* yb;
    __device__ __forceinline__ void operator()(const AccT& acc, const pg8::Unit& u, int wr, int wc, int fr, int fq, const LAS int* tab) const {
        const int cl = wc * 64 + 16 * fq, col0 = u.pn * 256 + cl;
        const LAS float* bt = (const LAS float*)(tab + 512); const LAS float* gt = (const LAS float*)(tab + 256);
        f32x4 bv[2][2];
#pragma unroll
        for (int bj = 0; bj < 2; ++bj)
#pragma unroll
            for (int n = 0; n < 2; ++n) bv[bj][n] = *(const LAS f32x4*)(bt + cl + 8 * bj + 4 * n);
#pragma unroll
        for (int ai = 0; ai < 2; ++ai)
#pragma unroll
            for (int m = 0; m < 4; ++m) {
                const int rl = ai * 128 + wr * 64 + m * 16 + fr;
                const int ent = (u.rb * 256 + rl < u.cnt) ? tab[rl] : NR * 4; const float g = gt[rl] * Y8_SCALE;
                u32x4 w;
#pragma unroll
                for (int bj = 0; bj < 2; ++bj) { const f32x4 v0 = (acc[ai][bj][m][0] + bv[bj][0]) * g, v1 = (acc[ai][bj][m][1] + bv[bj][1]) * g;
                    w[2 * bj] = cvt_pk4_fp8(v0[0], v0[1], v0[2], v0[3]); w[2 * bj + 1] = cvt_pk4_fp8(v1[0], v1[1], v1[2], v1[3]); }
                *(GAS u32x4*)(yb + (size_t)ent * DM + col0) = w;
            }
    }
};

constexpr int PH_PER_LAYER = 8, PH_FINAL = 1 + MK_LAYERS * PH_PER_LAYER, N_PHASES = PH_FINAL + 1;

__global__ void __launch_bounds__(NTHR, 2) mega_fwd(Args args_byval) {
    KArgs args = (KArgs)__builtin_amdgcn_kernarg_segment_ptr();
    extern __shared__ __attribute__((aligned(16))) unsigned char lds_raw[];
    LAS unsigned char* lds = (LAS unsigned char*)lds_raw;
    int tid = threadIdx.x, lane = tid & 63, wave = __builtin_amdgcn_readfirstlane(tid >> 6);
    const int G = gridDim.x, bx = blockIdx.x;
    volatile LAS unsigned* MISC = (volatile LAS unsigned*)(lds + MISC_OFF);
    if (tid < 16) MISC[tid] = 0u;
    __syncthreads();
    unsigned* ctl = (unsigned*)(args->ws + WS_CTL);
    XcdBarrier bar; bar.bar = ctl + CW_BAR; bar.x = 0; bar.st = nullptr;
    if (!MK_SPLIT) bar = xcd_barrier_post(ctl + CW_BAR, MISC);
    const int lo = args->ph_lo, hi = args->ph_hi;
#define IN(k) (lo <= (k) && (k) < hi)
#define SEAM(k) do { if (!MK_SPLIT && (k) + 1 < hi) xcd_barrier(bar); } while (0)
    LAS int* rowtab = (LAS int*)(lds + ROWTAB_OFF);

    if (IN(0)) { if (EN(0)) for (int rep = 0; rep < NREP(0); ++rep) prologue(args, lds, tid, lane, wave); }
    if (!MK_SPLIT) xcd_barrier_census(bar);
    if (IN(0)) SEAM(0);

    for (int layer = 0; layer < MK_LAYERS; ++layer) {
        const int kind = layer % 3, base = 1 + layer * PH_PER_LAYER;
        asm volatile("" : "+s"(args));
        tid = threadIdx.x; asm volatile("" : "+v"(tid)); lane = tid & 63; wave = __builtin_amdgcn_readfirstlane(tid >> 6);
        const float* mods_layer = (const float*)(args->ws + WS_MODS) + (size_t)layer * 9 * NMOD;
        bf16* xs = (bf16*)(args->ws + WS_XS);
        if (IN(base + 0)) {
            if (EN(1)) { if (kind == 1) phase_norm1<true>(args, layer, lane, wave); else if (kind == 2) phase_norm1<false>(args, layer, lane, wave); }
            if (kind != 0) SEAM(base + 0);
        }
        if (IN(base + 1)) {
            if (kind == 0) { if (EN(2)) phase_norm1_pooldiff(args, lds, layer, tid, lane, wave); }
            else if (kind == 1) { if (EN(3)) for (int rep = 0; rep < NREP(3); ++rep) phase_s5_scan(args, lds, lane, wave); }
            else if (EN(4)) for (int rep = 0; rep < NREP(4); ++rep) {
                pg8::StaticSchedG S{{(const char*)(args->ws + WS_B1), (const char*)(args->ws + WS_WQKV), (size_t)256 * DM, (size_t)256 * DM, NTILE, 6, NTILE * 6, G, bx, 0, 0}};
                EpiQkv E{(bf16*)(args->ws + WS_B2), (bf16*)(args->ws + WS_KB), (bf16*)(args->ws + WS_VB)};
                pg8::gemm_phase<EpiQkv, pg8::StaticSchedG, true, true>(tid, lds, rowtab, DM / 2, DM / 2, DM / 2, S, E);
            }
            SEAM(base + 1);
        }
        if (IN(base + 2)) {
            if (kind == 0) { if (EN(5)) for (int rep = 0; rep < NREP(5); ++rep) {
                const int j = layer / 3;
                pg8::StaticSchedG S{{(const char*)(args->ws + WS_B2), (const char*)(args->ws + WS_POOLW) + (size_t)j * 4 * 65536, (size_t)256 * DM, (size_t)256 * 256, NTILE, 4, NTILE * 4, G, bx, (size_t)256, 0}};
                EpiResid E{rep + 1 < NREP(5) ? (bf16*)(args->ws + WS_YG) : xs, mods_layer, args->in[I_POOLS] + j * DM, layer == 0 ? args->in[I_X] : nullptr, args->in[I_CTX], layer == 0 ? nullptr : (const bf16*)(args->ws + WS_B1)};
                pg8::gemm_phase<EpiResid, pg8::StaticSchedG, true, true>(tid, lds, rowtab, DM / 2, 128, 128, S, E);
            } } else if (kind == 1) { if (EN(6)) for (int rep = 0; rep < NREP(6); ++rep) phase_s5_readout(args, layer, lane, wave); }
            else { if (EN(7)) phase_qkpost(args, lds, tid, lane, wave); }
            SEAM(base + 2);
        }
        if (IN(base + 3) && kind != 0) {
            if (kind == 1) { if (EN(8)) for (int rep = 0; rep < NREP(8); ++rep) {
                pg8::StaticSchedG S{{(const char*)(args->ws + WS_B2), (const char*)(args->ws + WS_GLUW), (size_t)256 * DM, (size_t)256 * DM, NTILE, 8, NTILE * 8, G, bx, 0, 0}};
                EpiGlu E{rep + 1 < NREP(8) ? (bf16*)(args->ws + WS_YG) : xs, mods_layer, args->in[I_GLUB]};
                pg8::gemm_phase<EpiGlu, pg8::StaticSchedG, true, true>(tid, lds, rowtab, DM / 2, DM / 2, DM / 2, S, E);
            } } else if (EN(9)) for (int rep = 0; rep < NREP(9); ++rep) {
                const bf16* Q = (const bf16*)(args->ws + WS_B2); const unsigned char* Kb = args->ws + WS_B3  ; const unsigned char* Vt = args->ws + WS_YG  ; unsigned char* O = args->ws + WS_B1;
                const int vcu = (G % 8 == 0) ? (bx % 8) * (G / 8) + bx / 8 : bx;
                float gqm = fmaxf(fabsf(args->in[I_QG][lane]), fabsf(args->in[I_QG][lane + 64])), gkm = fmaxf(fabsf(args->in[I_KG][lane]), fabsf(args->in[I_KG][lane + 64]));
#pragma unroll
                for (int o_ = 1; o_ < 64; o_ <<= 1) { gqm = fmaxf(gqm, __shfl_xor(gqm, o_)); gkm = fmaxf(gkm, __shfl_xor(gkm, o_)); }
                const float mnC = __uint_as_float(__builtin_amdgcn_readfirstlane(__float_as_uint(-(128.0f * 1.02f) * gqm * gkm * (att::SCALE * 1.4426950408889634f))));
                for (int u = vcu; u < 1024; u += G) {
                    const int grp = u >> 6, b = grp >> 1, kvh = grp & 1, h = kvh * 4 + ((u & 63) >> 4), qb = u & 15;
                    const size_t qrow = (size_t)b * SEG + CTXL + qb * 256, krow = (size_t)b * SEG;
                    att::attn_dense_body(tid, Q + qrow * DM + h * 128, Kb + krow * 256 + kvh * 128, Vt + (size_t)(b * 2 + kvh) * 68 * att::V8T_TILE_, O + qrow * DM + h * 128, SEG, (char*)lds_raw, args->in[I_QG], (const f32x2*)(args->ws + WS_ROPE), qb * 256, mnC);
                }
                if constexpr (MK_LAYERS > 4) if (MK_LAYERS - layer > 2) for (int u = vcu; u < 64; u += G) {
                    const int b = u >> 3, h = u & 7, kvh = h >> 2;
                    const size_t qrow = (size_t)b * SEG;
                    att::attn_dense_body(tid, Q + qrow * DM + h * 128, Kb + qrow * 256 + kvh * 128, Vt + (size_t)(b * 2 + kvh) * 68 * att::V8T_TILE_, O + qrow * DM + h * 128, CTXL, (char*)lds_raw, args->in[I_QG], (const f32x2*)(args->ws + WS_ROPE), -1, mnC);
                }
            }
            SEAM(base + 3);
        }
        if (IN(base + 4) && kind == 2) { if (EN(10)) for (int rep = 0; rep < NREP(10); ++rep) {
            pg8::StaticSchedG S{{(const char*)(args->ws + WS_B1), (const char*)(args->ws + WS_WO), (size_t)256 * DM, (size_t)256 * DM, 128, 4, 128 * 4, G, bx, 0, 1}};
            EpiResid E{rep + 1 < NREP(10) ? (bf16*)(args->ws + WS_YG) : xs, mods_layer, nullptr, nullptr, nullptr, nullptr};
            pg8::gemm_phase<EpiResid, pg8::StaticSchedG, true, true>(tid, lds, rowtab, DM / 2, DM / 2, DM / 2, S, E); }
            SEAM(base + 4);
        }
        if (IN(base + 5)) { if (EN(11)) phase_router(args, lds, layer, tid, lane, wave); SEAM(base + 5); }
        if (IN(base + 6) || IN(base + 7)) {
            const unsigned* cnt = (const unsigned*)(args->ws + WS_CTL) + CW_CNT + layer * 32;
            const int cntl = (int)__hip_atomic_load(cnt + (lane & 31), __ATOMIC_RELAXED, __HIP_MEMORY_SCOPE_AGENT);
            const int nrb = (cntl + 255) >> 8;
            int incl = nrb;
#pragma unroll
            for (int o = 1; o < 32; o <<= 1) { const int t = __shfl_up(incl, o, 32); if ((lane & 31) >= o) incl += t; }
            const int pbl = incl - nrb, TB = __builtin_amdgcn_readlane(incl, 31);
            if (IN(base + 6)) { if (EN(12)) for (int rep = 0; rep < NREP(12); ++rep) {
                pg8::MoeSched<1> S{(const char*)(args->ws + WS_B3F), (const char*)(args->ws + WS_W1T) + (size_t)layer * 32 * 2048 * 1024, 0, (size_t)256 * DM, (size_t)2048 * 1024,
                                (const int*)(args->ws + WS_LIST), (const float*)(args->ws + WS_GATE), args->in[I_B1] + (size_t)layer * 32 * 2048, 8, TB * 8, G, bx, pbl, cntl};
                EpiMoe1 E{args->ws + WS_ACT};
                pg8::gemm_phase<EpiMoe1, pg8::MoeSched<1>, true, MOE1_FMT>(tid, lds, rowtab, DM / 2, DM / 2, DM / 2, S, E); }
                if (MK_PROBE_NULL) {
                    pg8::MoeSched<1> S{(const char*)(args->ws + WS_B3F), (const char*)(args->ws + WS_W1T) + (size_t)layer * 32 * 2048 * 1024, 0, (size_t)256 * DM, (size_t)2048 * 1024,
                                    (const int*)(args->ws + WS_LIST), (const float*)(args->ws + WS_GATE), args->in[I_B1] + (size_t)layer * 32 * 2048, 8, TB * 8, G, bx, pbl, cntl};
                    EpiNull E{(float*)(args->ws + WS_YG)};
                    pg8::gemm_phase<EpiNull, pg8::MoeSched<1>, true, MOE1_FMT>(tid, lds, rowtab, DM / 2, DM / 2, DM / 2, S, E);
                }
                SEAM(base + 6);
            }
            if (IN(base + 7)) { if (EN(13)) for (int rep = 0; rep < NREP(13); ++rep) {
                pg8::MoeSched<2> S{(const char*)(args->ws + WS_ACT), (const char*)(args->ws + WS_W2T) + (size_t)layer * 32 * 1024 * 1024, (size_t)256 * DFF, (size_t)256 * DFF, (size_t)1024 * 1024,
                                (const int*)(args->ws + WS_LIST), (const float*)(args->ws + WS_GATE), args->in[I_B2] + (size_t)layer * 32 * DM, 4, TB * 4, G, bx, pbl, cntl};
                EpiMoe2 E{args->ws + WS_YB};
                pg8::gemm_phase<EpiMoe2, pg8::MoeSched<2>, true, true>(tid, lds, rowtab, DFF / 2, DFF / 2, DFF / 2, S, E); }
                SEAM(base + 7);
            }
        }
    }
    if (IN(PH_FINAL)) { if (EN(14)) phase_final(args, lane, wave); }
#undef IN
#undef SEAM
}

extern "C" void kernel_launch(void* const* d_in, const int* in_sizes, int n_in, void* d_out, int out_size, void* d_ws, size_t ws_size, hipStream_t stream) {
    static int grid = 0;
    if (grid == 0) {
        if (n_in != N_IN || out_size != NB * SEQ * DM || ws_size < WS_END) { fprintf(stderr, "kernel_launch: shape/workspace mismatch: n_in %d out %d ws %zu (need %zu)\n", n_in, out_size, ws_size, (size_t)WS_END); grid = -1; return; }
        int dev = 0, cus = 0, per_cu = 0;
        if (hipGetDevice(&dev) != hipSuccess || hipDeviceGetAttribute(&cus, hipDeviceAttributeMultiprocessorCount, dev) != hipSuccess) { grid = -1; return; }
        if (hipFuncSetAttribute((const void*)mega_fwd, hipFuncAttributeMaxDynamicSharedMemorySize, LDS_BYTES) != hipSuccess) { fprintf(stderr, "kernel_launch: hipFuncSetAttribute failed\n"); grid = -1; return; }
        if (hipOccupancyMaxActiveBlocksPerMultiprocessor(&per_cu, (const void*)mega_fwd, NTHR, LDS_BYTES) != hipSuccess || per_cu < 1) { fprintf(stderr, "kernel_launch: occupancy query reports %d blocks per CU\n", per_cu); }
        (void)hipGetLastError();
        grid = cus;
        if (grid > 256) grid = 256;
    }
    if (grid < 0) return;
    (void)hipMemsetAsync((char*)d_ws + WS_CTL, 0, 65536, stream);
    Args a{};
    for (int i = 0; i < N_IN; ++i) a.in[i] = (const float*)d_in[i];
    a.out = (float*)d_out; a.ws = (unsigned char*)d_ws;
#if MK_SPLIT
    for (int p = 0; p < N_PHASES; ++p) { a.ph_lo = p; a.ph_hi = p + 1; hipLaunchKernelGGL(mega_fwd, dim3(grid), dim3(NTHR), LDS_BYTES, stream, a); }
#else
    a.ph_lo = 0; a.ph_hi = N_PHASES;
    hipLaunchKernelGGL(mega_fwd, dim3(grid), dim3(NTHR), LDS_BYTES, stream, a);
#endif
    const hipError_t le = hipPeekAtLastError();
    if (le != hipSuccess) fprintf(stderr, "kernel_launch: launch failed: %s\n", hipGetErrorName(le));
}
```
